# Optimizing an MI355X kernel written in HIP

```python
import jax, jax.numpy as jnp
from jax import lax
import numpy as np

D_MODEL = 1024
BATCH = 2
SEQ = 8192
DEPTH = 2

CTX_LEN = 256
GRID_W = 64
EPS = 1e-6
GLA_HEADS = 4
GLA_DK = 128
GLA_DV = 256
GLA_LR = 16
GLA_TAU = 16.0
GLA_CHUNK = 64
ROPE_BASE = 10000.0
NA_HEADS = 8
NA_HD = 64
WIN_R = 8
WIN_C = 16
N_EXPERTS = 16
N_GROUPS = 4
EXPERTS_PER_GROUP = N_EXPERTS // N_GROUPS
TOP_K = 2
D_FF_EXPERT = 1024
MOE_BLOCK = 128

GLA_QK = GLA_HEADS * GLA_DK
GLA_V = GLA_HEADS * GLA_DV
NA_W = NA_HEADS * NA_HD
IN_SIZES = (GLA_QK, GLA_QK, GLA_V, GLA_V, 2 * GLA_LR, NA_W, NA_W, NA_W, D_MODEL, D_MODEL)
IN_COLS = sum(IN_SIZES)

kernel_name = 'hybrid_gla_natten_moe_prefix_dit'


def rmsnorm(x, w):
    xf = x.astype(jnp.float32)
    y = xf * lax.rsqrt(jnp.mean(xf * xf, axis=-1, keepdims=True) + EPS)
    return (y * w.astype(jnp.float32)).astype(x.dtype)


def heads(t, n, d):
    B, L, _ = t.shape
    return t.reshape(B, L, n, d).transpose(0, 2, 1, 3)


def axial_rope(t, rows, cols):
    half = t.shape[-1] // 2
    inv = ROPE_BASE ** (-jnp.arange(0, half, 2, dtype=jnp.float32) / half)

    def rot(u, pos):
        ang = pos.astype(jnp.float32)[:, None] * inv[None, :]
        cos, sin = jnp.cos(ang), jnp.sin(ang)
        u1, u2 = jnp.split(u, 2, axis=-1)
        return jnp.concatenate([u1 * cos - u2 * sin, u1 * sin + u2 * cos], axis=-1)

    return jnp.concatenate([rot(t[..., :half], rows), rot(t[..., half:], cols)], axis=-1)


def gla_chunk_scan(q, k, v, logg, s0, need_out):
    B, H, L, _ = q.shape
    dv = v.shape[-1]
    n = L // GLA_CHUNK

    def chunks(t):
        return jnp.moveaxis(t.reshape(B, H, n, GLA_CHUNK, t.shape[-1]), 2, 0)

    lower = jnp.tril(jnp.ones((GLA_CHUNK, GLA_CHUNK), dtype=bool))

    def step(S, inp):
        qc, kc, vc, gc = inp
        b = jnp.cumsum(gc, axis=2)
        b_end = b[:, :, -1:, :]
        k_dec = kc * jnp.exp(b_end - b)
        S_new = S * jnp.exp(b_end[:, :, 0, :, None]) + jnp.einsum('bhsd,bhse->bhde', k_dec, vc)
        if not need_out:
            return S_new, None
        inter = jnp.einsum('bhtd,bhde->bhte', qc * jnp.exp(b), S)
        att = jnp.einsum('bhtd,bhsd->bhts', qc * jnp.exp(b - b_end), k_dec)
        att = jnp.where(lower, att, 0.0)
        o = inter + jnp.einsum('bhts,bhse->bhte', att, vc)
        return S_new, o

    S, o = lax.scan(step, s0, (chunks(q), chunks(k), chunks(v), chunks(logg)))
    if need_out:
        o = jnp.moveaxis(o, 0, 2).reshape(B, H, L, dv)
    return S, o


def gla_branch(xp, cp, w_gk_up, b_gk, norm_w, ctx_out):
    f32 = jnp.float32

    def prep(parts, grid):
        q, k, v, _, lr = parts
        q = heads(q, GLA_HEADS, GLA_DK).astype(f32)
        k = heads(k, GLA_HEADS, GLA_DK).astype(f32)
        if grid:
            t = jnp.arange(q.shape[2])
            q = axial_rope(q, t // GRID_W, t % GRID_W)
            k = axial_rope(k, t // GRID_W, t % GRID_W)
        q = q * (GLA_DK ** -0.5)
        v = heads(v, GLA_HEADS, GLA_DV).astype(f32)
        gates = []
        for d in range(2):
            z = lr[..., d * GLA_LR:(d + 1) * GLA_LR].astype(f32) @ w_gk_up[d].astype(f32) + b_gk[d].astype(f32)
            gates.append(heads(jax.nn.log_sigmoid(z) / GLA_TAU, GLA_HEADS, GLA_DK))
        return q, k, v, gates

    qx, kx, vx, (gxf, gxb) = prep(xp, True)
    qc, kc, vc, (gcf, gcb) = prep(cp, False)
    B = qx.shape[0]
    s0 = jnp.zeros((B, GLA_HEADS, GLA_DK, GLA_DV), f32)

    def flip(t):
        return jnp.flip(t, axis=2)

    s_cf, oc_f = gla_chunk_scan(qc, kc, vc, gcf, s0, ctx_out)
    s_cb, oc_b = gla_chunk_scan(flip(qc), flip(kc), flip(vc), flip(gcb), s0, ctx_out)
    _, ox_f = gla_chunk_scan(qx, kx, vx, gxf, s_cf, True)
    _, ox_b = gla_chunk_scan(flip(qx), flip(kx), flip(vx), flip(gxb), s_cb, True)

    def finish(o, g):
        o = o * lax.rsqrt(jnp.mean(o * o, axis=-1, keepdims=True) + EPS) * norm_w.astype(f32)
        Bo, H, L, dv = o.shape
        o = o.transpose(0, 2, 1, 3).reshape(Bo, L, H * dv)
        return (o * jax.nn.silu(g.astype(f32))).astype(g.dtype)

    yx = finish(ox_f + flip(ox_b), xp[3])
    yc = finish(oc_f + flip(oc_b), cp[3]) if ctx_out else None
    return yx, yc


def na_branch(xp, cp, rpb, ctx_out):
    f32 = jnp.float32
    q, k, v = xp
    B, L, _ = q.shape
    rows = L // GRID_W
    kr = min(WIN_R, rows)
    scale = NA_HD ** -0.5
    qg = (q * scale).reshape(B, rows, GRID_W, NA_HEADS, NA_HD)
    kg = k.reshape(B, rows, GRID_W, NA_HEADS, NA_HD)
    vg = v.reshape(B, rows, GRID_W, NA_HEADS, NA_HD)
    qc, kc, vc = [t.reshape(B, -1, NA_HEADS, NA_HD) for t in cp]

    col = jnp.arange(GRID_W)
    c0 = jnp.clip(col - WIN_C // 2, 0, GRID_W - WIN_C)
    col_mask = (col[None, :] >= c0[:, None]) & (col[None, :] < c0[:, None] + WIN_C)
    col_idx = jnp.clip(col[None, :] - col[:, None], -(WIN_C - 1), WIN_C - 1) + (WIN_C - 1)
    rpb32 = rpb.astype(f32)
    n_loc = kr * GRID_W

    def row_block(r):
        r0 = jnp.clip(r - kr // 2, 0, rows - kr)
        q_r = lax.dynamic_index_in_dim(qg, r, axis=1, keepdims=False)
        k_b = lax.dynamic_slice_in_dim(kg, r0, kr, axis=1)
        v_b = lax.dynamic_slice_in_dim(vg, r0, kr, axis=1)
        row_idx = r0 + jnp.arange(kr) - r + (WIN_R - 1)
        bias = rpb32[:, row_idx][:, :, col_idx].transpose(0, 2, 1, 3)
        s_loc = jnp.einsum('bqhd,bikhd->bhqik', q_r, k_b).astype(f32) + bias[None]
        s_loc = jnp.where(col_mask[:, None, :], s_loc, -jnp.inf).reshape(B, NA_HEADS, GRID_W, n_loc)
        s_ctx = jnp.einsum('bqhd,bchd->bhqc', q_r, kc).astype(f32)
        p = jax.nn.softmax(jnp.concatenate([s_loc, s_ctx], axis=-1), axis=-1).astype(v.dtype)
        o = jnp.einsum('bhqk,bkhd->bqhd', p[..., :n_loc], v_b.reshape(B, n_loc, NA_HEADS, NA_HD))
        o = o + jnp.einsum('bhqc,bchd->bqhd', p[..., n_loc:], vc)
        return o

    o = lax.map(row_block, jnp.arange(rows))
    yx = o.transpose(1, 0, 2, 3, 4).reshape(B, L, NA_W)
    yc = None
    if ctx_out:
        s = jnp.einsum('bqhd,bkhd->bhqk', qc * scale, kc).astype(f32)
        p = jax.nn.softmax(s, axis=-1).astype(vc.dtype)
        yc = jnp.einsum('bhqk,bkhd->bqhd', p, vc).reshape(B, -1, NA_W)
    return yx, yc


def hybrid_mixer(hx, hc, w_in, w_gk_up, b_gk, gla_norm_w, rpb, w_bo_gla, w_bo_na, w_out, ctx_out):
    idx = np.cumsum(IN_SIZES)[:-1].tolist()
    xp = jnp.split(hx @ w_in, idx, axis=-1)
    cp = jnp.split(hc @ w_in, idx, axis=-1)
    gla_x, gla_c = gla_branch(xp[:5], cp[:5], w_gk_up, b_gk, gla_norm_w, ctx_out)
    na_x, na_c = na_branch(xp[5:8], cp[5:8], rpb, ctx_out)

    def merge(gla_o, na_o, gates):
        m = jax.nn.sigmoid(gates[0]) * (gla_o @ w_bo_gla) + jax.nn.sigmoid(gates[1]) * (na_o @ w_bo_na)
        return m @ w_out

    yx = merge(gla_x, na_x, xp[8:])
    yc = merge(gla_c, na_c, cp[8:]) if ctx_out else None
    return yx, yc


def moe_ffn(h, w_router, b_router, w1, w3, w2):
    N, D = h.shape
    aff = jax.nn.sigmoid(h.astype(jnp.float32) @ w_router.astype(jnp.float32))
    sel = aff + b_router.astype(jnp.float32)
    gscore = lax.top_k(sel.reshape(N, N_GROUPS, EXPERTS_PER_GROUP), 2)[0].sum(-1)
    gbest = jnp.argmax(gscore, axis=-1)
    in_grp = (jnp.arange(N_EXPERTS) // EXPERTS_PER_GROUP)[None, :] == gbest[:, None]
    _, top_idx = lax.top_k(jnp.where(in_grp, sel, -jnp.inf), TOP_K)
    top_w = jnp.take_along_axis(aff, top_idx, axis=1)
    top_w = top_w / jnp.sum(top_w, axis=-1, keepdims=True)

    flat_e = top_idx.reshape(-1)
    flat_tok = jnp.repeat(jnp.arange(N, dtype=jnp.int32), TOP_K)
    flat_w = top_w.reshape(-1)
    order = jnp.argsort(flat_e)
    se, stok, sw = flat_e[order], flat_tok[order], flat_w[order]
    counts = jnp.bincount(flat_e, length=N_EXPERTS)
    starts = jnp.cumsum(counts) - counts
    padded = (counts + MOE_BLOCK - 1) // MOE_BLOCK * MOE_BLOCK
    pends = jnp.cumsum(padded)
    pstarts = pends - padded
    dest = pstarts[se] + (jnp.arange(N * TOP_K) - starts[se])
    n_blocks = (N * TOP_K + N_EXPERTS * (MOE_BLOCK - 1) + MOE_BLOCK - 1) // MOE_BLOCK
    P = n_blocks * MOE_BLOCK
    buf_tok = jnp.full((P,), N, dtype=jnp.int32).at[dest].set(stok)
    buf_w = jnp.zeros((P,), jnp.float32).at[dest].set(sw)
    blk_expert = jnp.minimum(jnp.searchsorted(pends, jnp.arange(n_blocks) * MOE_BLOCK, side='right'), N_EXPERTS - 1)
    h_pad = jnp.concatenate([h, jnp.zeros((1, D), h.dtype)], axis=0)

    def run_block(args):
        tok, e = args
        xb = h_pad[tok]
        return (jax.nn.silu(xb @ w1[e]) * (xb @ w3[e])) @ w2[e]

    y = lax.map(run_block, (buf_tok.reshape(n_blocks, MOE_BLOCK), blk_expert)).reshape(P, D)
    y = y * buf_w[:, None].astype(y.dtype)
    return jnp.zeros((N + 1, D), y.dtype).at[buf_tok].add(y)[:N]


def setup_inputs(seed: int = 0) -> dict:
    key = jax.random.key(seed)
    ks = jax.random.split(key, 24)
    D = D_MODEL

    def nrm(k, shape, s):
        return jax.random.normal(k, shape, jnp.float32) * s

    return {
        'x': nrm(ks[0], (BATCH, SEQ, D), 1.0),
        'c': nrm(ks[1], (BATCH, D), 1.0),
        'ctx': nrm(ks[2], (BATCH, CTX_LEN, D), 1.0),
        'c_ctx': nrm(ks[3], (D,), 1.0),
        'w_ada': nrm(ks[4], (DEPTH, D, 6 * D), 0.5 * D ** -0.5),
        'b_ada': nrm(ks[5], (DEPTH, 6 * D), 0.01),
        'norm1_w': 1.0 + nrm(ks[6], (DEPTH, D), 0.05),
        'norm2_w': 1.0 + nrm(ks[7], (DEPTH, D), 0.05),
        'w_in': nrm(ks[8], (DEPTH, D, IN_COLS), D ** -0.5),
        'w_gk_up': nrm(ks[9], (DEPTH, 2, GLA_LR, GLA_QK), GLA_LR ** -0.5),
        'b_gk': nrm(ks[10], (DEPTH, 2, GLA_QK), 0.1),
        'gla_norm_w': 1.0 + nrm(ks[11], (DEPTH, GLA_DV), 0.05),
        'rpb': nrm(ks[12], (DEPTH, NA_HEADS, 2 * WIN_R - 1, 2 * WIN_C - 1), 0.1),
        'w_bo_gla': nrm(ks[13], (DEPTH, GLA_V, D), GLA_V ** -0.5),
        'w_bo_na': nrm(ks[14], (DEPTH, NA_W, D), NA_W ** -0.5),
        'w_out': nrm(ks[15], (DEPTH, D, D), D ** -0.5),
        'w_router': nrm(ks[16], (D, N_EXPERTS), D ** -0.5),
        'b_router': nrm(ks[17], (N_EXPERTS,), 0.01),
        'w1': nrm(ks[18], (DEPTH, N_EXPERTS, D, D_FF_EXPERT), D ** -0.5),
        'w3': nrm(ks[19], (DEPTH, N_EXPERTS, D, D_FF_EXPERT), D ** -0.5),
        'w2': nrm(ks[20], (DEPTH, N_EXPERTS, D_FF_EXPERT, D), D_FF_EXPERT ** -0.5),
        'final_norm_w': 1.0 + nrm(ks[21], (D,), 0.05),
    }


def reference(x, c, ctx, c_ctx, w_ada, b_ada, norm1_w, norm2_w, w_in, w_gk_up, b_gk, gla_norm_w, rpb,
              w_bo_gla, w_bo_na, w_out, w_router, b_router, w1, w3, w2, final_norm_w):
    B, L, D = x.shape
    Lc = ctx.shape[1]
    for l in range(DEPTH):
        ctx_out = l < DEPTH - 1
        mx = (jax.nn.silu(c) @ w_ada[l] + b_ada[l]).reshape(B, 6, 1, D)
        mc = (jax.nn.silu(c_ctx) @ w_ada[l] + b_ada[l]).reshape(6, D)
        hx = rmsnorm(x, norm1_w[l]) * (1.0 + mx[:, 1]) + mx[:, 0]
        hc = rmsnorm(ctx, norm1_w[l]) * (1.0 + mc[1]) + mc[0]
        yx, yc = hybrid_mixer(hx, hc, w_in[l], w_gk_up[l], b_gk[l], gla_norm_w[l], rpb[l],
                              w_bo_gla[l], w_bo_na[l], w_out[l], ctx_out)
        x = x + mx[:, 2] * yx
        hx = rmsnorm(x, norm2_w[l]) * (1.0 + mx[:, 4]) + mx[:, 3]
        if ctx_out:
            ctx = ctx + mc[2] * yc
            hc = rmsnorm(ctx, norm2_w[l]) * (1.0 + mc[4]) + mc[3]
            tokens = jnp.concatenate([hx.reshape(-1, D), hc.reshape(-1, D)], axis=0)
            y = moe_ffn(tokens, w_router, b_router, w1[l], w3[l], w2[l])
            x = x + mx[:, 5] * y[:B * L].reshape(B, L, D)
            ctx = ctx + mc[5] * y[B * L:].reshape(B, Lc, D)
        else:
            y = moe_ffn(hx.reshape(-1, D), w_router, b_router, w1[l], w3[l], w2[l])
            x = x + mx[:, 5] * y.reshape(B, L, D)
    return rmsnorm(x, final_norm_w)
```

```cpp
#include <hip/hip_runtime.h>
#include <hip/hip_cooperative_groups.h>
#include <cstdio>
namespace cg = cooperative_groups;

#ifndef FUSED
#define FUSED 0
#endif

typedef unsigned short bf16_t;

#define NT 16896
#define NL 16384
#define DM 1024
#define INC 6688
#define NTHR 512
#define SMEM_BYTES 32768

__device__ __forceinline__ float bf2f(bf16_t v) { return __uint_as_float(((unsigned)v) << 16); }
__device__ __forceinline__ bf16_t f2bf(float f) {
  unsigned u = __float_as_uint(f);
  u += 0x7fffu + ((u >> 16) & 1u);
  return (bf16_t)(u >> 16);
}
__device__ __forceinline__ float sigmoidf_(float x) { return 1.f / (1.f + expf(-x)); }
__device__ __forceinline__ float siluf_(float x) { return x / (1.f + expf(-x)); }
__device__ __forceinline__ float wave_sum(float v) {
#pragma unroll
  for (int o = 32; o > 0; o >>= 1) v += __shfl_xor(v, o, 64);
  return v;
}
__device__ __forceinline__ float wave_max(float v) {
#pragma unroll
  for (int o = 32; o > 0; o >>= 1) v = fmaxf(v, __shfl_xor(v, o, 64));
  return v;
}

struct Params {
  const float *x, *c, *ctx, *c_ctx, *w_ada, *b_ada, *norm1_w, *norm2_w, *w_in, *w_gk_up, *b_gk, *gla_norm_w, *rpb,
      *w_bo_gla, *w_bo_na, *w_out, *w_router, *b_router, *w1, *w3, *w2, *final_norm_w;
  float* out;
  float *xbuf, *mod, *rope, *lr32, *topw, *of, *ob;
  int *cnt, *list;
  bf16_t *hA, *proj, *gla_o, *na_o, *mbuf, *h2, *hid, *ybuf;
};

__device__ void ph_init(const Params& p, char* smem, int bid, int nb) {
  float* sc = (float*)smem;
  int tid = threadIdx.x;
  for (int i = tid; i < 3 * 1024; i += NTHR) {
    int r = i >> 10, k = i & 1023;
    float v = (r < 2) ? p.c[r * 1024 + k] : p.c_ctx[k];
    sc[i] = siluf_(v);
  }
  __syncthreads();
  int gt = bid * NTHR + tid, gs = nb * NTHR;
  for (int it = gt; it < 2 * 6144; it += gs) {
    int l = it / 6144, jj = it % 6144;
    const float* w = p.w_ada + (size_t)l * 1024 * 6144 + jj;
    float a0 = 0.f, a1 = 0.f, a2 = 0.f;
    for (int i = 0; i < 1024; ++i) {
      float wv = w[(size_t)i * 6144];
      a0 += sc[i] * wv; a1 += sc[1024 + i] * wv; a2 += sc[2048 + i] * wv;
    }
    float bb = p.b_ada[l * 6144 + jj];
    p.mod[(l * 3 + 0) * 6144 + jj] = a0 + bb;
    p.mod[(l * 3 + 1) * 6144 + jj] = a1 + bb;
    p.mod[(l * 3 + 2) * 6144 + jj] = a2 + bb;
  }
  for (int it = gt; it < 128 * 32; it += gs) {
    int pos = it >> 5, i = it & 31;
    double inv = pow(10000.0, -(2.0 * i) / 64.0);
    double ang = (double)pos * inv;
    p.rope[it * 2] = (float)cos(ang);
    p.rope[it * 2 + 1] = (float)sin(ang);
  }
  if (gt < 32) p.cnt[gt] = 0;
}

__device__ void ph_norm1(const Params& p, int l, int bid, int nb) {
  int tid = threadIdx.x, wave = tid >> 6, lane = tid & 63;
  for (int row = bid * 8 + wave; row < NT; row += nb * 8) {
    const float* src;
    if (l == 0) src = (row < NL) ? p.x + (size_t)row * 1024 : p.ctx + (size_t)(row - NL) * 1024;
    else src = p.xbuf + (size_t)row * 1024;
    float4 v[4];
    float ss = 0.f;
#pragma unroll
    for (int i = 0; i < 4; ++i) {
      v[i] = *(const float4*)(src + i * 256 + lane * 4);
      ss += v[i].x * v[i].x + v[i].y * v[i].y + v[i].z * v[i].z + v[i].w * v[i].w;
    }
    ss = wave_sum(ss);
    float rstd = rsqrtf(ss * (1.f / 1024.f) + 1e-6f);
    int r = (row < NL) ? (row >> 13) : 2;
    const float* md = p.mod + (l * 3 + r) * 6144;
    const float* nw = p.norm1_w + l * 1024;
#pragma unroll
    for (int i = 0; i < 4; ++i) {
      int j = i * 256 + lane * 4;
      float xv[4] = {v[i].x, v[i].y, v[i].z, v[i].w};
#pragma unroll
      for (int q = 0; q < 4; ++q) {
        float h = xv[q] * rstd * nw[j + q] * (1.f + md[1024 + j + q]) + md[j + q];
        p.hA[(size_t)row * 1024 + j + q] = f2bf(h);
      }
      if (l == 0) *(float4*)(p.xbuf + (size_t)row * 1024 + j) = v[i];
    }
  }
}

template <bool DUAL, class AF, class EPI>
__device__ void gemm_naive(char* smem, int bid, int nb, int M, int N, int K, AF arow, const float* B, const float* B2,
                           int ldb, EPI epi) {
  float(*As)[132] = (float(*)[132])smem;
  float(*Bs)[68] = (float(*)[68])(smem + 16 * 132 * 4);
  float(*Bs2)[68] = (float(*)[68])(smem + 16 * 132 * 4 + 16 * 68 * 4);
  int tid = threadIdx.x, ty = tid >> 4, tx = tid & 15;
  int mt = (M + 127) / 128, ntl = (N + 63) / 64, ntile = mt * ntl;
  for (int tile = bid; tile < ntile; tile += nb) {
    int tm = tile / ntl, tn = tile % ntl;
    int row0 = tm * 128, col0 = tn * 64;
    float acc[4][4], acc2[4][4];
#pragma unroll
    for (int i = 0; i < 4; ++i)
#pragma unroll
      for (int j = 0; j < 4; ++j) { acc[i][j] = 0.f; acc2[i][j] = 0.f; }
    int ar = tid >> 2, ak = (tid & 3) * 4;
    const bf16_t* ap = (row0 + ar < M) ? arow(row0 + ar) : nullptr;
    int bk = (tid & 255) >> 4, bn = (tid & 15) * 4;
    bool bvalid = (col0 + bn) < N;
    for (int k0 = 0; k0 < K; k0 += 16) {
      float a4[4] = {0.f, 0.f, 0.f, 0.f};
      if (ap) {
        uint2 u = *(const uint2*)(ap + k0 + ak);
        a4[0] = __uint_as_float(u.x << 16); a4[1] = __uint_as_float(u.x & 0xffff0000u);
        a4[2] = __uint_as_float(u.y << 16); a4[3] = __uint_as_float(u.y & 0xffff0000u);
      }
#pragma unroll
      for (int q = 0; q < 4; ++q) As[ak + q][ar] = a4[q];
      if (tid < 256) {
        float4 bv = make_float4(0.f, 0.f, 0.f, 0.f);
        if (bvalid) bv = *(const float4*)(B + (size_t)(k0 + bk) * ldb + col0 + bn);
        *(float4*)&Bs[bk][bn] = bv;
      } else if (DUAL) {
        float4 bv = make_float4(0.f, 0.f, 0.f, 0.f);
        if (bvalid) bv = *(const float4*)(B2 + (size_t)(k0 + bk) * ldb + col0 + bn);
        *(float4*)&Bs2[bk][bn] = bv;
      }
      __syncthreads();
#pragma unroll
      for (int kk = 0; kk < 16; ++kk) {
        float4 a = *(const float4*)&As[kk][ty * 4];
        float4 b = *(const float4*)&Bs[kk][tx * 4];
        float av[4] = {a.x, a.y, a.z, a.w}, bv[4] = {b.x, b.y, b.z, b.w};
#pragma unroll
        for (int i = 0; i < 4; ++i)
#pragma unroll
          for (int j = 0; j < 4; ++j) acc[i][j] += av[i] * bv[j];
        if (DUAL) {
          float4 b2 = *(const float4*)&Bs2[kk][tx * 4];
          float bw[4] = {b2.x, b2.y, b2.z, b2.w};
#pragma unroll
          for (int i = 0; i < 4; ++i)
#pragma unroll
            for (int j = 0; j < 4; ++j) acc2[i][j] += av[i] * bw[j];
        }
      }
      __syncthreads();
    }
#pragma unroll
    for (int i = 0; i < 4; ++i)
#pragma unroll
      for (int j = 0; j < 4; ++j) {
        int gi = row0 + ty * 4 + i, gj = col0 + tx * 4 + j;
        if (gi < M && gj < N) epi(gi, gj, acc[i][j], acc2[i][j]);
      }
  }
}

__device__ void ph_proj(const Params& p, int l, char* smem, int bid, int nb) {
  const bf16_t* A = p.hA;
  bf16_t* proj = p.proj;
  float* lr32 = p.lr32;
  gemm_naive<false>(
      smem, bid, nb, NT, INC, 1024, [=](int i) { return A + (size_t)i * 1024; }, p.w_in + (size_t)l * 1024 * INC,
      nullptr, INC, [=](int i, int j, float v, float) {
        proj[(size_t)i * INC + j] = f2bf(v);
        if (j >= 3072 && j < 3104) lr32[i * 32 + (j - 3072)] = v;
      });
}

__device__ void gla_scan_naive(const Params& p, int l, char* smem, int chain) {
  float* buf = (float*)smem;
  float* po = buf + 384;
  int tid = threadIdx.x;
  int b = chain >> 3, hd = (chain >> 1) & 3, dir = chain & 1;
  int e = tid & 255, dh2 = tid >> 8;
  float S[64];
#pragma unroll
  for (int d = 0; d < 64; ++d) S[d] = 0.f;
  float* dsto = dir ? p.ob : p.of;
  for (int step = 0; step < 8448; ++step) {
    bool isctx = step < 256;
    int idx = isctx ? step : step - 256;
    int n = isctx ? 256 : 8192;
    int t = dir ? (n - 1 - idx) : idx;
    int row = isctx ? (NL + b * 256 + t) : (b * 8192 + t);
    const bf16_t* pr = p.proj + (size_t)row * INC;
    if (tid < 128) {
      int d = tid;
      const float* lr = p.lr32 + row * 32 + dir * 16;
      float z = p.b_gk[(l * 2 + dir) * 512 + hd * 128 + d];
      for (int r = 0; r < 16; ++r) z += lr[r] * p.w_gk_up[((size_t)(l * 2 + dir) * 16 + r) * 512 + hd * 128 + d];
      float ls = fminf(z, 0.f) - log1pf(expf(-fabsf(z)));
      float eg = expf(ls * (1.f / 16.f));
      int dh = d & 63, i = dh & 31;
      float qv = bf2f(pr[hd * 128 + d]), kv = bf2f(pr[512 + hd * 128 + d]);
      if (!isctx) {
        int pos = (d < 64) ? (t >> 6) : (t & 63);
        float cs = p.rope[(pos * 32 + i) * 2], sn = p.rope[(pos * 32 + i) * 2 + 1];
        int dp = (dh < 32) ? d + 32 : d - 32;
        float qp = bf2f(pr[hd * 128 + dp]), kp = bf2f(pr[512 + hd * 128 + dp]);
        if (dh < 32) { qv = qv * cs - qp * sn; kv = kv * cs - kp * sn; }
        else { qv = qp * sn + qv * cs; kv = kp * sn + kv * cs; }
      }
      qv *= 0.08838834764831845f;
      buf[d] = qv; buf[128 + d] = kv; buf[256 + d] = eg;
    }
    __syncthreads();
    float v = bf2f(pr[1024 + hd * 256 + e]);
    float o = 0.f;
#pragma unroll
    for (int dd = 0; dd < 64; ++dd) {
      int d = dh2 * 64 + dd;
      S[dd] = S[dd] * buf[256 + d] + buf[128 + d] * v;
      o += buf[d] * S[dd];
    }
    if (dh2) po[e] = o;
    __syncthreads();
    if (!dh2) dsto[(size_t)row * 1024 + hd * 256 + e] = o + po[e];
  }
}

__device__ void na_naive(const Params& p, int l, char* smem, int bid, int nb) {
  int tid = threadIdx.x, wave = tid >> 6, lane = tid & 63;
  float* ps = (float*)smem + wave * 448;
  float* qs = ps + 384;
  int nq = (l == 0) ? NT : NL;
  int total = nq * 8;
  const float* rp = p.rpb + (size_t)l * 8 * 15 * 31;
  for (int base = bid * 8; base < total; base += nb * 8) {
    int it = base + wave;
    int qrow = it >> 3, h = it & 7;
    bool lat = qrow < NL;
    int b, r = 0, c = 0, r0 = 0, c0 = 0;
    if (lat) {
      b = qrow >> 13; int t = qrow & 8191; r = t >> 6; c = t & 63;
      r0 = min(max(r - 4, 0), 120); c0 = min(max(c - 8, 0), 48);
    } else b = (qrow - NL) >> 8;
    int nloc = lat ? 128 : 0, nk = nloc + 256;
    qs[lane] = bf2f(p.proj[(size_t)qrow * INC + 3104 + h * 64 + lane]) * 0.125f;
    __syncthreads();
    float mx = -INFINITY;
#pragma unroll 1
    for (int i = 0; i < 6; ++i) {
      int j = lane + 64 * i;
      if (j < nk) {
        int krow; float bias = 0.f;
        if (j < nloc) {
          int ki = j >> 4, kc = c0 + (j & 15);
          krow = b * 8192 + (r0 + ki) * 64 + kc;
          int ri = r0 + ki - r + 7, ci = min(max(kc - c, -15), 15) + 15;
          bias = rp[(h * 15 + ri) * 31 + ci];
        } else krow = NL + b * 256 + (j - nloc);
        const bf16_t* kp = p.proj + (size_t)krow * INC + 3616 + h * 64;
        float a = 0.f;
#pragma unroll 8
        for (int dd = 0; dd < 64; ++dd) a += qs[dd] * bf2f(kp[dd]);
        float s = a + bias;
        ps[j] = s;
        mx = fmaxf(mx, s);
      }
    }
    mx = wave_max(mx);
    float sum = 0.f;
#pragma unroll 1
    for (int i = 0; i < 6; ++i) {
      int j = lane + 64 * i;
      if (j < nk) {
        float e = expf(ps[j] - mx);
        sum += e;
        ps[j] = e;
      }
    }
    sum = wave_sum(sum);
    __syncthreads();
    float o = 0.f;
#pragma unroll 4
    for (int j = 0; j < nk; ++j) {
      int krow;
      if (j < nloc) krow = b * 8192 + (r0 + (j >> 4)) * 64 + c0 + (j & 15);
      else krow = NL + b * 256 + (j - nloc);
      o += ps[j] * bf2f(p.proj[(size_t)krow * INC + 4128 + h * 64 + lane]);
    }
    p.na_o[(size_t)qrow * 512 + h * 64 + lane] = f2bf(o / sum);
    __syncthreads();
  }
}

__device__ void ph_mix(const Params& p, int l, char* smem, int bid, int nb) {
  if (bid < 16) gla_scan_naive(p, l, smem, bid);
  else na_naive(p, l, smem, bid - 16, nb - 16);
}

__device__ void ph_gla_finish(const Params& p, int l, int bid, int nb) {
  int tid = threadIdx.x, wave = tid >> 6, lane = tid & 63;
  int nrow = (l == 0) ? NT : NL;
  for (int it = bid * 8 + wave; it < nrow * 4; it += nb * 8) {
    int row = it >> 2, hd = it & 3;
    size_t off = (size_t)row * 1024 + hd * 256 + lane * 4;
    float4 a = *(const float4*)(p.of + off), bb = *(const float4*)(p.ob + off);
    float o[4] = {a.x + bb.x, a.y + bb.y, a.z + bb.z, a.w + bb.w};
    float ss = o[0] * o[0] + o[1] * o[1] + o[2] * o[2] + o[3] * o[3];
    ss = wave_sum(ss);
    float rstd = rsqrtf(ss * (1.f / 256.f) + 1e-6f);
#pragma unroll
    for (int q = 0; q < 4; ++q) {
      int e = lane * 4 + q;
      float g = bf2f(p.proj[(size_t)row * INC + 2048 + hd * 256 + e]);
      float y = o[q] * rstd * p.gla_norm_w[l * 256 + e] * siluf_(g);
      p.gla_o[(size_t)row * 1024 + hd * 256 + e] = f2bf(y);
    }
  }
}

__device__ void ph_merge_a(const Params& p, int l, char* smem, int bid, int nb) {
  const bf16_t* A = p.gla_o; const bf16_t* proj = p.proj; float* mt = p.of;
  int M = (l == 0) ? NT : NL;
  gemm_naive<false>(
      smem, bid, nb, M, 1024, 1024, [=](int i) { return A + (size_t)i * 1024; }, p.w_bo_gla + (size_t)l * 1024 * 1024,
      nullptr, 1024, [=](int i, int j, float v, float) {
        float g = bf2f(proj[(size_t)i * INC + 4640 + j]);
        mt[(size_t)i * 1024 + j] = sigmoidf_(g) * v;
      });
}
__device__ void ph_merge_b(const Params& p, int l, char* smem, int bid, int nb) {
  const bf16_t* A = p.na_o; const bf16_t* proj = p.proj; float* mt = p.of; bf16_t* mb = p.mbuf;
  int M = (l == 0) ? NT : NL;
  gemm_naive<false>(
      smem, bid, nb, M, 1024, 512, [=](int i) { return A + (size_t)i * 512; }, p.w_bo_na + (size_t)l * 512 * 1024,
      nullptr, 1024, [=](int i, int j, float v, float) {
        float g = bf2f(proj[(size_t)i * INC + 5664 + j]);
        mb[(size_t)i * 1024 + j] = f2bf(mt[(size_t)i * 1024 + j] + sigmoidf_(g) * v);
      });
}
__device__ void ph_out(const Params& p, int l, char* smem, int bid, int nb) {
  const bf16_t* A = p.mbuf; float* xb = p.xbuf; const float* mod = p.mod;
  int M = (l == 0) ? NT : NL;
  gemm_naive<false>(
      smem, bid, nb, M, 1024, 1024, [=](int i) { return A + (size_t)i * 1024; }, p.w_out + (size_t)l * 1024 * 1024,
      nullptr, 1024, [=](int i, int j, float v, float) {
        int r = (i < NL) ? (i >> 13) : 2;
        xb[(size_t)i * 1024 + j] += mod[(l * 3 + r) * 6144 + 2 * 1024 + j] * v;
      });
}

__device__ void ph_norm2(const Params& p, int l, int bid, int nb) {
  int tid = threadIdx.x, wave = tid >> 6, lane = tid & 63;
  int M = (l == 0) ? NT : NL;
  for (int row = bid * 8 + wave; row < M; row += nb * 8) {
    const float* src = p.xbuf + (size_t)row * 1024;
    float4 v[4];
    float ss = 0.f;
#pragma unroll
    for (int i = 0; i < 4; ++i) {
      v[i] = *(const float4*)(src + i * 256 + lane * 4);
      ss += v[i].x * v[i].x + v[i].y * v[i].y + v[i].z * v[i].z + v[i].w * v[i].w;
    }
    ss = wave_sum(ss);
    float rstd = rsqrtf(ss * (1.f / 1024.f) + 1e-6f);
    int r = (row < NL) ? (row >> 13) : 2;
    const float* md = p.mod + (l * 3 + r) * 6144;
    const float* nw = p.norm2_w + l * 1024;
    float lg[16];
#pragma unroll
    for (int e = 0; e < 16; ++e) lg[e] = 0.f;
#pragma unroll
    for (int i = 0; i < 4; ++i) {
      int j = i * 256 + lane * 4;
      float xv[4] = {v[i].x, v[i].y, v[i].z, v[i].w};
#pragma unroll
      for (int q = 0; q < 4; ++q) {
        float h = xv[q] * rstd * nw[j + q] * (1.f + md[4 * 1024 + j + q]) + md[3 * 1024 + j + q];
        p.h2[(size_t)row * 1024 + j + q] = f2bf(h);
        const float4* wr = (const float4*)(p.w_router + (size_t)(j + q) * 16);
#pragma unroll
        for (int e4 = 0; e4 < 4; ++e4) {
          float4 w = wr[e4];
          lg[e4 * 4 + 0] += h * w.x; lg[e4 * 4 + 1] += h * w.y; lg[e4 * 4 + 2] += h * w.z; lg[e4 * 4 + 3] += h * w.w;
        }
      }
    }
#pragma unroll
    for (int e = 0; e < 16; ++e) lg[e] = wave_sum(lg[e]);
    if (lane == 0) {
      float aff[16], sel[16];
#pragma unroll
      for (int e = 0; e < 16; ++e) { aff[e] = sigmoidf_(lg[e]); sel[e] = aff[e] + p.b_router[e]; }
      float best = -INFINITY; int gb = 0;
      float bs[4], ba[4];
#pragma unroll
      for (int q = 0; q < 4; ++q) { bs[q] = 0.f; ba[q] = 0.f; }
#pragma unroll
      for (int g = 0; g < 4; ++g) {
        float s0 = sel[4 * g], s1 = sel[4 * g + 1], s2 = sel[4 * g + 2], s3 = sel[4 * g + 3];
        float tot = s0 + s1 + s2 + s3;
        float m1 = fmaxf(fmaxf(s0, s1), fmaxf(s2, s3));
        int f = (s0 == m1) ? 0 : (s1 == m1) ? 1 : (s2 == m1) ? 2 : 3;
        float m2 = -INFINITY;
        if (f != 0) m2 = fmaxf(m2, s0);
        if (f != 1) m2 = fmaxf(m2, s1);
        if (f != 2) m2 = fmaxf(m2, s2);
        if (f != 3) m2 = fmaxf(m2, s3);
        float gs = m1 + m2;
        (void)tot;
        if (gs > best) {
          best = gs; gb = g;
          bs[0] = s0; bs[1] = s1; bs[2] = s2; bs[3] = s3;
          ba[0] = aff[4 * g]; ba[1] = aff[4 * g + 1]; ba[2] = aff[4 * g + 2]; ba[3] = aff[4 * g + 3];
        }
      }
      float m1 = fmaxf(fmaxf(bs[0], bs[1]), fmaxf(bs[2], bs[3]));
      int i1 = (bs[0] == m1) ? 0 : (bs[1] == m1) ? 1 : (bs[2] == m1) ? 2 : 3;
      float m2 = -INFINITY; int i2 = 0;
#pragma unroll
      for (int q = 3; q >= 0; --q)
        if (q != i1 && bs[q] >= m2) { m2 = bs[q]; i2 = q; }
      float a1 = (i1 == 0) ? ba[0] : (i1 == 1) ? ba[1] : (i1 == 2) ? ba[2] : ba[3];
      float a2 = (i2 == 0) ? ba[0] : (i2 == 1) ? ba[1] : (i2 == 2) ? ba[2] : ba[3];
      float inv = 1.f / (a1 + a2);
      int e1 = gb * 4 + i1, e2 = gb * 4 + i2;
      int s1 = atomicAdd(&p.cnt[l * 16 + e1], 1);
      p.list[e1 * NT + s1] = row * 2;
      p.topw[row * 2] = a1 * inv;
      int s2 = atomicAdd(&p.cnt[l * 16 + e2], 1);
      p.list[e2 * NT + s2] = row * 2 + 1;
      p.topw[row * 2 + 1] = a2 * inv;
    }
  }
}

__device__ void ph_moe1(const Params& p, int l, char* smem, int bid, int nb) {
  const bf16_t* h2 = p.h2; bf16_t* hid = p.hid;
  int base = 0;
  for (int e = 0; e < 16; ++e) {
    int cnt = p.cnt[l * 16 + e];
    const int* lst = p.list + e * NT;
    const float* B1 = p.w1 + ((size_t)(l * 16 + e) << 20);
    const float* B3 = p.w3 + ((size_t)(l * 16 + e) << 20);
    int bb = base;
    gemm_naive<true>(
        smem, bid, nb, cnt, 1024, 1024, [=](int i) { return h2 + (size_t)(lst[i] >> 1) * 1024; }, B1, B3, 1024,
        [=](int i, int j, float v1, float v3) { hid[(size_t)(bb + i) * 1024 + j] = f2bf(siluf_(v1) * v3); });
    base += (cnt + 127) & ~127;
  }
}
__device__ void ph_moe2(const Params& p, int l, char* smem, int bid, int nb) {
  const bf16_t* hid = p.hid; bf16_t* yb = p.ybuf; const float* topw = p.topw;
  int base = 0;
  for (int e = 0; e < 16; ++e) {
    int cnt = p.cnt[l * 16 + e];
    const int* lst = p.list + e * NT;
    const float* B2 = p.w2 + ((size_t)(l * 16 + e) << 20);
    int bb = base;
    gemm_naive<false>(
        smem, bid, nb, cnt, 1024, 1024, [=](int i) { return hid + (size_t)(bb + i) * 1024; }, B2, nullptr, 1024,
        [=](int i, int j, float v, float) {
          int pr = lst[i];
          yb[(size_t)pr * 1024 + j] = f2bf(v * topw[pr]);
        });
    base += (cnt + 127) & ~127;
  }
}
__device__ void ph_combine(const Params& p, int l, int bid, int nb) {
  int M = (l == 0) ? NT : NL;
  size_t total = (size_t)M * 1024;
  for (size_t i = (size_t)bid * NTHR + threadIdx.x; i < total; i += (size_t)nb * NTHR) {
    int row = (int)(i >> 10), j = (int)(i & 1023);
    int r = (row < NL) ? (row >> 13) : 2;
    float y = bf2f(p.ybuf[(size_t)(row * 2) * 1024 + j]) + bf2f(p.ybuf[(size_t)(row * 2 + 1) * 1024 + j]);
    p.xbuf[i] += p.mod[(l * 3 + r) * 6144 + 5 * 1024 + j] * y;
  }
}
__device__ void ph_final(const Params& p, int bid, int nb) {
  int tid = threadIdx.x, wave = tid >> 6, lane = tid & 63;
  for (int row = bid * 8 + wave; row < NL; row += nb * 8) {
    const float* src = p.xbuf + (size_t)row * 1024;
    float4 v[4];
    float ss = 0.f;
#pragma unroll
    for (int i = 0; i < 4; ++i) {
      v[i] = *(const float4*)(src + i * 256 + lane * 4);
      ss += v[i].x * v[i].x + v[i].y * v[i].y + v[i].z * v[i].z + v[i].w * v[i].w;
    }
    ss = wave_sum(ss);
    float rstd = rsqrtf(ss * (1.f / 1024.f) + 1e-6f);
#pragma unroll
    for (int i = 0; i < 4; ++i) {
      int j = i * 256 + lane * 4;
      float4 w = *(const float4*)(p.final_norm_w + j);
      float4 o = make_float4(v[i].x * rstd * w.x, v[i].y * rstd * w.y, v[i].z * rstd * w.z, v[i].w * rstd * w.w);
      *(float4*)(p.out + (size_t)row * 1024 + j) = o;
    }
  }
}

__device__ __forceinline__ void run_phase(const Params& p, int ph, int l, char* smem, int bid, int nb) {
  switch (ph) {
#if !defined(ONLYPH) || ONLYPH == 0
    case 0: ph_init(p, smem, bid, nb); break;
#endif
#if !defined(ONLYPH) || ONLYPH == 1
    case 1: ph_norm1(p, l, bid, nb); break;
#endif
#if !defined(ONLYPH) || ONLYPH == 2
    case 2: ph_proj(p, l, smem, bid, nb); break;
#endif
#if !defined(ONLYPH) || ONLYPH == 3
    case 3: ph_mix(p, l, smem, bid, nb); break;
#endif
#if !defined(ONLYPH) || ONLYPH == 4
    case 4: ph_gla_finish(p, l, bid, nb); break;
#endif
#if !defined(ONLYPH) || ONLYPH == 5
    case 5: ph_merge_a(p, l, smem, bid, nb); break;
#endif
#if !defined(ONLYPH) || ONLYPH == 6
    case 6: ph_merge_b(p, l, smem, bid, nb); break;
#endif
#if !defined(ONLYPH) || ONLYPH == 7
    case 7: ph_out(p, l, smem, bid, nb); break;
#endif
#if !defined(ONLYPH) || ONLYPH == 8
    case 8: ph_norm2(p, l, bid, nb); break;
#endif
#if !defined(ONLYPH) || ONLYPH == 9
    case 9: ph_moe1(p, l, smem, bid, nb); break;
#endif
#if !defined(ONLYPH) || ONLYPH == 10
    case 10: ph_moe2(p, l, smem, bid, nb); break;
#endif
#if !defined(ONLYPH) || ONLYPH == 11
    case 11: ph_combine(p, l, bid, nb); break;
#endif
#if !defined(ONLYPH) || ONLYPH == 12
    case 12: ph_final(p, bid, nb); break;
#endif
  }
}

__global__ void __launch_bounds__(NTHR) k_phase(Params p, int ph, int l) {
  __shared__ __attribute__((aligned(16))) char smem[SMEM_BYTES];
  run_phase(p, ph, l, smem, blockIdx.x, gridDim.x);
}

#if FUSED
__global__ void __launch_bounds__(NTHR) k_mega(Params p) {
  __shared__ __attribute__((aligned(16))) char smem[SMEM_BYTES];
  cg::grid_group grid = cg::this_grid();
  int bid = blockIdx.x, nb = gridDim.x;
  ph_init(p, smem, bid, nb);
  grid.sync();
#pragma unroll 1
  for (int l = 0; l < 2; ++l) {
    ph_norm1(p, l, bid, nb); grid.sync();
    ph_proj(p, l, smem, bid, nb); grid.sync();
    ph_mix(p, l, smem, bid, nb); grid.sync();
    ph_gla_finish(p, l, bid, nb); grid.sync();
    ph_merge_a(p, l, smem, bid, nb); grid.sync();
    ph_merge_b(p, l, smem, bid, nb); grid.sync();
    ph_out(p, l, smem, bid, nb); grid.sync();
    ph_norm2(p, l, bid, nb); grid.sync();
    ph_moe1(p, l, smem, bid, nb); grid.sync();
    ph_moe2(p, l, smem, bid, nb); grid.sync();
    ph_combine(p, l, bid, nb); grid.sync();
  }
  ph_final(p, bid, nb);
}
#endif

extern "C" void kernel_launch(void* const* d_in, const int* in_sizes, int n_in, void* d_out, int out_size, void* d_ws,
                              size_t ws_size, hipStream_t stream) {
  Params p{};
  const float** fp = (const float**)&p;
  for (int i = 0; i < 22; ++i) fp[i] = (const float*)d_in[i];
  p.out = (float*)d_out;
  char* w = (char*)d_ws;
  size_t off = 0;
  auto take = [&](size_t bytes) { char* r = w + off; off += (bytes + 255) & ~(size_t)255; return r; };
  p.xbuf = (float*)take((size_t)NT * 1024 * 4);
  p.mod = (float*)take(2 * 3 * 6144 * 4);
  p.rope = (float*)take(128 * 32 * 2 * 4);
  p.lr32 = (float*)take((size_t)NT * 32 * 4);
  p.topw = (float*)take((size_t)NT * 2 * 4);
  p.cnt = (int*)take(256);
  p.list = (int*)take((size_t)16 * NT * 4);
  p.hA = (bf16_t*)take((size_t)NT * 1024 * 2);
  p.gla_o = (bf16_t*)take((size_t)NT * 1024 * 2);
  p.na_o = (bf16_t*)take((size_t)NT * 512 * 2);
  p.mbuf = (bf16_t*)take((size_t)NT * 1024 * 2);
  p.of = (float*)take((size_t)NT * 1024 * 4);
  p.ob = (float*)take((size_t)NT * 1024 * 4);
  char* projr = take((size_t)NT * INC * 2);
  p.proj = (bf16_t*)projr;
  p.h2 = (bf16_t*)projr;
  p.hid = (bf16_t*)(projr + (size_t)NT * 1024 * 2);
  p.ybuf = (bf16_t*)(projr + (size_t)NT * 1024 * 2 + (size_t)(2 * NT + 16 * 128) * 1024 * 2);
  if (off > ws_size) { fprintf(stderr, "workspace too small: need %zu have %zu\n", off, ws_size); return; }

  static int grid_blocks = 0;
  if (!grid_blocks) {
    int dev = 0, cus = 0, per_cu = 0;
    hipGetDevice(&dev);
    hipDeviceGetAttribute(&cus, hipDeviceAttributeMultiprocessorCount, dev);
#if FUSED
    hipOccupancyMaxActiveBlocksPerMultiprocessor(&per_cu, k_mega, NTHR, 0);
#else
    per_cu = 1;
#endif
    if (per_cu < 1) per_cu = 1;
    grid_blocks = cus;
    if (grid_blocks <= 0) grid_blocks = 256;
  }
#if FUSED
  void* args[] = {&p};
  hipError_t e = hipLaunchCooperativeKernel((void*)k_mega, dim3(grid_blocks), dim3(NTHR), args, 0, stream);
  if (e != hipSuccess) fprintf(stderr, "cooperative launch failed: %s (grid %d)\n", hipGetErrorString(e), grid_blocks);
#else
  k_phase<<<grid_blocks, NTHR, 0, stream>>>(p, 0, 0);
  for (int l = 0; l < 2; ++l)
    for (int ph = 1; ph <= 11; ++ph) k_phase<<<grid_blocks, NTHR, 0, stream>>>(p, ph, l);
  k_phase<<<grid_blocks, NTHR, 0, stream>>>(p, 12, 0);
#endif
}
```

```cpp
#include <hip/hip_runtime.h>
#include <hip/hip_cooperative_groups.h>
#include <cstdio>
#include <cstdint>
namespace cg = cooperative_groups;

typedef unsigned short bf16_t;
typedef short bf16x8 __attribute__((ext_vector_type(8)));
typedef float f32x4 __attribute__((ext_vector_type(4)));
typedef unsigned u32x4 __attribute__((ext_vector_type(4)));
typedef unsigned u32x2 __attribute__((ext_vector_type(2)));
#define LAS __attribute__((address_space(3)))

#define NT 16896
#define NL 16384
#define PSTR 6912
#define INC 6688
#define GSTR 1536
#define NTHR 512
#define NWAVES 8
#define RING_BYTES 131072
#define LDS_BYTES 151552
#define MISC_OFF 131072

__device__ __forceinline__ float bf2f(bf16_t v) { return __uint_as_float(((unsigned)v) << 16); }
typedef __bf16 hwbf16x2 __attribute__((ext_vector_type(2)));
typedef float f32x2 __attribute__((ext_vector_type(2)));
__device__ __forceinline__ unsigned pk2(float lo, float hi) { const f32x2 v = {lo, hi}; return __builtin_bit_cast(unsigned, __builtin_convertvector(v, hwbf16x2)); }
__device__ __forceinline__ bf16_t f2bf(float f) { return (bf16_t)(pk2(f, 0.f) & 0xffffu); }
__device__ __forceinline__ float bflo(unsigned u) { return __uint_as_float(u << 16); }
__device__ __forceinline__ float bfhi(unsigned u) { return __uint_as_float(u & 0xffff0000u); }
__device__ __forceinline__ float sigmoidf_(float x) { return 1.f / (1.f + __expf(-x)); }
__device__ __forceinline__ float siluf_(float x) { return x / (1.f + __expf(-x)); }
__device__ __forceinline__ float wave_sum(float v) {
#pragma unroll
  for (int o = 32; o > 0; o >>= 1) v += __shfl_xor(v, o, 64);
  return v;
}
__device__ __forceinline__ float wave_max(float v) {
#pragma unroll
  for (int o = 32; o > 0; o >>= 1) v = fmaxf(v, __shfl_xor(v, o, 64));
  return v;
}
__device__ __forceinline__ int otid() { int t = threadIdx.x; asm volatile("" : "+v"(t)); return t; }

constexpr size_t al256(size_t x) { return (x + 255) & ~(size_t)255; }
constexpr size_t WS_CTL = 0;
constexpr size_t WS_MOD = WS_CTL + 32768;
constexpr size_t WS_ROPE = WS_MOD + al256(2 * 3 * 6144 * 4);
constexpr size_t WS_LR32 = WS_ROPE + al256(128 * 32 * 2 * 4);
constexpr size_t WS_TOPW = WS_LR32 + al256((size_t)NT * 32 * 4);
constexpr size_t WS_POS = WS_TOPW + al256((size_t)NT * 2 * 4);
constexpr size_t WS_LIST = WS_POS + al256((size_t)NT * 2 * 4);
constexpr size_t WS_DB = WS_LIST + al256((size_t)16 * NT * 4);
constexpr size_t WS_APART = WS_DB + al256((size_t)16 * 132 * 128 * 4);
constexpr size_t WS_XBUF = WS_APART + al256((size_t)2 * 32 * 3 * 6144 * 4);
constexpr size_t WS_WINT = WS_XBUF + al256((size_t)NT * 1024 * 4);
constexpr size_t WS_WMT = WS_WINT + al256((size_t)2 * PSTR * 1024 * 2);
constexpr size_t WS_WOT = WS_WMT + al256((size_t)2 * 1024 * GSTR * 2);
constexpr size_t WS_HM = WS_WOT + al256((size_t)2 * 1024 * 1024 * 2);
constexpr size_t WS_GM = WS_HM + al256((size_t)NT * 1024 * 2);
constexpr size_t WS_RG = WS_GM + al256((size_t)NT * GSTR * 2);
constexpr size_t WS_PROJ = WS_RG + al256((size_t)NT * 1024 * 4 * 2);
constexpr size_t WS_END = WS_PROJ + al256((size_t)NT * PSTR * 2);
constexpr size_t PROWS = 37888;
constexpr size_t WS_Y = WS_RG + (size_t)16 * 3 * 1024 * 1024 * 2;
static_assert((size_t)16 * 3 * 1024 * 1024 * 2 + (size_t)NT * 1024 * 2 <= (size_t)NT * 1024 * 4 * 2, "y buffer");
static_assert(2 * PROWS * 2048 + (size_t)NT * 2 * 2048 <= (size_t)NT * PSTR * 2, "MoE buffers must fit in the projection region");
static_assert((size_t)16 * 132 * 256 * 128 * 2 <= (size_t)NT * 1024 * 4 * 2, "GLA state buffer");
static_assert((size_t)16 * 3 * 1024 * 1024 * 2 <= (size_t)NT * 1024 * 4 * 2, "expert copies");

struct Params {
  const float *x, *c, *ctx, *c_ctx, *w_ada, *b_ada, *norm1_w, *norm2_w, *w_in, *w_gk_up, *b_gk, *gla_norm_w, *rpb,
      *w_bo_gla, *w_bo_na, *w_out, *w_router, *b_router, *w1, *w3, *w2, *final_norm_w;
  float* out;
  char* ws;
};
#define WSP(T, off) ((T*)(wsb + (off)))
typedef const unsigned long long __attribute__((address_space(4))) karg_t;
#define GAS __attribute__((address_space(1)))
#define WS_LOCAL karg_t* kab = (karg_t*)__builtin_amdgcn_kernarg_segment_ptr(); asm volatile("" : "+s"(kab)); char* wsb = (char*)(GAS char*)kab[23];
#define KARG(T, idx) ((T*)(GAS T*)kab[idx])

#define XB_TMO      128
#define XB_XCNT(j)  (256  + 64 * (j))
#define XB_XSUB(j)  (1280 + 64 * (j))
#define XB_XGEN(j)  (2304 + 64 * (j))
#define XB_TOP      3328
#define XB_TOPGEN   3392
#define XCD_BAR_WORDS 3456
#define XB_SPIN_CAP (1u << 22)
__device__ __forceinline__ unsigned xb_ld(unsigned* p) { return __hip_atomic_load(p, __ATOMIC_RELAXED, __HIP_MEMORY_SCOPE_AGENT); }
__device__ __forceinline__ unsigned xb_add(unsigned* p, unsigned v) { return __hip_atomic_fetch_add(p, v, __ATOMIC_RELAXED, __HIP_MEMORY_SCOPE_AGENT); }
__device__ __forceinline__ unsigned xb_xcc_id() { return (unsigned)__builtin_amdgcn_s_getreg((3 << 11) | 20) & 0xFu; }
#define XB_SPIN(cond, bar) do { unsigned _sp = 0; while (cond) { __builtin_amdgcn_s_sleep(1); \
    if ((++_sp & 255u) == 0u) { if (xb_ld(&(bar)[XB_TMO])) break; if (_sp > XB_SPIN_CAP) { atomicAdd(&(bar)[XB_TMO], 1u); break; } } } } while (0)
struct XcdBarrier { unsigned* bar; unsigned x; volatile LAS unsigned* st; };
__device__ __forceinline__ XcdBarrier xcd_barrier_post(unsigned* bar, volatile LAS unsigned* st) {
  XcdBarrier b; b.bar = bar; b.x = xb_xcc_id(); b.st = st;
  if (threadIdx.x == 0) (void)xb_add(&bar[XB_XCNT(b.x)], 1u);
  return b;
}
__device__ __forceinline__ void xcd_barrier_complete(unsigned* bar, unsigned x, unsigned& nloc, unsigned& nx) {
  const unsigned G = gridDim.x * gridDim.y * gridDim.z;
  unsigned sum, cnt, mine, sp = 0u;
  for (;;) {
    sum = 0u; cnt = 0u; mine = 0u;
#pragma unroll
    for (unsigned j = 0; j < 16; ++j) { const unsigned c = xb_ld(&bar[XB_XCNT(j)]); sum += c; cnt += (c > 0u) ? 1u : 0u; mine = (j == x) ? c : mine; }
    if (sum == G) break;
    __builtin_amdgcn_s_sleep(1);
    if ((++sp & 255u) == 0u) { if (xb_ld(&bar[XB_TMO])) break; if (sp > XB_SPIN_CAP) { atomicAdd(&bar[XB_TMO], 1u); break; } }
  }
  nloc = mine > 0u ? mine : 1u; nx = cnt > 0u ? cnt : 1u;
}
__device__ __forceinline__ void xcd_barrier1(const XcdBarrier& b);
__device__ __forceinline__ void xcd_barrier(const XcdBarrier& b) { xcd_barrier1(b); }
__device__ __forceinline__ void xcd_barrier1(const XcdBarrier& b0) {
  asm volatile("s_waitcnt vmcnt(0)" ::: "memory");
  __syncthreads();
  if (threadIdx.x == 0) {
    XcdBarrier b = b0;
    { unsigned long long a_ = (unsigned long long)b.bar; unsigned lo_ = (unsigned)a_, hi_ = (unsigned)(a_ >> 32), x_ = b.x, st_ = (unsigned)(size_t)b.st;
      asm volatile("" : "+s"(lo_), "+s"(hi_), "+s"(x_), "+s"(st_));
      b.bar = (unsigned*)(((unsigned long long)hi_ << 32) | lo_); b.x = x_; b.st = (volatile LAS unsigned*)(size_t)st_; }
    unsigned* bar = b.bar;
    __builtin_amdgcn_s_waitcnt(0);
    unsigned nloc = b.st[0], nx = b.st[1];
    if (nloc == 0u) { xcd_barrier_complete(bar, b.x, nloc, nx); b.st[0] = nloc; b.st[1] = nx; }
    const unsigned old = xb_add(&bar[XB_XSUB(b.x)], 1u);
    const unsigned gen = old / nloc;
    if (old + 1u == (gen + 1u) * nloc) {
      __builtin_amdgcn_fence(__ATOMIC_RELEASE, "agent");
      asm volatile("s_waitcnt vmcnt(0)" ::: "memory");
      const unsigned og = xb_add(&bar[XB_TOP], 1u);
      const unsigned tg = og / nx;
      if (og + 1u == (tg + 1u) * nx) xb_add(&bar[XB_TOPGEN], 1u);
      else XB_SPIN(xb_ld(&bar[XB_TOPGEN]) == tg, bar);
      __builtin_amdgcn_fence(__ATOMIC_ACQUIRE, "agent");
      xb_add(&bar[XB_XGEN(b.x)], 1u);
      asm volatile("s_waitcnt vmcnt(0)" ::: "memory");
    } else {
      XB_SPIN(xb_ld(&bar[XB_XGEN(b.x)]) == gen, bar);
      __builtin_amdgcn_fence(__ATOMIC_ACQUIRE, "agent");
      asm volatile("s_waitcnt vmcnt(0)" ::: "memory");
    }
  }
  __syncthreads();
}

namespace pg8 {
constexpr int BM = 256, BK = 64, HALF = 128, HTB = HALF * BK * 2, NXCD = 8, WGM = 8;
__device__ __forceinline__ int lds_byte(int r, int c) { const int st = (r >> 4) * 2 + (c >> 5), rr = r & 15, cc = c & 31, ob = rr * 64 + cc * 2; return st * 1024 + (ob ^ (((ob >> 9) & 1) << 5)); }
__device__ __forceinline__ void stage_rc(int b, int& R, int& C) { const int st = b / 1024, sb = b % 1024, swz = sb ^ (((sb >> 9) & 1) << 5); R = (st >> 1) * 16 + swz / 64; C = (st & 1) * 32 + (swz % 64) / 2; }
__device__ __forceinline__ int perm32(int rho) { const int n = rho >> 4, i = rho & 15; return 8 * (i >> 2) + 4 * n + (i & 3); }
struct Unit { const char* A; const char* B; int pm, pn, e, aux; };

template <class Epi, class Sched, int HOOK_T, bool GATHER = false>
__device__ __forceinline__ void gemm_phase(LAS unsigned char* lds, const int K, const Sched& S, const Epi& E) {
  const int tid = otid(), wid = __builtin_amdgcn_readfirstlane(tid >> 6), lane = tid & 63, wr = wid >> 2, wc = wid & 3, fr = lane & 15, fq = lane >> 4;
  const int nt = K / BK;
  unsigned voffA[2], voffB[2];
#pragma unroll
  for (int i = 0; i < 2; ++i) { int R, C; stage_rc(tid * 16 + i * 8192, R, C); const int Rb = Epi::PERM ? ((R & ~31) + perm32(R & 31)) : R;
    voffA[i] = (unsigned)(R * K + C) * 2u; voffB[i] = (unsigned)(Rb * K + C) * 2u; }
  const size_t kstep = (size_t)(BK * 2);
  const size_t hstep = (size_t)HALF * K * 2;
  int gR[2]; unsigned gC[2];
#pragma unroll
  for (int i = 0; i < 2; ++i) { int R, C; stage_rc(tid * 16 + i * 8192, R, C); gR[i] = R; gC[i] = (unsigned)C * 2u; }
  unsigned vC[2][2], vN[2][2], vX[2][2];
  const unsigned ldsw = (unsigned)wid * 1024u;
  const int aoff = lds_byte(wr * 64 + fr, fq * 8), boff = lds_byte(wc * 32 + fr, fq * 8);
#define PG8_SA(b, h) (((b) * 2 + (h)) * HTB)
#define PG8_SB(b, h) ((4 + (b) * 2 + (h)) * HTB)
#define PG8_STAGE(bufoff, gbase, voff) do { _Pragma("unroll") for (int _i = 0; _i < 2; ++_i) \
        __builtin_amdgcn_global_load_lds((const unsigned*)((const char*)(gbase) + (voff)[_i]), (LAS unsigned*)(lds + (bufoff) + ldsw + _i * 8192), 16, 0, 0); } while (0)
#define PG8_STAGE_A(bufoff, gbase, h, V) do { if constexpr (GATHER) { PG8_STAGE(bufoff, gbase, (V)[h]); } else { PG8_STAGE(bufoff, (gbase) + (h) * hstep, voffA); } } while (0)
#define PG8_GOFF(V, U) do { if constexpr (GATHER) { _Pragma("unroll") for (int _h = 0; _h < 2; ++_h) _Pragma("unroll") for (int _i = 0; _i < 2; ++_i) \
        (V)[_h][_i] = (unsigned)S.arow(U, gR[_i] + 128 * _h) * (unsigned)(K * 2) + gC[_i]; } } while (0)
#define PG8_LDA(dst, b, h) do { _Pragma("unroll") for (int m = 0; m < 4; ++m) _Pragma("unroll") for (int k = 0; k < 2; ++k) dst[m][k] = *(const LAS bf16x8*)(lds + PG8_SA(b, h) + aoff + m * 2048 + k * 1024); } while (0)
#define PG8_LDB(dst, b, h) do { _Pragma("unroll") for (int n = 0; n < 2; ++n) _Pragma("unroll") for (int k = 0; k < 2; ++k) dst[n][k] = *(const LAS bf16x8*)(lds + PG8_SB(b, h) + boff + n * 2048 + k * 1024); } while (0)
#define PG8_MMA(ai, bj, At, Bt) do { __builtin_amdgcn_s_setprio(1); _Pragma("unroll") for (int m = 0; m < 4; ++m) _Pragma("unroll") for (int n = 0; n < 2; ++n) _Pragma("unroll") for (int k = 0; k < 2; ++k) \
        acc[ai][bj][m][n] = __builtin_amdgcn_mfma_f32_16x16x32_bf16(Bt[n][k], At[m][k], acc[ai][bj][m][n], 0, 0, 0); __builtin_amdgcn_s_setprio(0); } while (0)
#define PG8_WAIT_V(n) asm volatile("s_waitcnt vmcnt(" #n ")" ::: "memory")
#define PG8_WAIT_L(n) asm volatile("s_waitcnt lgkmcnt(" #n ")" ::: "memory")
#define PG8_BAR __builtin_amdgcn_s_barrier()
#define PG8_SCHED __builtin_amdgcn_sched_barrier(0)
#define PG8_KBODY \
      const bool last = (t == nt - 2); \
      const char* a1 = cA + (size_t)(t + 1) * kstep; \
      const char* a2 = last ? nA : cA + (size_t)(t + 2) * kstep; const char* b2 = last ? nB : cB + (size_t)(t + 2) * kstep; \
      const char* a3 = a2 + kstep; const char* b3 = b2 + kstep; \
      if constexpr (GATHER) { _Pragma("unroll") for (int _h = 0; _h < 2; ++_h) _Pragma("unroll") for (int _i = 0; _i < 2; ++_i) vX[_h][_i] = last ? vN[_h][_i] : vC[_h][_i]; } \
      PG8_LDB(B0, 0, 0); PG8_LDB(B1, 0, 1); PG8_SCHED; PG8_LDA(At, 0, 0); PG8_STAGE_A(PG8_SA(1, 1), a1, 1, vC); \
      PG8_WAIT_V(8); PG8_WAIT_L(0); PG8_BAR; PG8_MMA(0, 0, At, B0); PG8_MMA(0, 1, At, B1); PG8_BAR; PG8_SCHED; \
      PG8_LDA(At, 0, 1); PG8_STAGE(PG8_SB(0, 0), b2, voffB); PG8_STAGE(PG8_SB(0, 1), b2 + hstep, voffB); PG8_STAGE_A(PG8_SA(0, 0), a2, 0, vX); \
      PG8_WAIT_V(8); PG8_WAIT_L(0); PG8_BAR; PG8_MMA(1, 0, At, B0); PG8_MMA(1, 1, At, B1); PG8_BAR; PG8_SCHED; \
      PG8_LDB(B0, 1, 0); PG8_LDB(B1, 1, 1); PG8_SCHED; PG8_LDA(At, 1, 0); PG8_STAGE_A(PG8_SA(0, 1), a2, 1, vX); \
      PG8_WAIT_V(8); PG8_WAIT_L(0); PG8_BAR; PG8_MMA(0, 0, At, B0); PG8_MMA(0, 1, At, B1); PG8_BAR; PG8_SCHED; \
      PG8_LDA(At, 1, 1); PG8_STAGE(PG8_SB(1, 0), b3, voffB); PG8_STAGE(PG8_SB(1, 1), b3 + hstep, voffB); PG8_STAGE_A(PG8_SA(1, 0), a3, 0, vX); \
      PG8_WAIT_V(8); PG8_WAIT_L(0); PG8_BAR; PG8_MMA(1, 0, At, B0); PG8_MMA(1, 1, At, B1); PG8_BAR; PG8_SCHED;
  Unit cur, nxt; int ui = 0;
  if (!S.next(0, cur)) return;
  f32x4 acc[2][2][4][2];
#pragma unroll
  for (int a = 0; a < 2; ++a)
#pragma unroll
    for (int b = 0; b < 2; ++b)
#pragma unroll
      for (int m = 0; m < 4; ++m)
#pragma unroll
        for (int n = 0; n < 2; ++n) acc[a][b][m][n] = (f32x4){0.f, 0.f, 0.f, 0.f};
  bf16x8 At[4][2], B0[2][2], B1[2][2];
  const char* cA = cur.A; const char* cB = cur.B;
  PG8_GOFF(vC, cur);
  PG8_STAGE(PG8_SB(0, 0), cB, voffB); PG8_STAGE(PG8_SB(0, 1), cB + hstep, voffB); PG8_STAGE_A(PG8_SA(0, 0), cA, 0, vC); PG8_STAGE_A(PG8_SA(0, 1), cA, 1, vC);
  if (wr == 1) PG8_BAR;
  PG8_WAIT_V(2); PG8_BAR;
  PG8_STAGE(PG8_SB(1, 0), cB + kstep, voffB); PG8_STAGE_A(PG8_SA(1, 0), cA + kstep, 0, vC); PG8_STAGE(PG8_SB(1, 1), cB + hstep + kstep, voffB);
  PG8_WAIT_V(6); PG8_BAR;
  for (;;) {
    const bool has_next = S.next(ui + 1, nxt);
    const char* nA = has_next ? nxt.A : cA; const char* nB = has_next ? nxt.B : cB;
    if constexpr (GATHER) { if (has_next) { PG8_GOFF(vN, nxt); } else { _Pragma("unroll") for (int _h = 0; _h < 2; ++_h) _Pragma("unroll") for (int _i = 0; _i < 2; ++_i) vN[_h][_i] = vC[_h][_i]; } }
    if constexpr (HOOK_T > 0) {
      for (int t = 0; t < HOOK_T; t += 2) { PG8_KBODY }
      E.hook(acc, cur, wr, wc, fr, fq);
      for (int t = HOOK_T; t < nt; t += 2) { PG8_KBODY }
    } else {
      for (int t = 0; t < nt; t += 2) { PG8_KBODY }
    }
    if (wr == 0) PG8_BAR;
    E(acc, cur, wr, wc, fr, fq);
    if (!has_next) break;
#pragma unroll
    for (int a = 0; a < 2; ++a)
#pragma unroll
      for (int b = 0; b < 2; ++b)
#pragma unroll
        for (int m = 0; m < 4; ++m)
#pragma unroll
          for (int n = 0; n < 2; ++n) acc[a][b][m][n] = (f32x4){0.f, 0.f, 0.f, 0.f};
    cur = nxt; cA = nA; cB = nB; ++ui;
    if constexpr (GATHER) { _Pragma("unroll") for (int _h = 0; _h < 2; ++_h) _Pragma("unroll") for (int _i = 0; _i < 2; ++_i) vC[_h][_i] = vN[_h][_i]; }
    if (wr == 1) PG8_BAR;
  }
  PG8_WAIT_V(0);
  PG8_BAR;
#undef PG8_SA
#undef PG8_SB
#undef PG8_STAGE
#undef PG8_STAGE_A
#undef PG8_GOFF
#undef PG8_LDA
#undef PG8_LDB
#undef PG8_MMA
#undef PG8_WAIT_V
#undef PG8_WAIT_L
#undef PG8_BAR
#undef PG8_SCHED
#undef PG8_KBODY
}

struct DenseSched {
  __device__ __forceinline__ int arow(const Unit&, int) const { return 0; }
  int nM, nN, nwg, G, c; const char* A; const char* B; size_t tstep;
  __device__ __forceinline__ void init(int nM_, int nN_, int G_, int c_, const void* A_, const void* B_, int K) { nM = nM_; nN = nN_; nwg = nM * nN; G = G_; c = c_; A = (const char*)A_; B = (const char*)B_; tstep = (size_t)BM * K * 2; }
  __device__ __forceinline__ bool next(int i, Unit& u) const {
    const long L = (long)i * G + c; if (L >= nwg) return false;
    int wgid = (int)L; { const int q = nwg / NXCD, r = nwg % NXCD, xcd = wgid % NXCD, off = wgid / NXCD; wgid = (xcd < r ? xcd * (q + 1) : r * (q + 1) + (xcd - r) * q) + off; }
    const int nig = WGM * nN, gid = wgid / nig, fm = gid * WGM, gsz = (nM - fm) < WGM ? (nM - fm) : WGM;
    u.pm = fm + ((wgid % nig) % gsz); u.pn = (wgid % nig) / gsz; u.e = 0; u.aux = 0;
    u.A = A + (size_t)u.pm * tstep; u.B = B + (size_t)u.pn * tstep; return true;
  }
};
struct SingleSched {
  Unit u0;
  __device__ __forceinline__ int arow(const Unit&, int) const { return 0; }
  __device__ __forceinline__ bool next(int i, Unit& u) const { if (i != 0) return false; u = u0; return true; }
};
struct MoeSched {
  int U, nN, G, c; const char* A; const char* B; size_t tstep, estep; volatile LAS int* tab; const int* list; bool gather;
  __device__ __forceinline__ int arow(const Unit& u, int r) const { const int rl = u.aux * 256 + r; return (rl < tab[96 + u.e]) ? (list[(size_t)u.e * NT + rl] >> 1) : 0; }
  __device__ __forceinline__ bool next(int i, Unit& u) const {
    const long L = (long)i * G + c; if (L >= U) return false;
    int w = (int)L; { const int q = U / NXCD, r = U % NXCD, xcd = w % NXCD, off = w / NXCD; w = (xcd < r ? xcd * (q + 1) : r * (q + 1) + (xcd - r) * q) + off; }
    int e = 0;
#pragma unroll 1
    for (int k = 1; k < 16; ++k) e += (w >= tab[k]) ? 1 : 0;
    const int local = w - tab[e], mt = tab[32 + e], tb = tab[64 + e];
    const int pn = local / mt, pml = local - pn * mt;
    u.e = __builtin_amdgcn_readfirstlane(e); u.aux = __builtin_amdgcn_readfirstlane(pml);
    u.pm = __builtin_amdgcn_readfirstlane(tb + pml); u.pn = __builtin_amdgcn_readfirstlane(pn);
    u.A = gather ? A : A + (size_t)u.pm * tstep; u.B = B + (size_t)u.e * estep + (size_t)u.pn * tstep; return true;
  }
};
}
using pg8::Unit;
typedef f32x4 AccT[2][2][4][2];

struct EpiProj {
  static constexpr bool PERM = true;
  bf16_t* O; float* lr32;
  __device__ __forceinline__ void operator()(const AccT& acc, const Unit& u, int wr, int wc, int fr, int fq) const {
    const int row0 = u.pm * 256 + wr * 64 + fr, col0 = u.pn * 256 + wc * 32 + 8 * fq;
    const bool lrt = (u.pn == 12) && (wc == 0);
#pragma unroll
    for (int ai = 0; ai < 2; ++ai)
#pragma unroll
      for (int m = 0; m < 4; ++m) {
        const int row = row0 + ai * 128 + m * 16;
        bf16_t* rowp = O + (size_t)row * PSTR + col0;
#pragma unroll
        for (int bj = 0; bj < 2; ++bj) {
          const f32x4 v0 = acc[ai][bj][m][0], v1 = acc[ai][bj][m][1];
          u32x4 w; w.x = pk2(v0[0], v0[1]); w.y = pk2(v0[2], v0[3]); w.z = pk2(v1[0], v1[1]); w.w = pk2(v1[2], v1[3]);
          *(u32x4*)(rowp + bj * 128) = w;
          if (bj == 0 && lrt) { float* lp = lr32 + (size_t)row * 32 + 8 * fq; *(f32x4*)lp = v0; *(f32x4*)(lp + 4) = v1; }
        }
      }
  }
  __device__ __forceinline__ void hook(AccT&, const Unit&, int, int, int, int) const {}
};
struct EpiMerge {
  static constexpr bool PERM = true;
  const bf16_t* proj; bf16_t* O;
  __device__ __forceinline__ void hook(AccT& acc, const Unit& u, int wr, int wc, int fr, int fq) const {
    const int row0 = u.pm * 256 + wr * 64 + fr, col0 = u.pn * 256 + wc * 32 + 8 * fq;
#pragma unroll
    for (int ai = 0; ai < 2; ++ai) {
      u32x4 g0[4][2], g1[4][2];
#pragma unroll
      for (int m = 0; m < 4; ++m) {
        const bf16_t* gp = proj + (size_t)(row0 + ai * 128 + m * 16) * PSTR + col0;
#pragma unroll
        for (int bj = 0; bj < 2; ++bj) { g0[m][bj] = *(const u32x4*)(gp + 4640 + bj * 128); g1[m][bj] = *(const u32x4*)(gp + 5664 + bj * 128); }
      }
#pragma unroll
      for (int m = 0; m < 4; ++m)
#pragma unroll
        for (int bj = 0; bj < 2; ++bj)
#pragma unroll
          for (int q = 0; q < 4; ++q) {
            const float a0 = bflo(g0[m][bj][q]), a1 = bfhi(g0[m][bj][q]), b0 = bflo(g1[m][bj][q]), b1 = bfhi(g1[m][bj][q]);
            const float r0 = (1.f + __expf(-b0)) * __builtin_amdgcn_rcpf(1.f + __expf(-a0)), r1 = (1.f + __expf(-b1)) * __builtin_amdgcn_rcpf(1.f + __expf(-a1));
            acc[ai][bj][m][q >> 1][(q & 1) * 2] *= r0; acc[ai][bj][m][q >> 1][(q & 1) * 2 + 1] *= r1;
          }
      __builtin_amdgcn_sched_barrier(0);
    }
  }
  __device__ __forceinline__ void operator()(const AccT& acc, const Unit& u, int wr, int wc, int fr, int fq) const {
    int row0 = u.pm * 256 + wr * 64 + fr; const int col0 = u.pn * 256 + wc * 32 + 8 * fq;
    asm volatile("" : "+v"(row0));
#pragma unroll
    for (int ai = 0; ai < 2; ++ai)
#pragma unroll
      for (int m = 0; m < 4; ++m) {
        const int row = row0 + ai * 128 + m * 16;
        const bf16_t* gp = proj + (size_t)row * PSTR + col0 + 5664;
        bf16_t* op = O + (size_t)row * 1024 + col0;
#pragma unroll
        for (int bj = 0; bj < 2; ++bj) {
          const u32x4 g1 = *(const u32x4*)(gp + bj * 128);
          float o[8];
#pragma unroll
          for (int q = 0; q < 4; ++q) {
            o[2 * q] = acc[ai][bj][m][q >> 1][(q & 1) * 2] * sigmoidf_(bflo(g1[q]));
            o[2 * q + 1] = acc[ai][bj][m][q >> 1][(q & 1) * 2 + 1] * sigmoidf_(bfhi(g1[q]));
          }
          u32x4 w; w.x = pk2(o[0], o[1]); w.y = pk2(o[2], o[3]); w.z = pk2(o[4], o[5]); w.w = pk2(o[6], o[7]);
          *(u32x4*)(op + bj * 128) = w;
        }
      }
  }
};
struct EpiOut {
  static constexpr bool PERM = true;
  bf16_t* Y;
  __device__ __forceinline__ void operator()(const AccT& acc, const Unit& u, int wr, int wc, int fr, int fq) const {
    const int row0 = u.pm * 256 + wr * 64 + fr, col0 = u.pn * 256 + wc * 32 + 8 * fq;
#pragma unroll
    for (int ai = 0; ai < 2; ++ai)
#pragma unroll
      for (int m = 0; m < 4; ++m) {
        bf16_t* yp = Y + (size_t)(row0 + ai * 128 + m * 16) * 1024 + col0;
#pragma unroll
        for (int bj = 0; bj < 2; ++bj) {
          const f32x4 v0 = acc[ai][bj][m][0], v1 = acc[ai][bj][m][1];
          u32x4 w; w.x = pk2(v0[0], v0[1]); w.y = pk2(v0[2], v0[3]); w.z = pk2(v1[0], v1[1]); w.w = pk2(v1[2], v1[3]);
          *(u32x4*)(yp + bj * 128) = w;
        }
      }
  }
  __device__ __forceinline__ void hook(AccT&, const Unit&, int, int, int, int) const {}
};
struct EpiMoe1 {
  static constexpr bool PERM = true;
  bf16_t* hid;
  __device__ __forceinline__ void operator()(const AccT& acc, const Unit& u, int wr, int wc, int fr, int fq) const {
    const int row0 = u.pm * 256 + wr * 64 + fr, hc0 = u.pn * 128 + wc * 16 + 4 * fq;
#pragma unroll
    for (int ai = 0; ai < 2; ++ai)
#pragma unroll
      for (int m = 0; m < 4; ++m) {
        bf16_t* hp = hid + (size_t)(row0 + ai * 128 + m * 16) * 1024 + hc0;
#pragma unroll
        for (int bj = 0; bj < 2; ++bj) {
          const f32x4 a = acc[ai][bj][m][0], b = acc[ai][bj][m][1];
          u32x2 w; w.x = pk2(siluf_(a[0]) * b[0], siluf_(a[1]) * b[1]); w.y = pk2(siluf_(a[2]) * b[2], siluf_(a[3]) * b[3]);
          *(u32x2*)(hp + bj * 64) = w;
        }
      }
  }
  __device__ __forceinline__ void hook(AccT&, const Unit&, int, int, int, int) const {}
};
struct EpiMoe2 {
  static constexpr bool PERM = true;
  bf16_t* yb; const int* list; const float* topw; volatile LAS int* tab;
  __device__ __forceinline__ void operator()(const AccT& acc, const Unit& u, int wr, int wc, int fr, int fq) const {
    const int rl0 = u.aux * 256 + wr * 64 + fr, col0 = u.pn * 256 + wc * 32 + 8 * fq;
    const int cnt = tab[96 + u.e];
    const int* lst = list + (size_t)u.e * NT;
#pragma unroll
    for (int ai = 0; ai < 2; ++ai)
#pragma unroll
      for (int m = 0; m < 4; ++m) {
        const int rl = rl0 + ai * 128 + m * 16;
        if (rl < cnt) {
          const int pr = lst[rl];
          const float tw = topw[pr];
          bf16_t* op = yb + (size_t)pr * 1024 + col0;
#pragma unroll
          for (int bj = 0; bj < 2; ++bj) {
            const f32x4 v0 = acc[ai][bj][m][0] * tw, v1 = acc[ai][bj][m][1] * tw;
            u32x4 w; w.x = pk2(v0[0], v0[1]); w.y = pk2(v0[2], v0[3]); w.z = pk2(v1[0], v1[1]); w.w = pk2(v1[2], v1[3]);
            *(u32x4*)(op + bj * 128) = w;
          }
        }
      }
  }
  __device__ __forceinline__ void hook(AccT&, const Unit&, int, int, int, int) const {}
};

template <int MODE>
__device__ __forceinline__ void transpose_item(const float* W, int ldw, bf16_t* WT, int ldt, int koff, LAS float* scr, int kb, int nb, int lane) {
  const int k0 = 64 * kb, n0 = 32 * nb;
  {
    const int n4 = (lane & 7) * 4;
    f32x4 v[8];
#pragma unroll
    for (int i = 0; i < 8; ++i) v[i] = *(const f32x4*)(W + (size_t)(k0 + 8 * i + (lane >> 3)) * ldw + n0 + n4);
#pragma unroll
    for (int i = 0; i < 8; ++i) { LAS float* d = scr + (8 * i + (lane >> 3)) * 33 + n4; d[0] = v[i][0]; d[1] = v[i][1]; d[2] = v[i][2]; d[3] = v[i][3]; }
  }
  asm volatile("s_waitcnt lgkmcnt(0)" ::: "memory");
  const int c = lane & 7;
#pragma unroll
  for (int j = 0; j < 4; ++j) {
    const int n = (lane >> 3) + 8 * j; const LAS float* s = scr + (8 * c) * 33 + n;
    u32x4 o; o.x = pk2(s[0 * 33], s[1 * 33]); o.y = pk2(s[2 * 33], s[3 * 33]); o.z = pk2(s[4 * 33], s[5 * 33]); o.w = pk2(s[6 * 33], s[7 * 33]);
    const int ng = n0 + n;
    const int dr = (MODE == 0) ? ng : ((ng >> 2) * 8 + (ng & 3) + (MODE == 2 ? 4 : 0));
    *(u32x4*)(WT + (size_t)dr * ldt + koff + k0 + 8 * c) = o;
  }
  asm volatile("s_waitcnt lgkmcnt(0)" ::: "memory");
}

__device__ void ph_init(const Params& p, LAS unsigned char* lds, int bid, int nb) {
  WS_LOCAL
  const int tid = otid(), wave = tid >> 6, lane = tid & 63;
  LAS float* sc = (LAS float*)(lds + 8 * 8448);
  for (int i = tid; i < 3 * 1024; i += NTHR) {
    int r = i >> 10, k = i & 1023;
    float v = (r < 2) ? KARG(const float, 1)[r * 1024 + k] : KARG(const float, 3)[k];
    sc[i] = v / (1.f + expf(-v));
  }
  __syncthreads();
  LAS float* scr = (LAS float*)(lds + wave * 8448);
  const int gw = bid * NWAVES + wave, NGW = nb * NWAVES;
  constexpr int I_ADA = 2 * 24 * 32, I_IN = 16 * 209, I_MG = 16 * 32, I_MN = 8 * 32, I_O = 16 * 32, I_PAD = 224, I_ROPE = 64;
  constexpr int NITEMS = I_ADA + 2 * (I_IN + I_MG + I_MN + I_O + I_PAD) + I_ROPE;
  for (int it = gw; it < NITEMS; it += NGW) {
    int r = it;
    if (r < I_ADA) {
      const int l = r / 768, cb = (r % 768) >> 5, ks = r & 31, col0 = cb * 256 + lane * 4;
      const float* w = KARG(const float, 4) + ((size_t)l * 1024 + ks * 32) * 6144 + col0;
      f32x4 wv[32];
#pragma unroll
      for (int i = 0; i < 32; ++i) wv[i] = __builtin_nontemporal_load((const f32x4*)(w + (size_t)i * 6144));
      f32x4 a0 = {0.f, 0.f, 0.f, 0.f}, a1 = a0, a2 = a0;
#pragma unroll
      for (int i = 0; i < 32; ++i) { const int k = ks * 32 + i; a0 += sc[k] * wv[i]; a1 += sc[1024 + k] * wv[i]; a2 += sc[2048 + k] * wv[i]; }
      float* part = WSP(float, WS_APART) + ((size_t)(l * 32 + ks) * 3) * 6144 + col0;
      *(f32x4*)(part) = a0; *(f32x4*)(part + 6144) = a1; *(f32x4*)(part + 2 * 6144) = a2;
      continue;
    }
    r -= I_ADA;
    if (r < I_ROPE) {
      const int idx = r * 64 + lane, pos = idx >> 5, i = idx & 31;
      const float inv = exp2f(-(float)i * (13.287712379549449f / 32.f)), ang = (float)pos * inv;
      const float kk = rintf(ang * 0.15915494309189535f);
      float rr = fmaf(-kk, 6.2831854820251465f, ang); rr = fmaf(-kk, -1.7484556000744883e-07f, rr);
      WSP(float, WS_ROPE)[idx * 2] = cosf(rr); WSP(float, WS_ROPE)[idx * 2 + 1] = sinf(rr);
      continue;
    }
    r -= I_ROPE;
    const int per = I_IN + I_MG + I_MN + I_O + I_PAD;
    const int l = r / per; r -= l * per;
    if (r < I_IN) { transpose_item<0>(KARG(const float, 8) + (size_t)l * 1024 * INC, INC, WSP(bf16_t, WS_WINT) + (size_t)l * PSTR * 1024, 1024, 0, scr, r / 209, r % 209, lane); continue; } r -= I_IN;
    if (r < I_MG) { transpose_item<0>(KARG(const float, 13) + (size_t)l * 1024 * 1024, 1024, WSP(bf16_t, WS_WMT) + (size_t)l * 1024 * GSTR, GSTR, 0, scr, r / 32, r % 32, lane); continue; } r -= I_MG;
    if (r < I_MN) { transpose_item<0>(KARG(const float, 14) + (size_t)l * 512 * 1024, 1024, WSP(bf16_t, WS_WMT) + (size_t)l * 1024 * GSTR, GSTR, 1024, scr, r / 32, r % 32, lane); continue; } r -= I_MN;
    if (r < I_O) { transpose_item<0>(KARG(const float, 15) + (size_t)l * 1024 * 1024, 1024, WSP(bf16_t, WS_WOT) + (size_t)l * 1024 * 1024, 1024, 0, scr, r / 32, r % 32, lane); continue; } r -= I_O;
    {
      unsigned zz = 0u; asm volatile("" : "+v"(zz));
      u32x4 z = {zz, zz, zz, zz};
      u32x4* dst = (u32x4*)(WSP(bf16_t, WS_WINT) + (size_t)l * PSTR * 1024 + (size_t)(INC + r) * 1024);
      dst[lane] = z; dst[lane + 64] = z;
    }
  }
}
__device__ void ph_ada_reduce(const Params& p, int bid, int nb) {
  WS_LOCAL
  const int tid = otid(), wave = tid >> 6, lane = tid & 63;
  for (int it = bid * NWAVES + wave; it < 48; it += nb * NWAVES) {
    const int l = it / 24, cb = it % 24, col0 = cb * 256 + lane * 4;
    const float* pb = WSP(float, WS_APART) + ((size_t)(l * 32) * 3) * 6144 + col0;
    const f32x4 bb = *(const f32x4*)(KARG(const float, 5) + l * 6144 + col0);
#pragma unroll
    for (int rr = 0; rr < 3; ++rr) {
      f32x4 sum = bb;
#pragma unroll
      for (int k8 = 0; k8 < 32; ++k8) sum += *(const f32x4*)(pb + ((size_t)k8 * 3 + rr) * 6144);
      *(f32x4*)(WSP(float, WS_MOD) + (l * 3 + rr) * 6144 + col0) = sum;
    }
  }
}
__device__ void ph_experts(const Params& p, int l, LAS unsigned char* lds, int bid, int nb) {
  WS_LOCAL
  const int tid = otid(), wave = tid >> 6, lane = tid & 63;
  LAS float* scr = (LAS float*)(lds + wave * 8448);
  const int skipb = (l == 0) ? 16 : 0;
  if (bid < skipb) return;
  const int gw = (bid - skipb) * NWAVES + wave, NGW = (nb - skipb) * NWAVES;
  for (int it = gw; it < 16 * 3 * 512; it += NGW) {
    const int e = it / 1536, r = it % 1536, mat = r / 512, q = r % 512;
    const size_t eo = ((size_t)(l * 16 + e)) << 20;
    if (mat == 0) transpose_item<1>(KARG(const float, 18) + eo, 1024, WSP(bf16_t, WS_RG) + ((size_t)e << 21), 1024, 0, scr, q / 32, q % 32, lane);
    else if (mat == 1) transpose_item<2>(KARG(const float, 19) + eo, 1024, WSP(bf16_t, WS_RG) + ((size_t)e << 21), 1024, 0, scr, q / 32, q % 32, lane);
    else transpose_item<0>(KARG(const float, 20) + eo, 1024, WSP(bf16_t, WS_RG + (size_t)16 * 2048 * 1024 * 2) + ((size_t)e << 20), 1024, 0, scr, q / 32, q % 32, lane);
  }
}

__device__ void ph_norm1(const Params& p, int l, int bid, int nb) {
  WS_LOCAL
  const int tid = otid(), wave = tid >> 6, lane = tid & 63;
  const int NGW = nb * NWAVES;
  for (int rowa = bid * NWAVES + wave; rowa < NT; rowa += 2 * NGW) {
    f32x4 v[2][4];
    int rows[2]; rows[0] = rowa; rows[1] = rowa + NGW;
    const bool has2 = rows[1] < NT;
    if (!has2) rows[1] = rowa;
#pragma unroll
    for (int u = 0; u < 2; ++u) {
      const int row = rows[u];
      if (l == 0) {
        const float* src = (row < NL) ? KARG(const float, 0) + (size_t)row * 1024 : KARG(const float, 2) + (size_t)(row - NL) * 1024;
#pragma unroll
        for (int i = 0; i < 4; ++i) v[u][i] = __builtin_nontemporal_load((const f32x4*)(src + i * 256 + lane * 4));
      } else {
        const int r = (row < NL) ? (row >> 13) : 2;
        const float* src = WSP(float, WS_XBUF) + (size_t)row * 1024;
        const float* m5 = WSP(float, WS_MOD) + (0 * 3 + r) * 6144 + 5 * 1024;
        const bf16_t* y0 = WSP(bf16_t, WS_PROJ + 2 * PROWS * 2048) + (size_t)(row * 2) * 1024;
#pragma unroll
        for (int i = 0; i < 4; ++i) {
          const int j = i * 256 + lane * 4;
          v[u][i] = *(const f32x4*)(src + j);
          const u32x2 ya = __builtin_nontemporal_load((const u32x2*)(y0 + j)), yb = __builtin_nontemporal_load((const u32x2*)(y0 + 1024 + j));
          const f32x4 g = *(const f32x4*)(m5 + j);
          v[u][i][0] += g[0] * (bflo(ya.x) + bflo(yb.x)); v[u][i][1] += g[1] * (bfhi(ya.x) + bfhi(yb.x));
          v[u][i][2] += g[2] * (bflo(ya.y) + bflo(yb.y)); v[u][i][3] += g[3] * (bfhi(ya.y) + bfhi(yb.y));
        }
      }
    }
#pragma unroll
    for (int u = 0; u < 2; ++u) {
      if (u == 1 && !has2) break;
      const int row = rows[u];
      const int r = (row < NL) ? (row >> 13) : 2;
      float ss = 0.f;
#pragma unroll
      for (int i = 0; i < 4; ++i) ss += v[u][i][0] * v[u][i][0] + v[u][i][1] * v[u][i][1] + v[u][i][2] * v[u][i][2] + v[u][i][3] * v[u][i][3];
      ss = wave_sum(ss);
      const float rstd = rsqrtf(ss * (1.f / 1024.f) + 1e-6f);
      const float* md = WSP(float, WS_MOD) + (l * 3 + r) * 6144;
      const float* nw = KARG(const float, 6) + l * 1024;
#pragma unroll
      for (int i = 0; i < 4; ++i) {
        const int j = i * 256 + lane * 4;
        const f32x4 w = *(const f32x4*)(nw + j), m1 = *(const f32x4*)(md + 1024 + j), m0 = *(const f32x4*)(md + j);
        f32x4 h;
#pragma unroll
        for (int q = 0; q < 4; ++q) h[q] = v[u][i][q] * rstd * w[q] * (1.f + m1[q]) + m0[q];
        u32x2 o; o.x = pk2(h[0], h[1]); o.y = pk2(h[2], h[3]);
        *(u32x2*)(WSP(bf16_t, WS_HM) + (size_t)row * 1024 + j) = o;
        if (l != 0) *(f32x4*)(WSP(float, WS_XBUF) + (size_t)row * 1024 + j) = v[u][i];
      }
    }
  }
}

typedef short s16x4 __attribute__((ext_vector_type(4)));
__device__ __forceinline__ s16x4 ds_tr(const LAS unsigned char* p) { return __builtin_amdgcn_ds_read_tr16_b64_v4i16((LAS s16x4*)p); }
#define NA_RS 144
#define NAU 4
__device__ void na_wave_task(const Params& p, int l, LAS unsigned char* vlb, LAS unsigned char* vl, int task, int lane) {
  WS_LOCAL
  const int fr = lane & 15, g = lane >> 4, q4 = fr >> 2, p4 = fr & 3;
  constexpr int NLAT = 2 * (128 / NAU) * 4 * 8;
  int b, h, nloc, jg = 0, cb = 0, rbase = 0, rmin = 0;
  int qrow[NAU], ru[NAU], r0u[NAU];
  if (task < NLAT) {
    h = task & 7; jg = (task >> 3) & 3; const int rg = (task >> 5) % (128 / NAU); b = task / (32 * (128 / NAU));
    rbase = rg * NAU; cb = (jg == 0) ? 0 : (jg == 1) ? 8 : (jg == 2) ? 24 : 32;
#pragma unroll
    for (int u = 0; u < NAU; ++u) { ru[u] = rbase + u; r0u[u] = min(max(ru[u] - 4, 0), 120); qrow[u] = b * 8192 + ru[u] * 64 + 16 * jg; }
    rmin = r0u[0]; nloc = r0u[NAU - 1] + 8 - rmin;
  } else {
    const int t2 = task - NLAT; h = t2 & 7; const int qg = (t2 >> 3) % (16 / NAU); b = t2 / (8 * (16 / NAU));
#pragma unroll
    for (int u = 0; u < NAU; ++u) { ru[u] = 0; r0u[u] = 0; qrow[u] = NL + b * 256 + (qg * NAU + u) * 16; }
    nloc = 0;
  }
  const bf16_t* pj = WSP(bf16_t, WS_PROJ);
  bf16x8 qf[NAU][2];
#pragma unroll
  for (int u = 0; u < NAU; ++u)
#pragma unroll
    for (int ks = 0; ks < 2; ++ks) qf[u][ks] = *(const bf16x8*)(pj + (size_t)(qrow[u] + fr) * PSTR + 3104 + h * 64 + 32 * ks + 8 * g);
  const LAS float* rp = (const LAS float*)(vlb + 40960) + h * 465;
  const int cq = 16 * jg + fr, c0 = min(max(cq - 8, 0), 48);
  f32x4 oacc[NAU][4];
#pragma unroll
  for (int u = 0; u < NAU; ++u)
#pragma unroll
    for (int c = 0; c < 4; ++c) oacc[u][c] = (f32x4){0.f, 0.f, 0.f, 0.f};
  float mrun[NAU], lsum[NAU];
#pragma unroll
  for (int u = 0; u < NAU; ++u) { mrun[u] = -1e30f; lsum[u] = 0.f; }
  const int nst = nloc + 8;
#pragma unroll 1
  for (int st = 0; st < nst; ++st) {
    const bool loc = st < nloc;
    const int kr = rmin + st;
    const int kbase = loc ? (b * 8192 + kr * 64 + cb) : (NL + b * 256 + (st - nloc) * 32);
    bf16x8 kf[2][2]; u32x4 vv[4];
#pragma unroll
    for (int tb = 0; tb < 2; ++tb)
#pragma unroll
      for (int ks = 0; ks < 2; ++ks) kf[tb][ks] = *(const bf16x8*)(pj + (size_t)(kbase + 16 * tb + fr) * PSTR + 3616 + h * 64 + 32 * ks + 8 * g);
#pragma unroll
    for (int i = 0; i < 4; ++i) { const int ci = lane + 64 * i, key = ci >> 3, dch = ci & 7; vv[i] = *(const u32x4*)(pj + (size_t)(kbase + key) * PSTR + 4128 + h * 64 + dch * 8); }
    bool okc[8]; int cix[8];
#pragma unroll
    for (int k = 0; k < 8; ++k) { const int kc = cb + 16 * (k >> 2) + 4 * g + (k & 3); okc[k] = (kc >= c0) && (kc < c0 + 16); cix[k] = min(max(kc - cq + 15, 0), 30); }
#pragma unroll
    for (int i = 0; i < 4; ++i) { const int ci = lane + 64 * i, key = ci >> 3, dch = ci & 7; *(LAS u32x4*)(vl + key * NA_RS + dch * 16) = vv[i]; }
    bf16x8 pf[NAU];
#pragma unroll
    for (int u = 0; u < NAU; ++u) {
      f32x4 sc[2];
#pragma unroll
      for (int tb = 0; tb < 2; ++tb) {
        sc[tb] = __builtin_amdgcn_mfma_f32_16x16x32_bf16(kf[tb][0], qf[u][0], (f32x4){0.f, 0.f, 0.f, 0.f}, 0, 0, 0);
        sc[tb] = __builtin_amdgcn_mfma_f32_16x16x32_bf16(kf[tb][1], qf[u][1], sc[tb], 0, 0, 0);
      }
      float sv[8]; float mst = -1e30f;
      if (loc) {
        const bool rowok = (kr >= r0u[u]) && (kr < r0u[u] + 8);
        const LAS float* rrow = rp + min(max(kr - ru[u] + 7, 0), 14) * 31;
        float bias[8];
#pragma unroll
        for (int k = 0; k < 8; ++k) bias[k] = rrow[cix[k]];
        asm volatile("" : "+v"(bias[0]), "+v"(bias[1]), "+v"(bias[2]), "+v"(bias[3]), "+v"(bias[4]), "+v"(bias[5]), "+v"(bias[6]), "+v"(bias[7]));
#pragma unroll
        for (int k = 0; k < 8; ++k) { const float v = (okc[k] && rowok) ? sc[k >> 2][k & 3] * 0.125f + bias[k] : -INFINITY; sv[k] = v; mst = fmaxf(mst, v); }
      } else {
#pragma unroll
        for (int k = 0; k < 8; ++k) { const float v = sc[k >> 2][k & 3] * 0.125f; sv[k] = v; mst = fmaxf(mst, v); }
      }
      mst = fmaxf(mst, __shfl_xor(mst, 16, 64)); mst = fmaxf(mst, __shfl_xor(mst, 32, 64));
      const float mnew = fmaxf(mrun[u], mst); const float alpha = __expf(mrun[u] - mnew); mrun[u] = mnew;
      float ps = 0.f; float pv[8];
#pragma unroll
      for (int k = 0; k < 8; ++k) { const float e = __expf(sv[k] - mnew); pv[k] = e; ps += e; }
      lsum[u] = lsum[u] * alpha + ps;
#pragma unroll
      for (int c = 0; c < 4; ++c) oacc[u][c] *= alpha;
#pragma unroll
      for (int q = 0; q < 4; ++q) { const unsigned w = pk2(pv[2 * q], pv[2 * q + 1]); pf[u][2 * q] = (short)(w & 0xffffu); pf[u][2 * q + 1] = (short)(w >> 16); }
    }
    asm volatile("s_waitcnt lgkmcnt(0)" ::: "memory");
#pragma unroll
    for (int c = 0; c < 4; ++c) {
      const s16x4 lo = ds_tr(vl + (4 * g + q4) * NA_RS + (16 * c + 4 * p4) * 2);
      const s16x4 hi = ds_tr(vl + (16 + 4 * g + q4) * NA_RS + (16 * c + 4 * p4) * 2);
      bf16x8 vf; vf[0] = lo[0]; vf[1] = lo[1]; vf[2] = lo[2]; vf[3] = lo[3]; vf[4] = hi[0]; vf[5] = hi[1]; vf[6] = hi[2]; vf[7] = hi[3];
#pragma unroll
      for (int u = 0; u < NAU; ++u) oacc[u][c] = __builtin_amdgcn_mfma_f32_16x16x32_bf16(vf, pf[u], oacc[u][c], 0, 0, 0);
    }
    asm volatile("s_waitcnt lgkmcnt(0)" ::: "memory");
  }
#pragma unroll
  for (int u = 0; u < NAU; ++u) {
    float ls = lsum[u];
    ls += __shfl_xor(ls, 16, 64); ls += __shfl_xor(ls, 32, 64);
    const float inv = 1.f / ls;
    bf16_t* op = WSP(bf16_t, WS_GM) + (size_t)(qrow[u] + fr) * GSTR + 1024 + h * 64 + 4 * g;
#pragma unroll
    for (int c = 0; c < 4; ++c) {
      u32x2 w; w.x = pk2(oacc[u][c][0] * inv, oacc[u][c][1] * inv); w.y = pk2(oacc[u][c][2] * inv, oacc[u][c][3] * inv);
      *(u32x2*)(op + 16 * c) = w;
    }
  }
}
__device__ void na_phase(const Params& p, int l, LAS unsigned char* lds, int bid, int nb, int mode) {
  WS_LOCAL
  const int tid = otid(), wave = tid >> 6, lane = tid & 63;
  LAS unsigned char* vlb = lds + 4096;
  LAS unsigned char* vl = vlb + wave * 4608;
  constexpr int NLAT = 2 * (128 / NAU) * 4 * 8, NCTX = 2 * (16 / NAU) * 8;
  int t0, t1, ts;
  if (mode == 0) {
    LAS float* rl = (LAS float*)(vlb + 40960);
    const float* rg = KARG(const float, 12) + (size_t)l * 8 * 465;
    for (int k = tid; k < 8 * 465; k += NTHR) rl[k] = rg[k];
    t0 = bid * NWAVES + wave; t1 = NLAT; ts = nb * NWAVES;
  } else {
    const bool on = (l == 0) && (bid >= 32) && (bid < 32 + NCTX / NWAVES);
    t0 = NLAT + (bid - 32) * NWAVES + wave; t1 = on ? NLAT + NCTX : 0; ts = NLAT + NCTX;
  }
  __syncthreads();
  for (int t = t0; t < t1; t += ts) na_wave_task(p, l, vlb, vl, t, lane);
  __syncthreads();
}
#define G_LRS 0
#define G_TOT 8192
#define G_RED 10240
#define G_VT 12288
#define G_KT 46080
#define G_QB 63488
#define G_QE 80896
#define G_ATT 98304
#define G_RK 107520
#define G_RQ (MISC_OFF + 2048)
#define VRS 528
#define KRS 272
#define ARS 144
__device__ __forceinline__ void gla_load_w(const Params& p, int l, int hd, int tid, float (&w)[2][17]) {
  WS_LOCAL
  const int d = tid & 127;
#pragma unroll
  for (int dir = 0; dir < 2; ++dir) {
#pragma unroll
    for (int r = 0; r < 16; ++r) w[dir][r] = KARG(const float, 9)[((size_t)(l * 2 + dir) * 16 + r) * 512 + hd * 128 + d];
    w[dir][16] = KARG(const float, 10)[(l * 2 + dir) * 512 + hd * 128 + d];
  }
}
template <bool FULL>
__device__ __forceinline__ void gla_prep(const Params& p, int l, LAS unsigned char* lds, int hd, int dir, int tid, const float (&w)[17], float* dbout, int kt_off, int tot_off) {
  WS_LOCAL
  const int d = tid & 127, sq = tid >> 7;
  LAS float* lrs = (LAS float*)(lds + G_LRS); LAS float* tot = (LAS float*)(lds + tot_off);
  const float bgk = w[16];
  float pre[16];
#pragma unroll
  for (int i = 0; i < 16; i += 2) {
    const LAS float* lr = lrs + (dir * 16) * 64 + 16 * sq + i;
    f32x2 z = {bgk, bgk};
#pragma unroll
    for (int r = 0; r < 16; ++r) z += *(const LAS f32x2*)(lr + r * 64) * w[r];
    pre[i] = (fminf(z[0], 0.f) - __logf(1.f + __expf(-fabsf(z[0])))) * (1.f / 16.f);
    pre[i + 1] = (fminf(z[1], 0.f) - __logf(1.f + __expf(-fabsf(z[1])))) * (1.f / 16.f);
  }
  if (dir == 0) {
#pragma unroll
    for (int i = 1; i < 16; ++i) pre[i] += pre[i - 1];
  } else {
#pragma unroll
    for (int i = 14; i >= 0; --i) pre[i] += pre[i + 1];
  }
  tot[sq * 128 + d] = (dir == 0) ? pre[15] : pre[0];
  __syncthreads();
  const float t0 = tot[d], t1 = tot[128 + d], t2 = tot[256 + d], t3 = tot[384 + d];
  const float Btot = (t0 + t1) + (t2 + t3);
  float offs;
  if (dir == 0) offs = (sq > 0 ? t0 : 0.f) + (sq > 1 ? t1 : 0.f) + (sq > 2 ? t2 : 0.f);
  else offs = (sq < 3 ? t3 : 0.f) + (sq < 2 ? t2 : 0.f) + (sq < 1 ? t1 : 0.f);
  if (dbout != nullptr && sq == 0) dbout[d] = __expf(Btot);
  LAS unsigned char* kt = lds + kt_off; LAS unsigned char* qb = lds + G_QB; LAS unsigned char* qe = lds + G_QE;
#pragma unroll
  for (int i = 0; i < 16; ++i) {
    const int s = 16 * sq + i;
    const float bs = offs + pre[i];
    *(LAS bf16_t*)(kt + s * KRS + d * 2) = f2bf(bf2f(*(const LAS bf16_t*)(lds + G_RK + (s * 128 + d) * 2)) * __expf(Btot - bs));
    if (FULL) {
      const float qv = bf2f(*(const LAS bf16_t*)(lds + G_RQ + (s * 128 + d) * 2));
      *(LAS bf16_t*)(qb + s * KRS + d * 2) = f2bf(qv * __expf(bs));
      *(LAS bf16_t*)(qe + s * KRS + d * 2) = f2bf(qv * __expf(bs - Btot));
    }
  }
}
__device__ __forceinline__ u32x4 rope8(u32x4 self, u32x4 part, const float* tb, bool lower, float scale) {
  u32x4 o;
#pragma unroll
  for (int q = 0; q < 4; ++q) {
    const f32x4 cssn = *(const f32x4*)(tb + 4 * q);
    const float s0 = bflo(self[q]), s1 = bfhi(self[q]), p0 = bflo(part[q]), p1 = bfhi(part[q]);
    const float r0 = lower ? (s0 * cssn[0] - p0 * cssn[1]) : (p0 * cssn[1] + s0 * cssn[0]);
    const float r1 = lower ? (s1 * cssn[2] - p1 * cssn[3]) : (p1 * cssn[3] + s1 * cssn[2]);
    o[q] = pk2(r0 * scale, r1 * scale);
  }
  return o;
}
struct ChunkRegs { f32x4 lv; u32x4 vv[4], ks[2]; };
template <bool FULL>
__device__ __forceinline__ void gla_issue(const Params& p, int row0, int hd, int c, int tid_, ChunkRegs& R) {
  WS_LOCAL
  int tid = tid_; asm volatile("" : "+v"(tid));
  { const int r = tid >> 3, c4 = (tid & 7) * 4; R.lv = *(const f32x4*)(WSP(float, WS_LR32) + (size_t)(row0 + r) * 32 + c4); }
#pragma unroll
  for (int i = 0; i < 4; ++i) { const int ci = tid + 512 * i, r = ci >> 5, ch = ci & 31; R.vv[i] = *(const u32x4*)(WSP(bf16_t, WS_PROJ) + (size_t)(row0 + r) * PSTR + 1024 + hd * 256 + ch * 8); }
#pragma unroll
  for (int i = 0; i < 2; ++i) {
    const int ci = tid + 512 * i, r = ci >> 4, ch = ci & 15;
    const bf16_t* rowp = WSP(bf16_t, WS_PROJ) + (size_t)(row0 + r) * PSTR + hd * 128;
    if (!FULL) R.ks[i] = *(const u32x4*)(rowp + 512 + ch * 8);
  }
}
template <bool FULL>
__device__ __forceinline__ void gla_commit(const Params& p, LAS unsigned char* lds, int row0, int hd, int c, int tid_, const ChunkRegs& R) {
  WS_LOCAL
  int tid = tid_; asm volatile("" : "+v"(tid));
  { const int r = tid >> 3, c4 = (tid & 7) * 4; LAS float* lt = (LAS float*)(lds + G_LRS) + c4 * 64 + r; lt[0] = R.lv[0]; lt[64] = R.lv[1]; lt[128] = R.lv[2]; lt[192] = R.lv[3]; }
  const bool isctx = c < 4; const int cl = c - 4;
#pragma unroll
  for (int i = 0; i < 2; ++i) {
    const int ci = tid + 512 * i, r = ci >> 4, ch = ci & 15, chp = ch ^ 4;
    const bool lower = (ch & 7) < 4;
    const float* tb = WSP(float, WS_ROPE) + ((size_t)((ch < 8) ? cl : r) * 32 + ((8 * ch) & 31)) * 2;
    const bf16_t* rowp = WSP(bf16_t, WS_PROJ) + (size_t)(row0 + r) * PSTR + hd * 128;
    u32x4 ks = FULL ? *(const u32x4*)(rowp + 512 + ch * 8) : R.ks[i];
    if (!isctx) ks = rope8(ks, *(const u32x4*)(rowp + 512 + chp * 8), tb, lower, 1.f);
    *(LAS u32x4*)(lds + G_RK + ci * 16) = ks;
    if (FULL) {
      u32x4 qs = *(const u32x4*)(rowp + ch * 8);
      if (!isctx) qs = rope8(qs, *(const u32x4*)(rowp + chp * 8), tb, lower, 0.08838834764831845f);
      else {
#pragma unroll
        for (int q = 0; q < 4; ++q) qs[q] = pk2(bflo(qs[q]) * 0.08838834764831845f, bfhi(qs[q]) * 0.08838834764831845f);
      }
      *(LAS u32x4*)(lds + G_RQ + ci * 16) = qs;
    }
  }
#pragma unroll
  for (int i = 0; i < 4; ++i) { const int ci = tid + 512 * i, r = ci >> 5, ch = ci & 31; *(LAS u32x4*)(lds + G_VT + r * VRS + ch * 16) = R.vv[i]; }
}
__device__ __forceinline__ bf16x8 tr8(const LAS unsigned char* base, int rs, int r0, int q4, int cbyte) {
  const s16x4 lo = ds_tr(base + (r0 + q4) * rs + cbyte), hi = ds_tr(base + (r0 + 4 + q4) * rs + cbyte);
  bf16x8 v; v[0] = lo[0]; v[1] = lo[1]; v[2] = lo[2]; v[3] = lo[3]; v[4] = hi[0]; v[5] = hi[1]; v[6] = hi[2]; v[7] = hi[3];
  return v;
}
__device__ void gla_passA(const Params& p, int l, LAS unsigned char* lds, int bid, int nb) {
  WS_LOCAL
  const int tid = otid(), wave = tid >> 6, lane = tid & 63, fr = lane & 15, g = lane >> 4, q4 = fr >> 2, p4 = fr & 3;
  bf16_t* SB = (bf16_t*)WSP(float, WS_RG);
  ChunkRegs R; float wv[2][17];
  if (bid < 1056) {
    const int c = bid % 132, bh = bid / 132, b = bh >> 2, hd = bh & 3;
    gla_issue<false>(p, (c < 4) ? (NL + b * 256 + c * 64) : (b * 8192 + (c - 4) * 64), hd, c, tid, R);
  }
  for (int task = bid; task < 1056; task += nb) {
    const int c = task % 132, bh = task / 132, b = bh >> 2, hd = bh & 3;
    gla_load_w(p, l, hd, tid, wv);
    gla_commit<false>(p, lds, (c < 4) ? (NL + b * 256 + c * 64) : (b * 8192 + (c - 4) * 64), hd, c, tid, R);
    __syncthreads();
#pragma unroll
    for (int dir = 0; dir < 2; ++dir) {
      float wd[17];
#pragma unroll
      for (int r = 0; r < 17; ++r) wd[r] = wv[dir][r];
      gla_prep<false>(p, l, lds, hd, dir, tid, wd, WSP(float, WS_DB) + (size_t)((bh * 2 + dir) * 132 + c) * 128, dir ? G_QB : G_KT, dir ? G_RED : G_TOT);
    }
    __syncthreads();
    if (task + nb < 1056) {
      const int tn = task + nb, cn = tn % 132, bhn = tn / 132, bn = bhn >> 2, hdn = bhn & 3;
      gla_issue<false>(p, (cn < 4) ? (NL + bn * 256 + cn * 64) : (bn * 8192 + (cn - 4) * 64), hdn, cn, tid, R);
    }
    {
      bf16x8 af[2][2];
#pragma unroll
      for (int ks = 0; ks < 2; ++ks) { af[0][ks] = tr8(lds + G_KT, KRS, 32 * ks + 8 * g, q4, (16 * wave + 4 * p4) * 2); af[1][ks] = tr8(lds + G_QB, KRS, 32 * ks + 8 * g, q4, (16 * wave + 4 * p4) * 2); }
      bf16_t* dst0 = SB + ((size_t)((bh * 2) * 132 + c) * 256 + fr) * 128 + 16 * wave + 4 * g;
      bf16_t* dst1 = dst0 + (size_t)132 * 256 * 128;
#pragma unroll 4
      for (int n = 0; n < 16; ++n) {
        f32x4 a0 = {0.f, 0.f, 0.f, 0.f}, a1 = a0;
#pragma unroll
        for (int ks = 0; ks < 2; ++ks) {
          const bf16x8 bfr = tr8(lds + G_VT, VRS, 32 * ks + 8 * g, q4, (16 * n + 4 * p4) * 2);
          a0 = __builtin_amdgcn_mfma_f32_16x16x32_bf16(af[0][ks], bfr, a0, 0, 0, 0);
          a1 = __builtin_amdgcn_mfma_f32_16x16x32_bf16(af[1][ks], bfr, a1, 0, 0, 0);
        }
        u32x2 w0; w0.x = pk2(a0[0], a0[1]); w0.y = pk2(a0[2], a0[3]);
        u32x2 w1; w1.x = pk2(a1[0], a1[1]); w1.y = pk2(a1[2], a1[3]);
        *(u32x2*)(dst0 + (size_t)(16 * n) * 128) = w0;
        *(u32x2*)(dst1 + (size_t)(16 * n) * 128) = w1;
      }
    }
    __syncthreads();
  }
}
__device__ void gla_passB(const Params& p, int bid, int nb) {
  WS_LOCAL
  const int tid = otid();
  bf16_t* SB = (bf16_t*)WSP(float, WS_RG);
  for (int item = bid * NTHR + tid; item < 131072; item += nb * NTHR) {
    const int dq = item & 31, e = (item >> 5) & 255, chain = item >> 13, dir = chain & 1;
    f32x4 S = {0.f, 0.f, 0.f, 0.f};
    bf16_t* base = SB + ((size_t)chain * 132 * 256 + e) * 128 + dq * 4;
    const float* dbase = WSP(float, WS_DB) + (size_t)chain * 132 * 128 + dq * 4;
#pragma unroll 1
    for (int i0 = 0; i0 < 132; i0 += 12) {
      u32x2 u[12]; f32x4 dd[12]; int cc[12];
#pragma unroll
      for (int k = 0; k < 12; ++k) {
        const int i = i0 + k;
        cc[k] = dir ? ((i < 4) ? 3 - i : 135 - i) : i;
        u[k] = __builtin_nontemporal_load((const u32x2*)(base + (size_t)cc[k] * 32768));
        dd[k] = *(const f32x4*)(dbase + cc[k] * 128);
      }
#pragma unroll
      for (int k = 0; k < 12; ++k) {
        u32x2 o; o.x = pk2(S[0], S[1]); o.y = pk2(S[2], S[3]);
        *(u32x2*)(base + (size_t)cc[k] * 32768) = o;
        S[0] = S[0] * dd[k][0] + bflo(u[k].x); S[1] = S[1] * dd[k][1] + bfhi(u[k].x);
        S[2] = S[2] * dd[k][2] + bflo(u[k].y); S[3] = S[3] * dd[k][3] + bfhi(u[k].y);
      }
    }
  }
}
__device__ void gla_passC(const Params& p, int l, LAS unsigned char* lds, int bid, int nb) {
  WS_LOCAL
  const int tid = otid(), wave = tid >> 6, lane = tid & 63, fr = lane & 15, g = lane >> 4, q4 = fr >> 2, p4 = fr & 3;
  const bf16_t* SB = (const bf16_t*)WSP(float, WS_RG);
  const int c_lo = (l == 0) ? 0 : 4, nc = 132 - c_lo, ntask = 8 * nc;
  ChunkRegs R; float wv[2][17];
  if (bid < ntask) {
    const int c = c_lo + bid % nc, bh = bid / nc, b = bh >> 2, hd = bh & 3;
    gla_issue<true>(p, (c < 4) ? (NL + b * 256 + c * 64) : (b * 8192 + (c - 4) * 64), hd, c, tid, R);
  }
  for (int task = bid; task < ntask; task += nb) {
    const int c = c_lo + task % nc, bh = task / nc, b = bh >> 2, hd = bh & 3;
    const int row0 = (c < 4) ? (NL + b * 256 + c * 64) : (b * 8192 + (c - 4) * 64);
    gla_load_w(p, l, hd, tid, wv);
    gla_commit<true>(p, lds, row0, hd, c, tid, R);
    __syncthreads();
    f32x4 acc[2][4];
#pragma unroll
    for (int eb = 0; eb < 2; ++eb)
#pragma unroll
      for (int tb = 0; tb < 4; ++tb) acc[eb][tb] = (f32x4){0.f, 0.f, 0.f, 0.f};
    f32x4 attacc[2];
    attacc[0] = (f32x4){0.f, 0.f, 0.f, 0.f}; attacc[1] = attacc[0];
#pragma unroll 1
    for (int dir = 0; dir < 2; ++dir) {
      const int chain = bh * 2 + dir;
      { float wd[17];
#pragma unroll
        for (int r = 0; r < 17; ++r) wd[r] = dir ? wv[1][r] : wv[0][r];
        gla_prep<true>(p, l, lds, hd, dir, tid, wd, nullptr, G_KT, G_TOT); __syncthreads(); }
      {
        const int sb = wave >> 1;
        bf16x8 ka[4];
#pragma unroll
        for (int ks = 0; ks < 4; ++ks) ka[ks] = *(const LAS bf16x8*)(lds + G_KT + (16 * sb + fr) * KRS + (32 * ks + 8 * g) * 2);
#pragma unroll
        for (int t2 = 0; t2 < 2; ++t2) {
          const int tb = 2 * (wave & 1) + t2;
          f32x4 a = {0.f, 0.f, 0.f, 0.f};
#pragma unroll
          for (int ks = 0; ks < 4; ++ks) {
            const bf16x8 qf = *(const LAS bf16x8*)(lds + G_QE + (16 * tb + fr) * KRS + (32 * ks + 8 * g) * 2);
            a = __builtin_amdgcn_mfma_f32_16x16x32_bf16(ka[ks], qf, a, 0, 0, 0);
          }
          const int t = 16 * tb + fr;
#pragma unroll
          for (int jj = 0; jj < 4; ++jj) { const int s = 16 * sb + 4 * g + jj; const bool keep = dir ? (s >= t) : (s <= t); attacc[t2][jj] += keep ? a[jj] : 0.f; }
          if (dir == 1) {
            u32x2 w2; w2.x = pk2(attacc[t2][0], attacc[t2][1]); w2.y = pk2(attacc[t2][2], attacc[t2][3]);
            *(LAS u32x2*)(lds + G_ATT + t * ARS + (16 * sb + 4 * g) * 2) = w2;
          }
        }
      }
      {
        const bf16_t* sp = SB + ((size_t)(chain * 132 + c) * 256 + 32 * wave + fr) * 128 + 8 * g;
#pragma unroll
        for (int kh = 0; kh < 2; ++kh) {
          bf16x8 sf[2][2];
#pragma unroll
          for (int eb = 0; eb < 2; ++eb)
#pragma unroll
            for (int k2 = 0; k2 < 2; ++k2) sf[eb][k2] = *(const bf16x8*)(sp + (size_t)(16 * eb) * 128 + 32 * (2 * kh + k2));
#pragma unroll
          for (int tb = 0; tb < 4; ++tb)
#pragma unroll
            for (int k2 = 0; k2 < 2; ++k2) {
              const bf16x8 qf = *(const LAS bf16x8*)(lds + G_QB + (16 * tb + fr) * KRS + (32 * (2 * kh + k2) + 8 * g) * 2);
#pragma unroll
              for (int eb = 0; eb < 2; ++eb) acc[eb][tb] = __builtin_amdgcn_mfma_f32_16x16x32_bf16(sf[eb][k2], qf, acc[eb][tb], 0, 0, 0);
            }
          __builtin_amdgcn_sched_barrier(0);
        }
      }
      __syncthreads();
    }
#pragma unroll
    for (int ks = 0; ks < 2; ++ks) {
      bf16x8 vf[2];
#pragma unroll
      for (int eb = 0; eb < 2; ++eb) vf[eb] = tr8(lds + G_VT, VRS, 32 * ks + 8 * g, q4, (16 * (2 * wave + eb) + 4 * p4) * 2);
#pragma unroll
      for (int tb = 0; tb < 4; ++tb) {
        const bf16x8 af = *(const LAS bf16x8*)(lds + G_ATT + (16 * tb + fr) * ARS + (32 * ks + 8 * g) * 2);
#pragma unroll
        for (int eb = 0; eb < 2; ++eb) acc[eb][tb] = __builtin_amdgcn_mfma_f32_16x16x32_bf16(vf[eb], af, acc[eb][tb], 0, 0, 0);
      }
    }
    if (task + nb < ntask) {
      const int tn = task + nb, cn = c_lo + tn % nc, bhn = tn / nc, bn = bhn >> 2, hdn = bhn & 3;
      gla_issue<true>(p, (cn < 4) ? (NL + bn * 256 + cn * 64) : (bn * 8192 + (cn - 4) * 64), hdn, cn, tid, R);
    }
    u32x2 og[2][4]; f32x4 nwv[2];
#pragma unroll
    for (int eb = 0; eb < 2; ++eb) {
      const int e0 = 16 * (2 * wave + eb) + 4 * g;
      nwv[eb] = *(const f32x4*)(KARG(const float, 11) + l * 256 + e0);
#pragma unroll
      for (int tb = 0; tb < 4; ++tb) og[eb][tb] = *(const u32x2*)(WSP(bf16_t, WS_PROJ) + (size_t)(row0 + 16 * tb + fr) * PSTR + 2048 + hd * 256 + e0);
    }
    LAS float* red = (LAS float*)(lds + G_RED);
    float rstd[4];
#pragma unroll
    for (int tb = 0; tb < 4; ++tb) {
      float ss = 0.f;
#pragma unroll
      for (int eb = 0; eb < 2; ++eb)
#pragma unroll
        for (int jj = 0; jj < 4; ++jj) ss += acc[eb][tb][jj] * acc[eb][tb][jj];
      ss += __shfl_xor(ss, 16, 64); ss += __shfl_xor(ss, 32, 64);
      if (g == 0) red[wave * 64 + 16 * tb + fr] = ss;
    }
    __syncthreads();
#pragma unroll
    for (int tb = 0; tb < 4; ++tb) {
      float ss = 0.f;
#pragma unroll
      for (int w8 = 0; w8 < 8; ++w8) ss += red[w8 * 64 + 16 * tb + fr];
      rstd[tb] = rsqrtf(ss * (1.f / 256.f) + 1e-6f);
    }
#pragma unroll
    for (int eb = 0; eb < 2; ++eb) {
      const int e0 = 16 * (2 * wave + eb) + 4 * g;
      const f32x4 nw = nwv[eb];
#pragma unroll
      for (int tb = 0; tb < 4; ++tb) {
        const int row = row0 + 16 * tb + fr;
        const u32x2 ogv = og[eb][tb];
        const float y0 = acc[eb][tb][0] * rstd[tb] * nw[0] * siluf_(bflo(ogv.x)), y1 = acc[eb][tb][1] * rstd[tb] * nw[1] * siluf_(bfhi(ogv.x));
        const float y2 = acc[eb][tb][2] * rstd[tb] * nw[2] * siluf_(bflo(ogv.y)), y3 = acc[eb][tb][3] * rstd[tb] * nw[3] * siluf_(bfhi(ogv.y));
        u32x2 w2; w2.x = pk2(y0, y1); w2.y = pk2(y2, y3);
        *(u32x2*)(WSP(bf16_t, WS_GM) + (size_t)row * GSTR + hd * 256 + e0) = w2;
      }
    }
  }
}
__device__ __forceinline__ void route_top2(float affl, float sell, int& e1, int& e2, float& w1, float& w2) {
  float aff[16], sel[16];
#pragma unroll
  for (int e = 0; e < 16; ++e) { aff[e] = __int_as_float(__builtin_amdgcn_readlane(__float_as_int(affl), 4 * e)); sel[e] = __int_as_float(__builtin_amdgcn_readlane(__float_as_int(sell), 4 * e)); }
  float best = -INFINITY; int gb = 0;
  float bs[4], ba[4];
#pragma unroll
  for (int q = 0; q < 4; ++q) { bs[q] = 0.f; ba[q] = 0.f; }
#pragma unroll
  for (int g = 0; g < 4; ++g) {
    const float s0 = sel[4 * g], s1 = sel[4 * g + 1], s2 = sel[4 * g + 2], s3 = sel[4 * g + 3];
    const float m1 = fmaxf(fmaxf(s0, s1), fmaxf(s2, s3));
    const int f = (s0 == m1) ? 0 : (s1 == m1) ? 1 : (s2 == m1) ? 2 : 3;
    float m2 = -INFINITY;
    if (f != 0) m2 = fmaxf(m2, s0);
    if (f != 1) m2 = fmaxf(m2, s1);
    if (f != 2) m2 = fmaxf(m2, s2);
    if (f != 3) m2 = fmaxf(m2, s3);
    const float gs = m1 + m2;
    if (gs > best) {
      best = gs; gb = g;
      bs[0] = s0; bs[1] = s1; bs[2] = s2; bs[3] = s3;
      ba[0] = aff[4 * g]; ba[1] = aff[4 * g + 1]; ba[2] = aff[4 * g + 2]; ba[3] = aff[4 * g + 3];
    }
  }
  const float m1 = fmaxf(fmaxf(bs[0], bs[1]), fmaxf(bs[2], bs[3]));
  const int i1 = (bs[0] == m1) ? 0 : (bs[1] == m1) ? 1 : (bs[2] == m1) ? 2 : 3;
  float m2 = -INFINITY; int i2 = 0;
#pragma unroll
  for (int q = 3; q >= 0; --q)
    if (q != i1 && bs[q] >= m2) { m2 = bs[q]; i2 = q; }
  const float a1 = (i1 == 0) ? ba[0] : (i1 == 1) ? ba[1] : (i1 == 2) ? ba[2] : ba[3];
  const float a2 = (i2 == 0) ? ba[0] : (i2 == 1) ? ba[1] : (i2 == 2) ? ba[2] : ba[3];
  const float inv = 1.f / (a1 + a2);
  e1 = gb * 4 + i1; e2 = gb * 4 + i2; w1 = a1 * inv; w2 = a2 * inv;
}
__device__ void ph_norm2(const Params& p, int l, LAS unsigned char* lds, int bid, int nb) {
  WS_LOCAL
  const int tid = otid(), wave = tid >> 6, lane = tid & 63, fr = lane & 15, g = lane >> 4;
  const int M = (l == 0) ? NT : NL;
  const int R = (M + nb - 1) / nb, rbeg = bid * R, rend = min(rbeg + R, M);
  LAS int* lcnt = (LAS int*)lds;
  LAS int* lbase = lcnt + 16;
  LAS int* rec = lcnt + 64;
  LAS float* Hs = (LAS float*)(lds + 4096);
  LAS float* part = (LAS float*)(lds + 4096 + 16 * 1028 * 4);
  if (tid < 32) lcnt[tid] = 0;
  for (int k = tid; k < R; k += NTHR) rec[k * 8] = -1;
  float wreg[32];
#pragma unroll
  for (int t = 0; t < 32; ++t) wreg[t] = KARG(const float, 16)[(size_t)(128 * wave + 4 * t + g) * 16 + fr];
  const bf16_t* Yb = WSP(bf16_t, WS_Y);
  const float* nw = KARG(const float, 7) + l * 1024;
  const float brt = KARG(const float, 17)[(lane >> 2) & 15];
  __syncthreads();
  for (int r0 = rbeg; r0 < rend; r0 += 16) {
    int rows[2]; bool val[2];
#pragma unroll
    for (int u = 0; u < 2; ++u) { rows[u] = r0 + 2 * wave + u; val[u] = rows[u] < rend; if (!val[u]) rows[u] = rend - 1; }
    f32x4 v[2][4]; u32x2 yv[2][4];
#pragma unroll
    for (int u = 0; u < 2; ++u) {
      const int row = rows[u];
      const float* src = (l == 0) ? ((row < NL) ? KARG(const float, 0) + (size_t)row * 1024 : KARG(const float, 2) + (size_t)(row - NL) * 1024)
                                  : (const float*)(WSP(float, WS_XBUF) + (size_t)row * 1024);
#pragma unroll
      for (int i = 0; i < 4; ++i) { v[u][i] = *(const f32x4*)(src + i * 256 + lane * 4); yv[u][i] = *(const u32x2*)(Yb + (size_t)row * 1024 + i * 256 + lane * 4); }
    }
#pragma unroll
    for (int u = 0; u < 2; ++u) {
      const int row = rows[u];
      const float* md = WSP(float, WS_MOD) + (l * 3 + ((row < NL) ? (row >> 13) : 2)) * 6144;
      float ss = 0.f;
#pragma unroll
      for (int i = 0; i < 4; ++i) {
        const f32x4 m2 = *(const f32x4*)(md + 2048 + i * 256 + lane * 4);
        v[u][i][0] += m2[0] * bflo(yv[u][i].x); v[u][i][1] += m2[1] * bfhi(yv[u][i].x); v[u][i][2] += m2[2] * bflo(yv[u][i].y); v[u][i][3] += m2[3] * bfhi(yv[u][i].y);
        if (val[u]) *(f32x4*)(WSP(float, WS_XBUF) + (size_t)row * 1024 + i * 256 + lane * 4) = v[u][i];
        ss += v[u][i][0] * v[u][i][0] + v[u][i][1] * v[u][i][1] + v[u][i][2] * v[u][i][2] + v[u][i][3] * v[u][i][3];
      }
      const float rstd = rsqrtf(wave_sum(ss) * (1.f / 1024.f) + 1e-6f);
#pragma unroll
      for (int i = 0; i < 4; ++i) {
        const int j = i * 256 + lane * 4;
        const f32x4 w = *(const f32x4*)(nw + j), m4 = *(const f32x4*)(md + 4096 + j), m3 = *(const f32x4*)(md + 3072 + j);
        f32x4 h;
#pragma unroll
        for (int q = 0; q < 4; ++q) h[q] = v[u][i][q] * rstd * w[q] * (1.f + m4[q]) + m3[q];
        if (val[u]) { u32x2 o; o.x = pk2(h[0], h[1]); o.y = pk2(h[2], h[3]); *(u32x2*)(WSP(bf16_t, WS_HM) + (size_t)row * 1024 + j) = o; }
        *(LAS f32x4*)(Hs + (2 * wave + u) * 1028 + j) = h;
      }
    }
    __syncthreads();
    {
      f32x4 acc = {0.f, 0.f, 0.f, 0.f};
      const LAS float* hp = Hs + fr * 1028 + 128 * wave + g;
#pragma unroll
      for (int t = 0; t < 32; ++t) acc = __builtin_amdgcn_mfma_f32_16x16x4f32(hp[4 * t], wreg[t], acc, 0, 0, 0);
#pragma unroll
      for (int jj = 0; jj < 4; ++jj) part[(wave * 16 + 4 * g + jj) * 16 + fr] = acc[jj];
    }
    __syncthreads();
#pragma unroll
    for (int u = 0; u < 2; ++u) {
      const int rl = 2 * wave + u, em = (lane >> 2) & 15;
      float lg = 0.f;
#pragma unroll
      for (int w8 = 0; w8 < 8; ++w8) lg += part[(w8 * 16 + rl) * 16 + em];
      const float affl = 1.f / (1.f + expf(-lg)), sell = affl + brt;
      int e1, e2; float w1, w2;
      route_top2(affl, sell, e1, e2, w1, w2);
      if (lane == 0 && val[u]) {
        const int s1 = __hip_atomic_fetch_add(&lcnt[e1], 1, __ATOMIC_RELAXED, __HIP_MEMORY_SCOPE_WORKGROUP);
        const int s2 = __hip_atomic_fetch_add(&lcnt[e2], 1, __ATOMIC_RELAXED, __HIP_MEMORY_SCOPE_WORKGROUP);
        LAS int* rc = rec + (rows[u] - rbeg) * 8;
        rc[0] = rows[u]; rc[1] = e1; rc[2] = s1; rc[3] = e2; rc[4] = s2; rc[5] = __float_as_int(w1); rc[6] = __float_as_int(w2);
      }
    }
  }
  __syncthreads();
  if (tid < 16) { const int n = lcnt[tid]; lbase[tid] = n ? atomicAdd(&WSP(int, WS_CTL + 4096 * 4)[(l * 16 + tid) * 64], n) : 0; }
  __syncthreads();
  for (int k = tid; k < R; k += NTHR) {
    const LAS int* rc = rec + k * 8;
    const int row = rc[0];
    if (row >= 0) {
      const int e1 = rc[1], s1 = lbase[e1] + rc[2], e2 = rc[3], s2 = lbase[e2] + rc[4];
      WSP(int, WS_LIST)[e1 * NT + s1] = row * 2; WSP(float, WS_TOPW)[row * 2] = __int_as_float(rc[5]);
      WSP(int, WS_LIST)[e2 * NT + s2] = row * 2 + 1; WSP(float, WS_TOPW)[row * 2 + 1] = __int_as_float(rc[6]);
    }
  }
}
__device__ __forceinline__ void moe_tables(const Params& p, int l, volatile LAS int* tab, int nN) {
  WS_LOCAL
  if (threadIdx.x == 0) {
    int up = 0, tb = 0;
    for (int e = 0; e < 16; ++e) {
      const int c = __hip_atomic_load(&WSP(int, WS_CTL + 4096 * 4)[(l * 16 + e) * 64], __ATOMIC_RELAXED, __HIP_MEMORY_SCOPE_AGENT), mt = (c + 255) >> 8;
      tab[e] = up; tab[32 + e] = mt > 0 ? mt : 1; tab[64 + e] = tb; tab[96 + e] = c;
      up += mt * nN; tb += mt;
    }
    tab[16] = up;
  }
  __syncthreads();
}
__device__ void ph_proj(const Params& p, int l, LAS unsigned char* lds, int bid, int nb) {
  WS_LOCAL
  pg8::DenseSched S; S.init(NT / 256, PSTR / 256, nb, bid, WSP(bf16_t, WS_HM), WSP(bf16_t, WS_WINT) + (size_t)l * PSTR * 1024, 1024);
  EpiProj E{WSP(bf16_t, WS_PROJ), WSP(float, WS_LR32)};
  pg8::gemm_phase<EpiProj, pg8::DenseSched, 0>(lds, 1024, S, E);
}
__device__ void ph_merge(const Params& p, int l, LAS unsigned char* lds, int bid, int nb) {
  WS_LOCAL
  if (l == 0 && bid < 8) {
    const int pm = 64 + (bid >> 2), pn = bid & 3;
    unsigned* ctr = WSP(unsigned, WS_CTL + 6400 * 4) + (bid >> 2) * 64;
    pg8::SingleSched S; S.u0.pm = pm; S.u0.pn = pn; S.u0.e = 0; S.u0.aux = 0;
    S.u0.A = (const char*)WSP(bf16_t, WS_GM) + (size_t)pm * 256 * GSTR * 2; S.u0.B = (const char*)WSP(bf16_t, WS_WMT) + (size_t)pn * 256 * GSTR * 2;
    EpiMerge E{WSP(bf16_t, WS_PROJ), WSP(bf16_t, WS_HM)};
    pg8::gemm_phase<EpiMerge, pg8::SingleSched, 16>(lds, GSTR, S, E);
    asm volatile("s_waitcnt vmcnt(0)" ::: "memory");
    __syncthreads();
    if (threadIdx.x == 0) {
      __builtin_amdgcn_fence(__ATOMIC_RELEASE, "agent");
      asm volatile("s_waitcnt vmcnt(0)" ::: "memory");
      (void)__hip_atomic_fetch_add(ctr, 1u, __ATOMIC_RELAXED, __HIP_MEMORY_SCOPE_AGENT);
    }
  }
  {
    pg8::DenseSched S; S.init(NL / 256, 4, nb, bid, WSP(bf16_t, WS_GM), WSP(bf16_t, WS_WMT) + (size_t)l * 1024 * GSTR, GSTR);
    EpiMerge E{WSP(bf16_t, WS_PROJ), WSP(bf16_t, WS_HM)};
    pg8::gemm_phase<EpiMerge, pg8::DenseSched, 16>(lds, GSTR, S, E);
  }
  if (l == 0 && bid >= 8 && bid < 16) {
    const int j = bid - 8, pm = 64 + (j >> 2), pn = j & 3;
    unsigned* ctr = WSP(unsigned, WS_CTL + 6400 * 4) + (j >> 2) * 64;
    if (threadIdx.x == 0) {
      unsigned sp = 0;
      while (__hip_atomic_load(ctr, __ATOMIC_RELAXED, __HIP_MEMORY_SCOPE_AGENT) < 4u) { __builtin_amdgcn_s_sleep(2); if (++sp > (1u << 24)) break; }
      __builtin_amdgcn_fence(__ATOMIC_ACQUIRE, "agent");
      asm volatile("s_waitcnt vmcnt(0)" ::: "memory");
    }
    __syncthreads();
    pg8::SingleSched S; S.u0.pm = pm; S.u0.pn = pn; S.u0.e = 0; S.u0.aux = 0;
    S.u0.A = (const char*)WSP(bf16_t, WS_HM) + (size_t)pm * 256 * 1024 * 2; S.u0.B = (const char*)WSP(bf16_t, WS_WOT) + (size_t)pn * 256 * 1024 * 2;
    EpiOut E{WSP(bf16_t, WS_Y)};
    pg8::gemm_phase<EpiOut, pg8::SingleSched, 0>(lds, 1024, S, E);
  }
}
__device__ void ph_out(const Params& p, int l, LAS unsigned char* lds, int bid, int nb) {
  WS_LOCAL
  pg8::DenseSched S; S.init(NL / 256, 4, nb, bid, WSP(bf16_t, WS_HM), WSP(bf16_t, WS_WOT) + (size_t)l * 1024 * 1024, 1024);
  EpiOut E{WSP(bf16_t, WS_Y)};
  pg8::gemm_phase<EpiOut, pg8::DenseSched, 0>(lds, 1024, S, E);
}
__device__ void ph_moe1(const Params& p, int l, LAS unsigned char* lds, int bid, int nb) {
  WS_LOCAL
  volatile LAS int* tab = (volatile LAS int*)(lds + MISC_OFF + 256);
  moe_tables(p, l, tab, 8);
  pg8::MoeSched S; S.U = tab[16]; S.nN = 8; S.G = nb; S.c = bid; S.A = (const char*)WSP(bf16_t, WS_HM); S.B = (const char*)WSP(bf16_t, WS_RG);
  S.tstep = (size_t)256 * 1024 * 2; S.estep = (size_t)2048 * 1024 * 2; S.tab = tab; S.list = WSP(int, WS_LIST); S.gather = true;
  EpiMoe1 E{WSP(bf16_t, WS_PROJ + PROWS * 2048)};
  pg8::gemm_phase<EpiMoe1, pg8::MoeSched, 0, true>(lds, 1024, S, E);
}
__device__ void ph_moe2(const Params& p, int l, LAS unsigned char* lds, int bid, int nb) {
  WS_LOCAL
  volatile LAS int* tab = (volatile LAS int*)(lds + MISC_OFF + 256);
  __syncthreads();
  moe_tables(p, l, tab, 4);
  pg8::MoeSched S; S.U = tab[16]; S.nN = 4; S.G = nb; S.c = bid; S.A = (const char*)WSP(bf16_t, WS_PROJ + PROWS * 2048); S.B = (const char*)WSP(bf16_t, WS_RG + (size_t)16 * 2048 * 1024 * 2);
  S.tstep = (size_t)256 * 1024 * 2; S.estep = (size_t)1024 * 1024 * 2; S.tab = tab; S.list = WSP(int, WS_LIST); S.gather = false;
  EpiMoe2 E{WSP(bf16_t, WS_PROJ + 2 * PROWS * 2048), WSP(int, WS_LIST), WSP(float, WS_TOPW), tab};
  pg8::gemm_phase<EpiMoe2, pg8::MoeSched, 0>(lds, 1024, S, E);
}
__device__ void ph_final(const Params& p, int bid, int nb) {
  WS_LOCAL
  const int tid = otid(), wave = tid >> 6, lane = tid & 63;
  const int NGW = nb * NWAVES;
  for (int rowa = bid * NWAVES + wave; rowa < NL; rowa += 2 * NGW) {
    int rows[2]; rows[0] = rowa; rows[1] = rowa + NGW;
    const bool has2 = rows[1] < NL;
    if (!has2) rows[1] = rowa;
    f32x4 v[2][4]; float ss[2] = {0.f, 0.f};
#pragma unroll
    for (int u = 0; u < 2; ++u) {
      const int row = rows[u];
      const float* src = WSP(float, WS_XBUF) + (size_t)row * 1024;
      const float* m5 = WSP(float, WS_MOD) + (1 * 3 + (row >> 13)) * 6144 + 5 * 1024;
      const bf16_t* y0 = WSP(bf16_t, WS_PROJ + 2 * PROWS * 2048) + (size_t)(row * 2) * 1024;
#pragma unroll
      for (int i = 0; i < 4; ++i) {
        const int j = i * 256 + lane * 4;
        v[u][i] = __builtin_nontemporal_load((const f32x4*)(src + j));
        const u32x2 ya = __builtin_nontemporal_load((const u32x2*)(y0 + j)), yb = __builtin_nontemporal_load((const u32x2*)(y0 + 1024 + j));
        const f32x4 g = *(const f32x4*)(m5 + j);
        v[u][i][0] += g[0] * (bflo(ya.x) + bflo(yb.x)); v[u][i][1] += g[1] * (bfhi(ya.x) + bfhi(yb.x));
        v[u][i][2] += g[2] * (bflo(ya.y) + bflo(yb.y)); v[u][i][3] += g[3] * (bfhi(ya.y) + bfhi(yb.y));
        ss[u] += v[u][i][0] * v[u][i][0] + v[u][i][1] * v[u][i][1] + v[u][i][2] * v[u][i][2] + v[u][i][3] * v[u][i][3];
      }
    }
#pragma unroll
    for (int u = 0; u < 2; ++u) {
      if (u == 1 && !has2) break;
      const float rstd = rsqrtf(wave_sum(ss[u]) * (1.f / 1024.f) + 1e-6f);
#pragma unroll
      for (int i = 0; i < 4; ++i) {
        const int j = i * 256 + lane * 4;
        const f32x4 w = *(const f32x4*)(KARG(const float, 21) + j);
        __builtin_nontemporal_store(v[u][i] * rstd * w, (f32x4*)(KARG(float, 22) + (size_t)rows[u] * 1024 + j));
      }
    }
  }
}

__global__ void __launch_bounds__(NTHR, 2) k_mega(Params p) {
  extern __shared__ __attribute__((aligned(16))) unsigned char lds_raw[];
  LAS unsigned char* lds0 = (LAS unsigned char*)lds_raw;
  cg::grid_group grid = cg::this_grid();
  const int bid0 = blockIdx.x, nb0 = gridDim.x;
  volatile LAS unsigned* misc = (volatile LAS unsigned*)(lds0 + MISC_OFF);
  if (threadIdx.x < 64) misc[threadIdx.x] = 0u;
  __syncthreads();
  XcdBarrier bar = xcd_barrier_post((unsigned*)(p.ws + WS_CTL), misc);
  if (p.ws == nullptr) grid.sync();
#pragma unroll 1
  for (int step = 0; step < 23; ++step) {
    const int t = step - 2, l = (t >= 0) ? t / 10 : 0, ph = (step == 0) ? -1 : ((step == 1) ? -2 : ((step == 22) ? 11 : t % 10));
    int bid = bid0, nb = nb0; unsigned ldsu = (unsigned)(size_t)lds0;
    asm volatile("" : "+s"(bid), "+s"(nb), "+s"(ldsu));
    LAS unsigned char* lds = (LAS unsigned char*)(size_t)ldsu;
    switch (ph) {
      case -1: ph_init(p, lds, bid, nb); break;
      case -2: ph_ada_reduce(p, bid, nb); break;
      case 0: ph_norm1(p, l, bid, nb); break;
      case 1: ph_proj(p, l, lds, bid, nb); break;
      case 2: case 3: if (ph == 2) gla_passA(p, l, lds, bid, nb); else gla_passB(p, bid, nb);
              na_phase(p, l, lds, bid, nb, ph == 2 ? 1 : 0); break;
      case 4: gla_passC(p, l, lds, bid, nb); break;
      case 5: ph_experts(p, l, lds, bid, nb); __syncthreads(); ph_merge(p, l, lds, bid, nb); break;
      case 6: ph_out(p, l, lds, bid, nb); break;
      case 7: ph_norm2(p, l, lds, bid, nb); break;
      case 8: ph_moe1(p, l, lds, bid, nb); break;
      case 9: ph_moe2(p, l, lds, bid, nb); break;
      default: ph_final(p, bid, nb); break;
    }
    if (step == 22) break;
    xcd_barrier(bar);
  }
}

extern "C" void kernel_launch(void* const* d_in, const int* in_sizes, int n_in, void* d_out, int out_size, void* d_ws,
                              size_t ws_size, hipStream_t stream) {
  Params p{};
  const float** fp = (const float**)&p;
  for (int i = 0; i < 22; ++i) fp[i] = (const float*)d_in[i];
  p.out = (float*)d_out;
  p.ws = (char*)d_ws;
  if (WS_END > ws_size) { fprintf(stderr, "workspace too small: need %zu have %zu\n", (size_t)WS_END, ws_size); return; }

  static int grid_blocks = 0;
  if (!grid_blocks) {
    int dev = 0, cus = 0, per_cu = 0;
    (void)hipGetDevice(&dev);
    (void)hipDeviceGetAttribute(&cus, hipDeviceAttributeMultiprocessorCount, dev);
    (void)hipFuncSetAttribute((const void*)k_mega, hipFuncAttributeMaxDynamicSharedMemorySize, LDS_BYTES);
    (void)hipOccupancyMaxActiveBlocksPerMultiprocessor(&per_cu, k_mega, NTHR, LDS_BYTES);
    if (per_cu < 1) fprintf(stderr, "occupancy query reports %d blocks per CU\n", per_cu);
    grid_blocks = cus > 0 ? cus : 256;
  }
  (void)hipMemsetAsync(p.ws + WS_CTL, 0, 32768, stream);
  void* args[] = {&p};
  hipError_t e = hipLaunchCooperativeKernel((void*)k_mega, dim3(grid_blocks), dim3(NTHR), args, LDS_BYTES, stream);
  if (e != hipSuccess) fprintf(stderr, "cooperative launch failed: %s (grid %d)\n", hipGetErrorString(e), grid_blocks);
}
```

```cpp
#include <hip/hip_runtime.h>
#include <hip/hip_cooperative_groups.h>
#include <cstdio>
#include <cstdint>
namespace cg = cooperative_groups;

typedef unsigned short bf16_t;
typedef short bf16x8 __attribute__((ext_vector_type(8)));
typedef float f32x4 __attribute__((ext_vector_type(4)));
typedef unsigned u32x4 __attribute__((ext_vector_type(4)));
typedef unsigned u32x2 __attribute__((ext_vector_type(2)));
#define LAS __attribute__((address_space(3)))

#define NT 16896
#define NL 16384
#define PSTR 6912
#define INC 6688
#define GSTR 1536
#define NTHR 512
#define NWAVES 8
#define RING_BYTES 131072
#define LDS_BYTES 151552
#define MISC_OFF 131072

__device__ __forceinline__ float bf2f(bf16_t v) { return __uint_as_float(((unsigned)v) << 16); }
typedef __bf16 hwbf16x2 __attribute__((ext_vector_type(2)));
typedef float f32x2 __attribute__((ext_vector_type(2)));
__device__ __forceinline__ unsigned pk2(float lo, float hi) { const f32x2 v = {lo, hi}; return __builtin_bit_cast(unsigned, __builtin_convertvector(v, hwbf16x2)); }
__device__ __forceinline__ bf16_t f2bf(float f) { return (bf16_t)(pk2(f, 0.f) & 0xffffu); }
__device__ __forceinline__ float bflo(unsigned u) { return __uint_as_float(u << 16); }
__device__ __forceinline__ float bfhi(unsigned u) { return __uint_as_float(u & 0xffff0000u); }
__device__ __forceinline__ float sigmoidf_(float x) { return 1.f / (1.f + __expf(-x)); }
__device__ __forceinline__ float siluf_(float x) { return x / (1.f + __expf(-x)); }
__device__ __forceinline__ float wave_sum(float v) {
#pragma unroll
  for (int o = 32; o > 0; o >>= 1) v += __shfl_xor(v, o, 64);
  return v;
}
__device__ __forceinline__ float wave_max(float v) {
#pragma unroll
  for (int o = 32; o > 0; o >>= 1) v = fmaxf(v, __shfl_xor(v, o, 64));
  return v;
}
__device__ __forceinline__ int otid() { int t = threadIdx.x; asm volatile("" : "+v"(t)); return t; }

constexpr size_t al256(size_t x) { return (x + 255) & ~(size_t)255; }
constexpr size_t WS_CTL = 0;
constexpr size_t WS_MOD = WS_CTL + 32768;
constexpr size_t WS_ROPE = WS_MOD + al256(2 * 3 * 6144 * 4);
constexpr size_t WS_LR32 = WS_ROPE + al256(128 * 32 * 2 * 4);
constexpr size_t WS_TOPW = WS_LR32 + al256((size_t)NT * 32 * 4);
constexpr size_t WS_POS = WS_TOPW + al256((size_t)NT * 2 * 4);
constexpr size_t WS_LIST = WS_POS + al256((size_t)NT * 2 * 4);
constexpr size_t WS_DB = WS_LIST + al256((size_t)16 * NT * 4);
constexpr size_t WS_APART = WS_DB + al256((size_t)16 * 132 * 128 * 4);
constexpr size_t WS_XBUF = WS_APART + al256((size_t)2 * 32 * 3 * 6144 * 4);
constexpr size_t WS_WINT = WS_XBUF + al256((size_t)NT * 1024 * 4);
constexpr size_t WS_WMT = WS_WINT + al256((size_t)2 * PSTR * 1024 * 2);
constexpr size_t WS_WOT = WS_WMT + al256((size_t)2 * 1024 * GSTR * 2);
constexpr size_t WS_HM = WS_WOT + al256((size_t)2 * 1024 * 1024 * 2);
constexpr size_t WS_GM = WS_HM + al256((size_t)NT * 1024 * 2);
constexpr size_t WS_RG = WS_GM + al256((size_t)NT * GSTR * 2);
constexpr size_t WS_PROJ = WS_RG + al256((size_t)NT * 1024 * 4 * 2);
constexpr size_t WS_END = WS_PROJ + al256((size_t)NT * PSTR * 2);
constexpr size_t PROWS = 37888;
constexpr size_t WS_W2F8 = WS_RG + (size_t)16 * 2048 * 1024;
constexpr size_t WS_H8 = WS_HM;
constexpr size_t WS_Y = WS_RG + (size_t)16 * 3 * 1024 * 1024 * 2;
static_assert((size_t)16 * 3 * 1024 * 1024 * 2 + (size_t)NT * 1024 * 2 <= (size_t)NT * 1024 * 4 * 2, "y buffer");
static_assert(2 * PROWS * 2048 + (size_t)NT * 2 * 2048 <= (size_t)NT * PSTR * 2, "MoE buffers must fit in the projection region");
static_assert((size_t)16 * 132 * 256 * 128 * 2 <= (size_t)NT * 1024 * 4 * 2, "GLA state buffer");
static_assert((size_t)16 * 3 * 1024 * 1024 * 2 <= (size_t)NT * 1024 * 4 * 2, "expert copies");

struct Params {
  const float *x, *c, *ctx, *c_ctx, *w_ada, *b_ada, *norm1_w, *norm2_w, *w_in, *w_gk_up, *b_gk, *gla_norm_w, *rpb,
      *w_bo_gla, *w_bo_na, *w_out, *w_router, *b_router, *w1, *w3, *w2, *final_norm_w;
  float* out;
  char* ws;
};
#define WSP(T, off) ((T*)(wsb + (off)))
typedef const unsigned long long __attribute__((address_space(4))) karg_t;
#define GAS __attribute__((address_space(1)))
#define WS_LOCAL karg_t* kab = (karg_t*)__builtin_amdgcn_kernarg_segment_ptr(); asm volatile("" : "+s"(kab)); char* wsb = (char*)(GAS char*)kab[23];
#define KARG(T, idx) ((T*)(GAS T*)kab[idx])

#define XB_TMO      128
#define XB_XCNT(j)  (256  + 64 * (j))
#define XB_XSUB(j)  (1280 + 64 * (j))
#define XB_XGEN(j)  (2304 + 64 * (j))
#define XB_TOP      3328
#define XB_TOPGEN   3392
#define XCD_BAR_WORDS 3456
#define XB_SPIN_CAP (1u << 22)
__device__ __forceinline__ unsigned xb_ld(unsigned* p) { return __hip_atomic_load(p, __ATOMIC_RELAXED, __HIP_MEMORY_SCOPE_AGENT); }
__device__ __forceinline__ unsigned xb_add(unsigned* p, unsigned v) { return __hip_atomic_fetch_add(p, v, __ATOMIC_RELAXED, __HIP_MEMORY_SCOPE_AGENT); }
__device__ __forceinline__ unsigned xb_xcc_id() { return (unsigned)__builtin_amdgcn_s_getreg((3 << 11) | 20) & 0xFu; }
#define XB_SPIN(cond, bar) do { unsigned _sp = 0; while (cond) { __builtin_amdgcn_s_sleep(1); \
    if ((++_sp & 255u) == 0u) { if (xb_ld(&(bar)[XB_TMO])) break; if (_sp > XB_SPIN_CAP) { atomicAdd(&(bar)[XB_TMO], 1u); break; } } } } while (0)
struct XcdBarrier { unsigned* bar; unsigned x; volatile LAS unsigned* st; };
__device__ __forceinline__ XcdBarrier xcd_barrier_post(unsigned* bar, volatile LAS unsigned* st) {
  XcdBarrier b; b.bar = bar; b.x = xb_xcc_id(); b.st = st;
  if (threadIdx.x == 0) (void)xb_add(&bar[XB_XCNT(b.x)], 1u);
  return b;
}
__device__ __forceinline__ void xcd_barrier_complete(unsigned* bar, unsigned x, unsigned& nloc, unsigned& nx) {
  const unsigned G = gridDim.x * gridDim.y * gridDim.z;
  unsigned sum, cnt, mine, sp = 0u;
  for (;;) {
    sum = 0u; cnt = 0u; mine = 0u;
#pragma unroll
    for (unsigned j = 0; j < 16; ++j) { const unsigned c = xb_ld(&bar[XB_XCNT(j)]); sum += c; cnt += (c > 0u) ? 1u : 0u; mine = (j == x) ? c : mine; }
    if (sum == G) break;
    __builtin_amdgcn_s_sleep(1);
    if ((++sp & 255u) == 0u) { if (xb_ld(&bar[XB_TMO])) break; if (sp > XB_SPIN_CAP) { atomicAdd(&bar[XB_TMO], 1u); break; } }
  }
  nloc = mine > 0u ? mine : 1u; nx = cnt > 0u ? cnt : 1u;
}
__device__ __forceinline__ void xcd_barrier1(const XcdBarrier& b);
__device__ __forceinline__ void xcd_barrier(const XcdBarrier& b) { xcd_barrier1(b); }
__device__ __forceinline__ void xcd_barrier1(const XcdBarrier& b0) {
  asm volatile("s_waitcnt vmcnt(0)" ::: "memory");
  __syncthreads();
  if (threadIdx.x == 0) {
    XcdBarrier b = b0;
    { unsigned long long a_ = (unsigned long long)b.bar; unsigned lo_ = (unsigned)a_, hi_ = (unsigned)(a_ >> 32), x_ = b.x, st_ = (unsigned)(size_t)b.st;
      asm volatile("" : "+s"(lo_), "+s"(hi_), "+s"(x_), "+s"(st_));
      b.bar = (unsigned*)(((unsigned long long)hi_ << 32) | lo_); b.x = x_; b.st = (volatile LAS unsigned*)(size_t)st_; }
    unsigned* bar = b.bar;
    __builtin_amdgcn_s_waitcnt(0);
    unsigned nloc = b.st[0], nx = b.st[1];
    if (nloc == 0u) { xcd_barrier_complete(bar, b.x, nloc, nx); b.st[0] = nloc; b.st[1] = nx; }
    const unsigned old = xb_add(&bar[XB_XSUB(b.x)], 1u);
    const unsigned gen = old / nloc;
    if (old + 1u == (gen + 1u) * nloc) {
      __builtin_amdgcn_fence(__ATOMIC_RELEASE, "agent");
      asm volatile("s_waitcnt vmcnt(0)" ::: "memory");
      const unsigned og = xb_add(&bar[XB_TOP], 1u);
      const unsigned tg = og / nx;
      if (og + 1u == (tg + 1u) * nx) xb_add(&bar[XB_TOPGEN], 1u);
      else XB_SPIN(xb_ld(&bar[XB_TOPGEN]) == tg, bar);
      __builtin_amdgcn_fence(__ATOMIC_ACQUIRE, "agent");
      xb_add(&bar[XB_XGEN(b.x)], 1u);
      asm volatile("s_waitcnt vmcnt(0)" ::: "memory");
    } else {
      XB_SPIN(xb_ld(&bar[XB_XGEN(b.x)]) == gen, bar);
      __builtin_amdgcn_fence(__ATOMIC_ACQUIRE, "agent");
      asm volatile("s_waitcnt vmcnt(0)" ::: "memory");
    }
  }
  __syncthreads();
}

typedef int v4i32 __attribute__((ext_vector_type(4)));
typedef int v8i32 __attribute__((ext_vector_type(8)));
__device__ __forceinline__ v8i32 cat8(bf16x8 lo, bf16x8 hi) { return __builtin_shufflevector(__builtin_bit_cast(v4i32, lo), __builtin_bit_cast(v4i32, hi), 0, 1, 2, 3, 4, 5, 6, 7); }
__device__ __forceinline__ unsigned pk4_fp8(float a, float b, float c, float d) {
  int v = __builtin_amdgcn_cvt_pk_fp8_f32(a, b, 0, false);
  v = __builtin_amdgcn_cvt_pk_fp8_f32(c, d, v, true);
  return (unsigned)v;
}
namespace pg8 {
constexpr int BM = 256, BK = 64, HALF = 128, HTB = HALF * BK * 2, NXCD = 8, WGM = 8;
__device__ __forceinline__ int lds_byte(int r, int c) { const int st = (r >> 4) * 2 + (c >> 5), rr = r & 15, cc = c & 31, ob = rr * 64 + cc * 2; return st * 1024 + (ob ^ (((ob >> 9) & 1) << 5)); }
__device__ __forceinline__ void stage_rc(int b, int& R, int& C) { const int st = b / 1024, sb = b % 1024, swz = sb ^ (((sb >> 9) & 1) << 5); R = (st >> 1) * 16 + swz / 64; C = (st & 1) * 32 + (swz % 64) / 2; }
__device__ __forceinline__ int perm32(int rho) { const int n = rho >> 4, i = rho & 15; return 8 * (i >> 2) + 4 * n + (i & 3); }
struct Unit { const char* A; const char* B; int pm, pn, e, aux; };

template <class Epi, class Sched, int HOOK_T, bool GATHER = false, bool FP8 = false>
__device__ __forceinline__ void gemm_phase(LAS unsigned char* lds, const int K, const Sched& S, const Epi& E) {
  const int tid = otid(), wid = __builtin_amdgcn_readfirstlane(tid >> 6), lane = tid & 63, wr = wid >> 2, wc = wid & 3, fr = lane & 15, fq = lane >> 4;
  const int nt = K / BK;
  unsigned voffA[2], voffB[2];
#pragma unroll
  for (int i = 0; i < 2; ++i) { int R, C; stage_rc(tid * 16 + i * 8192, R, C); const int Rb = Epi::PERM ? ((R & ~31) + perm32(R & 31)) : R;
    voffA[i] = (unsigned)(R * K + C) * 2u; voffB[i] = (unsigned)(Rb * K + C) * 2u; }
  const size_t kstep = (size_t)(BK * 2);
  const size_t hstep = (size_t)HALF * K * 2;
  int gR[2]; unsigned gC[2];
#pragma unroll
  for (int i = 0; i < 2; ++i) { int R, C; stage_rc(tid * 16 + i * 8192, R, C); gR[i] = R; gC[i] = (unsigned)C * 2u; }
  unsigned vC[2][2], vN[2][2], vX[2][2];
  const unsigned ldsw = (unsigned)wid * 1024u;
  const int aoff = lds_byte(wr * 64 + fr, fq * 8), boff = lds_byte(wc * 32 + fr, fq * 8);
#define PG8_SA(b, h) (((b) * 2 + (h)) * HTB)
#define PG8_SB(b, h) ((4 + (b) * 2 + (h)) * HTB)
#define PG8_STAGE(bufoff, gbase, voff) do { _Pragma("unroll") for (int _i = 0; _i < 2; ++_i) \
        __builtin_amdgcn_global_load_lds((const unsigned*)((const char*)(gbase) + (voff)[_i]), (LAS unsigned*)(lds + (bufoff) + ldsw + _i * 8192), 16, 0, 0); } while (0)
#define PG8_STAGE_A(bufoff, gbase, h, V) do { if constexpr (GATHER) { PG8_STAGE(bufoff, gbase, (V)[h]); } else { PG8_STAGE(bufoff, (gbase) + (h) * hstep, voffA); } } while (0)
#define PG8_GOFF(V, U) do { if constexpr (GATHER) { _Pragma("unroll") for (int _h = 0; _h < 2; ++_h) _Pragma("unroll") for (int _i = 0; _i < 2; ++_i) \
        (V)[_h][_i] = (unsigned)S.arow(U, gR[_i] + 128 * _h) * (unsigned)(K * 2) + gC[_i]; } } while (0)
#define PG8_LDA(dst, b, h) do { _Pragma("unroll") for (int m = 0; m < 4; ++m) _Pragma("unroll") for (int k = 0; k < 2; ++k) dst[m][k] = *(const LAS bf16x8*)(lds + PG8_SA(b, h) + aoff + m * 2048 + k * 1024); } while (0)
#define PG8_LDB(dst, b, h) do { _Pragma("unroll") for (int n = 0; n < 2; ++n) _Pragma("unroll") for (int k = 0; k < 2; ++k) dst[n][k] = *(const LAS bf16x8*)(lds + PG8_SB(b, h) + boff + n * 2048 + k * 1024); } while (0)
#define PG8_MMA(ai, bj, At, Bt) do { __builtin_amdgcn_s_setprio(1); \
      if constexpr (FP8) { _Pragma("unroll") for (int m = 0; m < 4; ++m) _Pragma("unroll") for (int n = 0; n < 2; ++n) \
        asm volatile("v_mfma_f32_16x16x128_f8f6f4 %0, %1, %2, %0" : "+v"(acc[ai][bj][m][n]) : "v"(cat8(Bt[n][0], Bt[n][1])), "v"(cat8(At[m][0], At[m][1]))); } \
      else { _Pragma("unroll") for (int m = 0; m < 4; ++m) _Pragma("unroll") for (int n = 0; n < 2; ++n) _Pragma("unroll") for (int k = 0; k < 2; ++k) \
        acc[ai][bj][m][n] = __builtin_amdgcn_mfma_f32_16x16x32_bf16(Bt[n][k], At[m][k], acc[ai][bj][m][n], 0, 0, 0); } \
      __builtin_amdgcn_s_setprio(0); } while (0)
#define PG8_WAIT_V(n) asm volatile("s_waitcnt vmcnt(" #n ")" ::: "memory")
#define PG8_WAIT_L(n) asm volatile("s_waitcnt lgkmcnt(" #n ")" ::: "memory")
#define PG8_BAR __builtin_amdgcn_s_barrier()
#define PG8_SCHED __builtin_amdgcn_sched_barrier(0)
#define PG8_KBODY \
      const bool last = (t == nt - 2); \
      const char* a1 = cA + (size_t)(t + 1) * kstep; \
      const char* a2 = last ? nA : cA + (size_t)(t + 2) * kstep; const char* b2 = last ? nB : cB + (size_t)(t + 2) * kstep; \
      const char* a3 = a2 + kstep; const char* b3 = b2 + kstep; \
      if constexpr (GATHER) { _Pragma("unroll") for (int _h = 0; _h < 2; ++_h) _Pragma("unroll") for (int _i = 0; _i < 2; ++_i) vX[_h][_i] = last ? vN[_h][_i] : vC[_h][_i]; } \
      PG8_LDB(B0, 0, 0); PG8_LDB(B1, 0, 1); PG8_SCHED; PG8_LDA(At, 0, 0); PG8_STAGE_A(PG8_SA(1, 1), a1, 1, vC); \
      PG8_WAIT_V(8); PG8_WAIT_L(0); PG8_BAR; PG8_MMA(0, 0, At, B0); PG8_MMA(0, 1, At, B1); PG8_BAR; PG8_SCHED; \
      PG8_LDA(At, 0, 1); PG8_STAGE(PG8_SB(0, 0), b2, voffB); PG8_STAGE(PG8_SB(0, 1), b2 + hstep, voffB); PG8_STAGE_A(PG8_SA(0, 0), a2, 0, vX); \
      PG8_WAIT_V(8); PG8_WAIT_L(0); PG8_BAR; PG8_MMA(1, 0, At, B0); PG8_MMA(1, 1, At, B1); PG8_BAR; PG8_SCHED; \
      PG8_LDB(B0, 1, 0); PG8_LDB(B1, 1, 1); PG8_SCHED; PG8_LDA(At, 1, 0); PG8_STAGE_A(PG8_SA(0, 1), a2, 1, vX); \
      PG8_WAIT_V(8); PG8_WAIT_L(0); PG8_BAR; PG8_MMA(0, 0, At, B0); PG8_MMA(0, 1, At, B1); PG8_BAR; PG8_SCHED; \
      PG8_LDA(At, 1, 1); PG8_STAGE(PG8_SB(1, 0), b3, voffB); PG8_STAGE(PG8_SB(1, 1), b3 + hstep, voffB); PG8_STAGE_A(PG8_SA(1, 0), a3, 0, vX); \
      PG8_WAIT_V(8); PG8_WAIT_L(0); PG8_BAR; PG8_MMA(1, 0, At, B0); PG8_MMA(1, 1, At, B1); PG8_BAR; PG8_SCHED;
  Unit cur, nxt; int ui = 0;
  if (!S.next(0, cur)) return;
  f32x4 acc[2][2][4][2];
#pragma unroll
  for (int a = 0; a < 2; ++a)
#pragma unroll
    for (int b = 0; b < 2; ++b)
#pragma unroll
      for (int m = 0; m < 4; ++m)
#pragma unroll
        for (int n = 0; n < 2; ++n) acc[a][b][m][n] = (f32x4){0.f, 0.f, 0.f, 0.f};
  bf16x8 At[4][2], B0[2][2], B1[2][2];
  const char* cA = cur.A; const char* cB = cur.B;
  PG8_GOFF(vC, cur);
  PG8_STAGE(PG8_SB(0, 0), cB, voffB); PG8_STAGE(PG8_SB(0, 1), cB + hstep, voffB); PG8_STAGE_A(PG8_SA(0, 0), cA, 0, vC); PG8_STAGE_A(PG8_SA(0, 1), cA, 1, vC);
  if (wr == 1) PG8_BAR;
  PG8_WAIT_V(2); PG8_BAR;
  PG8_STAGE(PG8_SB(1, 0), cB + kstep, voffB); PG8_STAGE_A(PG8_SA(1, 0), cA + kstep, 0, vC); PG8_STAGE(PG8_SB(1, 1), cB + hstep + kstep, voffB);
  PG8_WAIT_V(6); PG8_BAR;
  for (;;) {
    const bool has_next = S.next(ui + 1, nxt);
    const char* nA = has_next ? nxt.A : cA; const char* nB = has_next ? nxt.B : cB;
    if constexpr (GATHER) { if (has_next) { PG8_GOFF(vN, nxt); } else { _Pragma("unroll") for (int _h = 0; _h < 2; ++_h) _Pragma("unroll") for (int _i = 0; _i < 2; ++_i) vN[_h][_i] = vC[_h][_i]; } }
    if constexpr (HOOK_T > 0) {
      _Pragma("unroll 1") for (int t = 0; t < HOOK_T; t += 2) { PG8_KBODY }
      E.hook(acc, cur, wr, wc, fr, fq);
      _Pragma("unroll 1") for (int t = HOOK_T; t < nt; t += 2) { PG8_KBODY }
    } else {
      _Pragma("unroll 1") for (int t = 0; t < nt; t += 2) { PG8_KBODY }
    }
    if constexpr (FP8) asm volatile("s_nop 15\n\ts_nop 15" ::: "memory");
    if (wr == 0) PG8_BAR;
    E(acc, cur, wr, wc, fr, fq);
    if (!has_next) break;
#pragma unroll
    for (int a = 0; a < 2; ++a)
#pragma unroll
      for (int b = 0; b < 2; ++b)
#pragma unroll
        for (int m = 0; m < 4; ++m)
#pragma unroll
          for (int n = 0; n < 2; ++n) acc[a][b][m][n] = (f32x4){0.f, 0.f, 0.f, 0.f};
    cur = nxt; cA = nA; cB = nB; ++ui;
    if constexpr (GATHER) { _Pragma("unroll") for (int _h = 0; _h < 2; ++_h) _Pragma("unroll") for (int _i = 0; _i < 2; ++_i) vC[_h][_i] = vN[_h][_i]; }
    if (wr == 1) PG8_BAR;
  }
  PG8_WAIT_V(0);
  PG8_BAR;
#undef PG8_SA
#undef PG8_SB
#undef PG8_STAGE
#undef PG8_STAGE_A
#undef PG8_GOFF
#undef PG8_LDA
#undef PG8_LDB
#undef PG8_MMA
#undef PG8_WAIT_V
#undef PG8_WAIT_L
#undef PG8_BAR
#undef PG8_SCHED
#undef PG8_KBODY
}

struct DenseSched {
  __device__ __forceinline__ int arow(const Unit&, int) const { return 0; }
  int nM, nN, nwg, G, c; const char* A; const char* B; size_t tstep;
  __device__ __forceinline__ void init(int nM_, int nN_, int G_, int c_, const void* A_, const void* B_, int K) { nM = nM_; nN = nN_; nwg = nM * nN; G = G_; c = c_; A = (const char*)A_; B = (const char*)B_; tstep = (size_t)BM * K * 2; }
  __device__ __forceinline__ bool next(int i, Unit& u) const {
    const long L = (long)i * G + c; if (L >= nwg) return false;
    int wgid = (int)L; { const int q = nwg / NXCD, r = nwg % NXCD, xcd = wgid % NXCD, off = wgid / NXCD; wgid = (xcd < r ? xcd * (q + 1) : r * (q + 1) + (xcd - r) * q) + off; }
    const int nig = WGM * nN, gid = wgid / nig, fm = gid * WGM, gsz = (nM - fm) < WGM ? (nM - fm) : WGM;
    u.pm = fm + ((wgid % nig) % gsz); u.pn = (wgid % nig) / gsz; u.e = 0; u.aux = 0;
    u.A = A + (size_t)u.pm * tstep; u.B = B + (size_t)u.pn * tstep; return true;
  }
};
struct SingleSched {
  Unit u0;
  __device__ __forceinline__ int arow(const Unit&, int) const { return 0; }
  __device__ __forceinline__ bool next(int i, Unit& u) const { if (i != 0) return false; u = u0; return true; }
};
struct MoeSched {
  int U, nN, G, c; const char* A; const char* B; size_t tstep, estep; volatile LAS int* tab; const int* list; bool gather;
  __device__ __forceinline__ int arow(const Unit& u, int r) const { const int rl = u.aux * 256 + r; return (rl < tab[96 + u.e]) ? (list[(size_t)u.e * NT + rl] >> 1) : 0; }
  __device__ __forceinline__ bool next(int i, Unit& u) const {
    const long L = (long)i * G + c; if (L >= U) return false;
    int w = (int)L; { const int q = U / NXCD, r = U % NXCD, xcd = w % NXCD, off = w / NXCD; w = (xcd < r ? xcd * (q + 1) : r * (q + 1) + (xcd - r) * q) + off; }
    int e = 0;
#pragma unroll 1
    for (int k = 1; k < 16; ++k) e += (w >= tab[k]) ? 1 : 0;
    const int local = w - tab[e], mt = tab[32 + e], tb = tab[64 + e];
    const int pn = local / mt, pml = local - pn * mt;
    u.e = __builtin_amdgcn_readfirstlane(e); u.aux = __builtin_amdgcn_readfirstlane(pml);
    u.pm = __builtin_amdgcn_readfirstlane(tb + pml); u.pn = __builtin_amdgcn_readfirstlane(pn);
    u.A = gather ? A : A + (size_t)u.pm * tstep; u.B = B + (size_t)u.e * estep + (size_t)u.pn * tstep; return true;
  }
};
}
using pg8::Unit;
typedef f32x4 AccT[2][2][4][2];

struct EpiProj {
  static constexpr bool PERM = true;
  bf16_t* O; float* lr32;
  __device__ __forceinline__ void operator()(const AccT& acc, const Unit& u, int wr, int wc, int fr, int fq) const {
    const int row0 = u.pm * 256 + wr * 64 + fr, col0 = u.pn * 256 + wc * 32 + 8 * fq;
    const bool lrt = (u.pn == 12) && (wc == 0);
#pragma unroll
    for (int ai = 0; ai < 2; ++ai)
#pragma unroll
      for (int m = 0; m < 4; ++m) {
        const int row = row0 + ai * 128 + m * 16;
        bf16_t* rowp = O + (size_t)row * PSTR + col0;
#pragma unroll
        for (int bj = 0; bj < 2; ++bj) {
          const f32x4 v0 = acc[ai][bj][m][0], v1 = acc[ai][bj][m][1];
          u32x4 w; w.x = pk2(v0[0], v0[1]); w.y = pk2(v0[2], v0[3]); w.z = pk2(v1[0], v1[1]); w.w = pk2(v1[2], v1[3]);
          *(u32x4*)(rowp + bj * 128) = w;
          if (bj == 0 && lrt) { float* lp = lr32 + (size_t)row * 32 + 8 * fq; *(f32x4*)lp = v0; *(f32x4*)(lp + 4) = v1; }
        }
      }
  }
  __device__ __forceinline__ void hook(AccT&, const Unit&, int, int, int, int) const {}
};
struct EpiMerge {
  static constexpr bool PERM = true;
  const bf16_t* proj; bf16_t* O;
  __device__ __forceinline__ void hook(AccT& acc, const Unit& u, int wr, int wc, int fr, int fq) const {
    const int row0 = u.pm * 256 + wr * 64 + fr, col0 = u.pn * 256 + wc * 32 + 8 * fq;
#pragma unroll
    for (int ai = 0; ai < 2; ++ai) {
      u32x4 g0[4][2], g1[4][2];
#pragma unroll
      for (int m = 0; m < 4; ++m) {
        const bf16_t* gp = proj + (size_t)(row0 + ai * 128 + m * 16) * PSTR + col0;
#pragma unroll
        for (int bj = 0; bj < 2; ++bj) { g0[m][bj] = *(const u32x4*)(gp + 4640 + bj * 128); g1[m][bj] = *(const u32x4*)(gp + 5664 + bj * 128); }
      }
#pragma unroll
      for (int m = 0; m < 4; ++m)
#pragma unroll
        for (int bj = 0; bj < 2; ++bj)
#pragma unroll
          for (int q = 0; q < 4; ++q) {
            const float a0 = bflo(g0[m][bj][q]), a1 = bfhi(g0[m][bj][q]), b0 = bflo(g1[m][bj][q]), b1 = bfhi(g1[m][bj][q]);
            const float r0 = (1.f + __expf(-b0)) * __builtin_amdgcn_rcpf(1.f + __expf(-a0)), r1 = (1.f + __expf(-b1)) * __builtin_amdgcn_rcpf(1.f + __expf(-a1));
            acc[ai][bj][m][q >> 1][(q & 1) * 2] *= r0; acc[ai][bj][m][q >> 1][(q & 1) * 2 + 1] *= r1;
          }
      __builtin_amdgcn_sched_barrier(0);
    }
  }
  __device__ __forceinline__ void operator()(const AccT& acc, const Unit& u, int wr, int wc, int fr, int fq) const {
    int row0 = u.pm * 256 + wr * 64 + fr; const int col0 = u.pn * 256 + wc * 32 + 8 * fq;
    asm volatile("" : "+v"(row0));
#pragma unroll
    for (int ai = 0; ai < 2; ++ai)
#pragma unroll
      for (int m = 0; m < 4; ++m) {
        const int row = row0 + ai * 128 + m * 16;
        const bf16_t* gp = proj + (size_t)row * PSTR + col0 + 5664;
        bf16_t* op = O + (size_t)row * 1024 + col0;
#pragma unroll
        for (int bj = 0; bj < 2; ++bj) {
          const u32x4 g1 = *(const u32x4*)(gp + bj * 128);
          float o[8];
#pragma unroll
          for (int q = 0; q < 4; ++q) {
            o[2 * q] = acc[ai][bj][m][q >> 1][(q & 1) * 2] * sigmoidf_(bflo(g1[q]));
            o[2 * q + 1] = acc[ai][bj][m][q >> 1][(q & 1) * 2 + 1] * sigmoidf_(bfhi(g1[q]));
          }
          u32x4 w; w.x = pk2(o[0], o[1]); w.y = pk2(o[2], o[3]); w.z = pk2(o[4], o[5]); w.w = pk2(o[6], o[7]);
          *(u32x4*)(op + bj * 128) = w;
        }
      }
  }
};
struct EpiOut {
  static constexpr bool PERM = true;
  bf16_t* Y;
  __device__ __forceinline__ void operator()(const AccT& acc, const Unit& u, int wr, int wc, int fr, int fq) const {
    const int row0 = u.pm * 256 + wr * 64 + fr, col0 = u.pn * 256 + wc * 32 + 8 * fq;
#pragma unroll
    for (int ai = 0; ai < 2; ++ai)
#pragma unroll
      for (int m = 0; m < 4; ++m) {
        bf16_t* yp = Y + (size_t)(row0 + ai * 128 + m * 16) * 1024 + col0;
#pragma unroll
        for (int bj = 0; bj < 2; ++bj) {
          const f32x4 v0 = acc[ai][bj][m][0], v1 = acc[ai][bj][m][1];
          u32x4 w; w.x = pk2(v0[0], v0[1]); w.y = pk2(v0[2], v0[3]); w.z = pk2(v1[0], v1[1]); w.w = pk2(v1[2], v1[3]);
          *(u32x4*)(yp + bj * 128) = w;
        }
      }
  }
  __device__ __forceinline__ void hook(AccT&, const Unit&, int, int, int, int) const {}
};
struct EpiMoe1 {
  static constexpr bool PERM = true;
  unsigned char* hid;
  __device__ __forceinline__ void operator()(const AccT& acc, const Unit& u, int wr, int wc, int fr, int fq) const {
    const int row0 = u.pm * 256 + wr * 64 + fr, hc0 = u.pn * 128 + wc * 16 + 4 * fq;
#pragma unroll
    for (int ai = 0; ai < 2; ++ai)
#pragma unroll
      for (int m = 0; m < 4; ++m) {
        unsigned char* hp = hid + (size_t)(row0 + ai * 128 + m * 16) * 1024 + hc0;
#pragma unroll
        for (int bj = 0; bj < 2; ++bj) {
          const f32x4 a = acc[ai][bj][m][0], b = acc[ai][bj][m][1];
          float hv[4];
#pragma unroll
          for (int j = 0; j < 4; ++j) hv[j] = __builtin_amdgcn_fmed3f(siluf_(a[j] * 0.0625f) * (b[j] * 0.5f), -440.f, 440.f);
          *(unsigned*)(hp + bj * 64) = pk4_fp8(hv[0], hv[1], hv[2], hv[3]);
        }
      }
  }
  __device__ __forceinline__ void hook(AccT&, const Unit&, int, int, int, int) const {}
};
struct EpiMoe2 {
  static constexpr bool PERM = true;
  bf16_t* yb; const int* list; const float* topw; volatile LAS int* tab;
  __device__ __forceinline__ void operator()(const AccT& acc, const Unit& u, int wr, int wc, int fr, int fq) const {
    const int rl0 = u.aux * 256 + wr * 64 + fr, col0 = u.pn * 256 + wc * 32 + 8 * fq;
    const int cnt = tab[96 + u.e];
    const int* lst = list + (size_t)u.e * NT;
#pragma unroll
    for (int ai = 0; ai < 2; ++ai)
#pragma unroll
      for (int m = 0; m < 4; ++m) {
        const int rl = rl0 + ai * 128 + m * 16;
        if (rl < cnt) {
          const int pr = lst[rl];
          const float tw = topw[pr] * (1.f / 128.f);
          bf16_t* op = yb + (size_t)pr * 1024 + col0;
#pragma unroll
          for (int bj = 0; bj < 2; ++bj) {
            const f32x4 v0 = acc[ai][bj][m][0] * tw, v1 = acc[ai][bj][m][1] * tw;
            u32x4 w; w.x = pk2(v0[0], v0[1]); w.y = pk2(v0[2], v0[3]); w.z = pk2(v1[0], v1[1]); w.w = pk2(v1[2], v1[3]);
            *(u32x4*)(op + bj * 128) = w;
          }
        }
      }
  }
  __device__ __forceinline__ void hook(AccT&, const Unit&, int, int, int, int) const {}
};

template <int MODE>
__device__ __forceinline__ void transpose_item(const float* W, int ldw, bf16_t* WT, int ldt, int koff, LAS float* scr, int kb, int nb, int lane) {
  const int k0 = 64 * kb, n0 = 32 * nb;
  {
    const int n4 = (lane & 7) * 4;
    f32x4 v[8];
#pragma unroll
    for (int i = 0; i < 8; ++i) v[i] = *(const f32x4*)(W + (size_t)(k0 + 8 * i + (lane >> 3)) * ldw + n0 + n4);
#pragma unroll
    for (int i = 0; i < 8; ++i) { LAS float* d = scr + (8 * i + (lane >> 3)) * 33 + n4; d[0] = v[i][0]; d[1] = v[i][1]; d[2] = v[i][2]; d[3] = v[i][3]; }
  }
  asm volatile("s_waitcnt lgkmcnt(0)" ::: "memory");
  const int c = lane & 7;
#pragma unroll
  for (int j = 0; j < 4; ++j) {
    const int n = (lane >> 3) + 8 * j; const LAS float* s = scr + (8 * c) * 33 + n;
    u32x4 o; o.x = pk2(s[0 * 33], s[1 * 33]); o.y = pk2(s[2 * 33], s[3 * 33]); o.z = pk2(s[4 * 33], s[5 * 33]); o.w = pk2(s[6 * 33], s[7 * 33]);
    const int ng = n0 + n;
    const int dr = (MODE == 0) ? ng : ((ng >> 2) * 8 + (ng & 3) + (MODE == 2 ? 4 : 0));
    *(u32x4*)(WT + (size_t)dr * ldt + koff + k0 + 8 * c) = o;
  }
  asm volatile("s_waitcnt lgkmcnt(0)" ::: "memory");
}

template <int MODE>
__device__ __forceinline__ void transpose_item_fp8(const float* W, int ldw, unsigned char* WT, int ldt, LAS float* scr, int kb, int nb, int lane) {
  const int k0 = 64 * kb, n0 = 32 * nb;
  {
    const int n4 = (lane & 7) * 4;
    f32x4 v[8];
#pragma unroll
    for (int i = 0; i < 8; ++i) v[i] = *(const f32x4*)(W + (size_t)(k0 + 8 * i + (lane >> 3)) * ldw + n0 + n4);
#pragma unroll
    for (int i = 0; i < 8; ++i) { LAS float* d = scr + (8 * i + (lane >> 3)) * 33 + n4; d[0] = v[i][0]; d[1] = v[i][1]; d[2] = v[i][2]; d[3] = v[i][3]; }
  }
  asm volatile("s_waitcnt lgkmcnt(0)" ::: "memory");
  const int c = lane & 7;
#pragma unroll
  for (int j = 0; j < 4; ++j) {
    const int n = (lane >> 3) + 8 * j; const LAS float* sp = scr + (8 * c) * 33 + n;
    u32x2 o; o.x = pk4_fp8(16.f * sp[0 * 33], 16.f * sp[1 * 33], 16.f * sp[2 * 33], 16.f * sp[3 * 33]); o.y = pk4_fp8(16.f * sp[4 * 33], 16.f * sp[5 * 33], 16.f * sp[6 * 33], 16.f * sp[7 * 33]);
    const int ng = n0 + n;
    const int dr = (MODE == 0) ? ng : ((ng >> 2) * 8 + (ng & 3) + (MODE == 2 ? 4 : 0));
    *(u32x2*)(WT + (size_t)dr * ldt + k0 + 8 * c) = o;
  }
  asm volatile("s_waitcnt lgkmcnt(0)" ::: "memory");
}
__device__ void ph_init(const Params& p, LAS unsigned char* lds, int bid, int nb) {
  WS_LOCAL
  const int tid = otid(), wave = tid >> 6, lane = tid & 63;
  LAS float* sc = (LAS float*)(lds + 8 * 8448);
  for (int i = tid; i < 3 * 1024; i += NTHR) {
    int r = i >> 10, k = i & 1023;
    float v = (r < 2) ? KARG(const float, 1)[r * 1024 + k] : KARG(const float, 3)[k];
    sc[i] = v / (1.f + expf(-v));
  }
  __syncthreads();
  LAS float* scr = (LAS float*)(lds + wave * 8448);
  const int gw = bid * NWAVES + wave, NGW = nb * NWAVES;
  constexpr int I_ADA = 2 * 24 * 32, I_IN = 16 * 209, I_MG = 16 * 32, I_MN = 8 * 32, I_O = 16 * 32, I_PAD = 224, I_ROPE = 64;
  constexpr int NITEMS = I_ADA + 2 * (I_IN + I_MG + I_MN + I_O + I_PAD) + I_ROPE;
  for (int it = gw; it < NITEMS; it += NGW) {
    int r = it;
    if (r < I_ADA) {
      const int l = r / 768, cb = (r % 768) >> 5, ks = r & 31, col0 = cb * 256 + lane * 4;
      const float* w = KARG(const float, 4) + ((size_t)l * 1024 + ks * 32) * 6144 + col0;
      f32x4 wv[32];
#pragma unroll
      for (int i = 0; i < 32; ++i) wv[i] = __builtin_nontemporal_load((const f32x4*)(w + (size_t)i * 6144));
      f32x4 a0 = {0.f, 0.f, 0.f, 0.f}, a1 = a0, a2 = a0;
#pragma unroll
      for (int i = 0; i < 32; ++i) { const int k = ks * 32 + i; a0 += sc[k] * wv[i]; a1 += sc[1024 + k] * wv[i]; a2 += sc[2048 + k] * wv[i]; }
      float* part = WSP(float, WS_APART) + ((size_t)(l * 32 + ks) * 3) * 6144 + col0;
      *(f32x4*)(part) = a0; *(f32x4*)(part + 6144) = a1; *(f32x4*)(part + 2 * 6144) = a2;
      continue;
    }
    r -= I_ADA;
    if (r < I_ROPE) {
      const int idx = r * 64 + lane, pos = idx >> 5, i = idx & 31;
      const float inv = exp2f(-(float)i * (13.287712379549449f / 32.f)), ang = (float)pos * inv;
      const float kk = rintf(ang * 0.15915494309189535f);
      float rr = fmaf(-kk, 6.2831854820251465f, ang); rr = fmaf(-kk, -1.7484556000744883e-07f, rr);
      WSP(float, WS_ROPE)[idx * 2] = cosf(rr); WSP(float, WS_ROPE)[idx * 2 + 1] = sinf(rr);
      continue;
    }
    r -= I_ROPE;
    const int per = I_IN + I_MG + I_MN + I_O + I_PAD;
    const int l = r / per; r -= l * per;
    if (r < I_IN) { transpose_item<0>(KARG(const float, 8) + (size_t)l * 1024 * INC, INC, WSP(bf16_t, WS_WINT) + (size_t)l * PSTR * 1024, 1024, 0, scr, r / 209, r % 209, lane); continue; } r -= I_IN;
    if (r < I_MG) { transpose_item<0>(KARG(const float, 13) + (size_t)l * 1024 * 1024, 1024, WSP(bf16_t, WS_WMT) + (size_t)l * 1024 * GSTR, GSTR, 0, scr, r / 32, r % 32, lane); continue; } r -= I_MG;
    if (r < I_MN) { transpose_item<0>(KARG(const float, 14) + (size_t)l * 512 * 1024, 1024, WSP(bf16_t, WS_WMT) + (size_t)l * 1024 * GSTR, GSTR, 1024, scr, r / 32, r % 32, lane); continue; } r -= I_MN;
    if (r < I_O) { transpose_item<0>(KARG(const float, 15) + (size_t)l * 1024 * 1024, 1024, WSP(bf16_t, WS_WOT) + (size_t)l * 1024 * 1024, 1024, 0, scr, r / 32, r % 32, lane); continue; } r -= I_O;
    {
      unsigned zz = 0u; asm volatile("" : "+v"(zz));
      u32x4 z = {zz, zz, zz, zz};
      u32x4* dst = (u32x4*)(WSP(bf16_t, WS_WINT) + (size_t)l * PSTR * 1024 + (size_t)(INC + r) * 1024);
      dst[lane] = z; dst[lane + 64] = z;
    }
  }
}
__device__ void ph_ada_reduce(const Params& p, int bid, int nb) {
  WS_LOCAL
  const int tid = otid(), wave = tid >> 6, lane = tid & 63;
  for (int it = bid * NWAVES + wave; it < 48; it += nb * NWAVES) {
    const int l = it / 24, cb = it % 24, col0 = cb * 256 + lane * 4;
    const float* pb = WSP(float, WS_APART) + ((size_t)(l * 32) * 3) * 6144 + col0;
    const f32x4 bb = *(const f32x4*)(KARG(const float, 5) + l * 6144 + col0);
#pragma unroll
    for (int rr = 0; rr < 3; ++rr) {
      f32x4 sum = bb;
#pragma unroll
      for (int k8 = 0; k8 < 32; ++k8) sum += *(const f32x4*)(pb + ((size_t)k8 * 3 + rr) * 6144);
      *(f32x4*)(WSP(float, WS_MOD) + (l * 3 + rr) * 6144 + col0) = sum;
    }
  }
}
__device__ void ph_experts(const Params& p, int l, LAS unsigned char* lds, int bid, int nb) {
  WS_LOCAL
  const int tid = otid(), wave = tid >> 6, lane = tid & 63;
  LAS float* scr = (LAS float*)(lds + wave * 8448);
  const int skipb = (l == 0) ? 16 : 0;
  if (bid < skipb) return;
  const int gw = (bid - skipb) * NWAVES + wave, NGW = (nb - skipb) * NWAVES;
  for (int it = gw; it < 16 * 3 * 512; it += NGW) {
    const int e = it / 1536, r = it % 1536, mat = r / 512, q = r % 512;
    const size_t eo = ((size_t)(l * 16 + e)) << 20;
    if (mat == 0) transpose_item_fp8<1>(KARG(const float, 18) + eo, 1024, WSP(unsigned char, WS_RG) + ((size_t)e << 21), 1024, scr, q / 32, q % 32, lane);
    else if (mat == 1) transpose_item_fp8<2>(KARG(const float, 19) + eo, 1024, WSP(unsigned char, WS_RG) + ((size_t)e << 21), 1024, scr, q / 32, q % 32, lane);
    else transpose_item_fp8<0>(KARG(const float, 20) + eo, 1024, WSP(unsigned char, WS_W2F8) + ((size_t)e << 20), 1024, scr, q / 32, q % 32, lane);
  }
}

__device__ void ph_norm1(const Params& p, int l, int bid, int nb) {
  WS_LOCAL
  const int tid = otid(), wave = tid >> 6, lane = tid & 63;
  const int NGW = nb * NWAVES;
  for (int rowa = bid * NWAVES + wave; rowa < NT; rowa += 2 * NGW) {
    f32x4 v[2][4];
    int rows[2]; rows[0] = rowa; rows[1] = rowa + NGW;
    const bool has2 = rows[1] < NT;
    if (!has2) rows[1] = rowa;
#pragma unroll
    for (int u = 0; u < 2; ++u) {
      const int row = rows[u];
      if (l == 0) {
        const float* src = (row < NL) ? KARG(const float, 0) + (size_t)row * 1024 : KARG(const float, 2) + (size_t)(row - NL) * 1024;
#pragma unroll
        for (int i = 0; i < 4; ++i) v[u][i] = __builtin_nontemporal_load((const f32x4*)(src + i * 256 + lane * 4));
      } else {
        const int r = (row < NL) ? (row >> 13) : 2;
        const float* src = WSP(float, WS_XBUF) + (size_t)row * 1024;
        const float* m5 = WSP(float, WS_MOD) + (0 * 3 + r) * 6144 + 5 * 1024;
        const bf16_t* y0 = WSP(bf16_t, WS_PROJ + 2 * PROWS * 2048) + (size_t)(row * 2) * 1024;
#pragma unroll
        for (int i = 0; i < 4; ++i) {
          const int j = i * 256 + lane * 4;
          v[u][i] = *(const f32x4*)(src + j);
          const u32x2 ya = __builtin_nontemporal_load((const u32x2*)(y0 + j)), yb = __builtin_nontemporal_load((const u32x2*)(y0 + 1024 + j));
          const f32x4 g = *(const f32x4*)(m5 + j);
          v[u][i][0] += g[0] * (bflo(ya.x) + bflo(yb.x)); v[u][i][1] += g[1] * (bfhi(ya.x) + bfhi(yb.x));
          v[u][i][2] += g[2] * (bflo(ya.y) + bflo(yb.y)); v[u][i][3] += g[3] * (bfhi(ya.y) + bfhi(yb.y));
        }
      }
    }
#pragma unroll
    for (int u = 0; u < 2; ++u) {
      if (u == 1 && !has2) break;
      const int row = rows[u];
      const int r = (row < NL) ? (row >> 13) : 2;
      float ss = 0.f;
#pragma unroll
      for (int i = 0; i < 4; ++i) ss += v[u][i][0] * v[u][i][0] + v[u][i][1] * v[u][i][1] + v[u][i][2] * v[u][i][2] + v[u][i][3] * v[u][i][3];
      ss = wave_sum(ss);
      const float rstd = rsqrtf(ss * (1.f / 1024.f) + 1e-6f);
      const float* md = WSP(float, WS_MOD) + (l * 3 + r) * 6144;
      const float* nw = KARG(const float, 6) + l * 1024;
#pragma unroll
      for (int i = 0; i < 4; ++i) {
        const int j = i * 256 + lane * 4;
        const f32x4 w = *(const f32x4*)(nw + j), m1 = *(const f32x4*)(md + 1024 + j), m0 = *(const f32x4*)(md + j);
        f32x4 h;
#pragma unroll
        for (int q = 0; q < 4; ++q) h[q] = v[u][i][q] * rstd * w[q] * (1.f + m1[q]) + m0[q];
        u32x2 o; o.x = pk2(h[0], h[1]); o.y = pk2(h[2], h[3]);
        *(u32x2*)(WSP(bf16_t, WS_HM) + (size_t)row * 1024 + j) = o;
        if (l != 0) *(f32x4*)(WSP(float, WS_XBUF) + (size_t)row * 1024 + j) = v[u][i];
      }
    }
  }
}

typedef short s16x4 __attribute__((ext_vector_type(4)));
__device__ __forceinline__ s16x4 ds_tr(const LAS unsigned char* p) { return __builtin_amdgcn_ds_read_tr16_b64_v4i16((LAS s16x4*)p); }
#define NA_RS 144
#define NAU 4
__device__ void na_wave_task(const Params& p, int l, LAS unsigned char* vlb, LAS unsigned char* vl, int task, int lane) {
  WS_LOCAL
  const int fr = lane & 15, g = lane >> 4, q4 = fr >> 2, p4 = fr & 3;
  constexpr int NLAT = 2 * (128 / NAU) * 4 * 8;
  int b, h, nloc, jg = 0, cb = 0, rbase = 0, rmin = 0;
  int qrow[NAU], ru[NAU], r0u[NAU];
  if (task < NLAT) {
    h = task & 7; jg = (task >> 3) & 3; const int rg = (task >> 5) % (128 / NAU); b = task / (32 * (128 / NAU));
    rbase = rg * NAU; cb = (jg == 0) ? 0 : (jg == 1) ? 8 : (jg == 2) ? 24 : 32;
#pragma unroll
    for (int u = 0; u < NAU; ++u) { ru[u] = rbase + u; r0u[u] = min(max(ru[u] - 4, 0), 120); qrow[u] = b * 8192 + ru[u] * 64 + 16 * jg; }
    rmin = r0u[0]; nloc = r0u[NAU - 1] + 8 - rmin;
  } else {
    const int t2 = task - NLAT; h = t2 & 7; const int qg = (t2 >> 3) % (16 / NAU); b = t2 / (8 * (16 / NAU));
#pragma unroll
    for (int u = 0; u < NAU; ++u) { ru[u] = 0; r0u[u] = 0; qrow[u] = NL + b * 256 + (qg * NAU + u) * 16; }
    nloc = 0;
  }
  const bf16_t* pj = WSP(bf16_t, WS_PROJ);
  bf16x8 qf[NAU][2];
#pragma unroll
  for (int u = 0; u < NAU; ++u)
#pragma unroll
    for (int ks = 0; ks < 2; ++ks) qf[u][ks] = *(const bf16x8*)(pj + (size_t)(qrow[u] + fr) * PSTR + 3104 + h * 64 + 32 * ks + 8 * g);
  const LAS float* rp = (const LAS float*)(vlb + 40960) + h * 465;
  const int cq = 16 * jg + fr, c0 = min(max(cq - 8, 0), 48);
  f32x4 oacc[NAU][4];
#pragma unroll
  for (int u = 0; u < NAU; ++u)
#pragma unroll
    for (int c = 0; c < 4; ++c) oacc[u][c] = (f32x4){0.f, 0.f, 0.f, 0.f};
  float mrun[NAU], lsum[NAU];
#pragma unroll
  for (int u = 0; u < NAU; ++u) { mrun[u] = -1e30f; lsum[u] = 0.f; }
  const int nst = nloc + 8;
#pragma unroll 1
  for (int st = 0; st < nst; ++st) {
    const bool loc = st < nloc;
    const int kr = rmin + st;
    const int kbase = loc ? (b * 8192 + kr * 64 + cb) : (NL + b * 256 + (st - nloc) * 32);
    bf16x8 kf[2][2]; u32x4 vv[4];
#pragma unroll
    for (int tb = 0; tb < 2; ++tb)
#pragma unroll
      for (int ks = 0; ks < 2; ++ks) kf[tb][ks] = *(const bf16x8*)(pj + (size_t)(kbase + 16 * tb + fr) * PSTR + 3616 + h * 64 + 32 * ks + 8 * g);
#pragma unroll
    for (int i = 0; i < 4; ++i) { const int ci = lane + 64 * i, key = ci >> 3, dch = ci & 7; vv[i] = *(const u32x4*)(pj + (size_t)(kbase + key) * PSTR + 4128 + h * 64 + dch * 8); }
    bool okc[8]; int cix[8];
#pragma unroll
    for (int k = 0; k < 8; ++k) { const int kc = cb + 16 * (k >> 2) + 4 * g + (k & 3); okc[k] = (kc >= c0) && (kc < c0 + 16); cix[k] = min(max(kc - cq + 15, 0), 30); }
#pragma unroll
    for (int i = 0; i < 4; ++i) { const int ci = lane + 64 * i, key = ci >> 3, dch = ci & 7; *(LAS u32x4*)(vl + key * NA_RS + dch * 16) = vv[i]; }
    bf16x8 pf[NAU];
#pragma unroll
    for (int u = 0; u < NAU; ++u) {
      f32x4 sc[2];
#pragma unroll
      for (int tb = 0; tb < 2; ++tb) {
        sc[tb] = __builtin_amdgcn_mfma_f32_16x16x32_bf16(kf[tb][0], qf[u][0], (f32x4){0.f, 0.f, 0.f, 0.f}, 0, 0, 0);
        sc[tb] = __builtin_amdgcn_mfma_f32_16x16x32_bf16(kf[tb][1], qf[u][1], sc[tb], 0, 0, 0);
      }
      float sv[8]; float mst = -1e30f;
      if (loc) {
        const bool rowok = (kr >= r0u[u]) && (kr < r0u[u] + 8);
        const LAS float* rrow = rp + min(max(kr - ru[u] + 7, 0), 14) * 31;
        float bias[8];
#pragma unroll
        for (int k = 0; k < 8; ++k) bias[k] = rrow[cix[k]];
        asm volatile("" : "+v"(bias[0]), "+v"(bias[1]), "+v"(bias[2]), "+v"(bias[3]), "+v"(bias[4]), "+v"(bias[5]), "+v"(bias[6]), "+v"(bias[7]));
#pragma unroll
        for (int k = 0; k < 8; ++k) { const float v = (okc[k] && rowok) ? sc[k >> 2][k & 3] * 0.125f + bias[k] : -INFINITY; sv[k] = v; mst = fmaxf(mst, v); }
      } else {
#pragma unroll
        for (int k = 0; k < 8; ++k) { const float v = sc[k >> 2][k & 3] * 0.125f; sv[k] = v; mst = fmaxf(mst, v); }
      }
      mst = fmaxf(mst, __shfl_xor(mst, 16, 64)); mst = fmaxf(mst, __shfl_xor(mst, 32, 64));
      const float mnew = fmaxf(mrun[u], mst); const float alpha = __expf(mrun[u] - mnew); mrun[u] = mnew;
      float ps = 0.f; float pv[8];
#pragma unroll
      for (int k = 0; k < 8; ++k) { const float e = __expf(sv[k] - mnew); pv[k] = e; ps += e; }
      lsum[u] = lsum[u] * alpha + ps;
#pragma unroll
      for (int c = 0; c < 4; ++c) oacc[u][c] *= alpha;
#pragma unroll
      for (int q = 0; q < 4; ++q) { const unsigned w = pk2(pv[2 * q], pv[2 * q + 1]); pf[u][2 * q] = (short)(w & 0xffffu); pf[u][2 * q + 1] = (short)(w >> 16); }
    }
    asm volatile("s_waitcnt lgkmcnt(0)" ::: "memory");
#pragma unroll
    for (int c = 0; c < 4; ++c) {
      const s16x4 lo = ds_tr(vl + (4 * g + q4) * NA_RS + (16 * c + 4 * p4) * 2);
      const s16x4 hi = ds_tr(vl + (16 + 4 * g + q4) * NA_RS + (16 * c + 4 * p4) * 2);
      bf16x8 vf; vf[0] = lo[0]; vf[1] = lo[1]; vf[2] = lo[2]; vf[3] = lo[3]; vf[4] = hi[0]; vf[5] = hi[1]; vf[6] = hi[2]; vf[7] = hi[3];
#pragma unroll
      for (int u = 0; u < NAU; ++u) oacc[u][c] = __builtin_amdgcn_mfma_f32_16x16x32_bf16(vf, pf[u], oacc[u][c], 0, 0, 0);
    }
    asm volatile("s_waitcnt lgkmcnt(0)" ::: "memory");
  }
#pragma unroll
  for (int u = 0; u < NAU; ++u) {
    float ls = lsum[u];
    ls += __shfl_xor(ls, 16, 64); ls += __shfl_xor(ls, 32, 64);
    const float inv = 1.f / ls;
    bf16_t* op = WSP(bf16_t, WS_GM) + (size_t)(qrow[u] + fr) * GSTR + 1024 + h * 64 + 4 * g;
#pragma unroll
    for (int c = 0; c < 4; ++c) {
      u32x2 w; w.x = pk2(oacc[u][c][0] * inv, oacc[u][c][1] * inv); w.y = pk2(oacc[u][c][2] * inv, oacc[u][c][3] * inv);
      *(u32x2*)(op + 16 * c) = w;
    }
  }
}
__device__ void na_phase(const Params& p, int l, LAS unsigned char* lds, int bid, int nb, int mode) {
  WS_LOCAL
  const int tid = otid(), wave = tid >> 6, lane = tid & 63;
  LAS unsigned char* vlb = lds + 4096;
  LAS unsigned char* vl = vlb + wave * 4608;
  constexpr int NLAT = 2 * (128 / NAU) * 4 * 8, NCTX = 2 * (16 / NAU) * 8;
  int t0, t1, ts;
  if (mode == 0) {
    LAS float* rl = (LAS float*)(vlb + 40960);
    const float* rg = KARG(const float, 12) + (size_t)l * 8 * 465;
    for (int k = tid; k < 8 * 465; k += NTHR) rl[k] = rg[k];
    t0 = bid * NWAVES + wave; t1 = NLAT; ts = nb * NWAVES;
  } else {
    const bool on = (l == 0) && (bid >= 32) && (bid < 32 + NCTX / NWAVES);
    t0 = NLAT + (bid - 32) * NWAVES + wave; t1 = on ? NLAT + NCTX : 0; ts = NLAT + NCTX;
  }
  __syncthreads();
  for (int t = t0; t < t1; t += ts) na_wave_task(p, l, vlb, vl, t, lane);
  __syncthreads();
}
#define G_LRS 0
#define G_TOT 8192
#define G_RED 10240
#define G_VT 12288
#define G_KT 46080
#define G_QB 63488
#define G_QE 80896
#define G_ATT 98304
#define G_RK 107520
#define G_RQ (MISC_OFF + 2048)
#define VRS 528
#define KRS 272
#define ARS 144
__device__ __forceinline__ void gla_load_w(const Params& p, int l, int hd, int tid, float (&w)[2][17]) {
  WS_LOCAL
  const int d = tid & 127;
#pragma unroll
  for (int dir = 0; dir < 2; ++dir) {
#pragma unroll
    for (int r = 0; r < 16; ++r) w[dir][r] = KARG(const float, 9)[((size_t)(l * 2 + dir) * 16 + r) * 512 + hd * 128 + d];
    w[dir][16] = KARG(const float, 10)[(l * 2 + dir) * 512 + hd * 128 + d];
  }
}
template <bool FULL>
__device__ __forceinline__ void gla_prep(const Params& p, int l, LAS unsigned char* lds, int hd, int dir, int tid, const float (&w)[17], float* dbout, int kt_off, int tot_off) {
  WS_LOCAL
  const int d = tid & 127, sq = tid >> 7;
  LAS float* lrs = (LAS float*)(lds + G_LRS); LAS float* tot = (LAS float*)(lds + tot_off);
  const float bgk = w[16];
  float pre[16];
#pragma unroll
  for (int i = 0; i < 16; i += 2) {
    const LAS float* lr = lrs + (dir * 16) * 64 + 16 * sq + i;
    f32x2 z = {bgk, bgk};
#pragma unroll
    for (int r = 0; r < 16; ++r) z += *(const LAS f32x2*)(lr + r * 64) * w[r];
    pre[i] = (fminf(z[0], 0.f) - __logf(1.f + __expf(-fabsf(z[0])))) * (1.f / 16.f);
    pre[i + 1] = (fminf(z[1], 0.f) - __logf(1.f + __expf(-fabsf(z[1])))) * (1.f / 16.f);
  }
  if (dir == 0) {
#pragma unroll
    for (int i = 1; i < 16; ++i) pre[i] += pre[i - 1];
  } else {
#pragma unroll
    for (int i = 14; i >= 0; --i) pre[i] += pre[i + 1];
  }
  tot[sq * 128 + d] = (dir == 0) ? pre[15] : pre[0];
  __syncthreads();
  const float t0 = tot[d], t1 = tot[128 + d], t2 = tot[256 + d], t3 = tot[384 + d];
  const float Btot = (t0 + t1) + (t2 + t3);
  float offs;
  if (dir == 0) offs = (sq > 0 ? t0 : 0.f) + (sq > 1 ? t1 : 0.f) + (sq > 2 ? t2 : 0.f);
  else offs = (sq < 3 ? t3 : 0.f) + (sq < 2 ? t2 : 0.f) + (sq < 1 ? t1 : 0.f);
  if (dbout != nullptr && sq == 0) dbout[d] = __expf(Btot);
  LAS unsigned char* kt = lds + kt_off; LAS unsigned char* qb = lds + G_QB; LAS unsigned char* qe = lds + G_QE;
#pragma unroll
  for (int i = 0; i < 16; ++i) {
    const int s = 16 * sq + i;
    const float bs = offs + pre[i];
    *(LAS bf16_t*)(kt + s * KRS + d * 2) = f2bf(bf2f(*(const LAS bf16_t*)(lds + G_RK + (s * 128 + d) * 2)) * __expf(Btot - bs));
    if (FULL) {
      const float qv = bf2f(*(const LAS bf16_t*)(lds + G_RQ + (s * 128 + d) * 2));
      *(LAS bf16_t*)(qb + s * KRS + d * 2) = f2bf(qv * __expf(bs));
      *(LAS bf16_t*)(qe + s * KRS + d * 2) = f2bf(qv * __expf(bs - Btot));
    }
  }
}
__device__ __forceinline__ u32x4 rope8(u32x4 self, u32x4 part, const float* tb, bool lower, float scale) {
  u32x4 o;
#pragma unroll
  for (int q = 0; q < 4; ++q) {
    const f32x4 cssn = *(const f32x4*)(tb + 4 * q);
    const float s0 = bflo(self[q]), s1 = bfhi(self[q]), p0 = bflo(part[q]), p1 = bfhi(part[q]);
    const float r0 = lower ? (s0 * cssn[0] - p0 * cssn[1]) : (p0 * cssn[1] + s0 * cssn[0]);
    const float r1 = lower ? (s1 * cssn[2] - p1 * cssn[3]) : (p1 * cssn[3] + s1 * cssn[2]);
    o[q] = pk2(r0 * scale, r1 * scale);
  }
  return o;
}
struct ChunkRegs { f32x4 lv; u32x4 vv[4], ks[2]; };
template <bool FULL>
__device__ __forceinline__ void gla_issue(const Params& p, int row0, int hd, int c, int tid_, ChunkRegs& R) {
  WS_LOCAL
  int tid = tid_; asm volatile("" : "+v"(tid));
  { const int r = tid >> 3, c4 = (tid & 7) * 4; R.lv = *(const f32x4*)(WSP(float, WS_LR32) + (size_t)(row0 + r) * 32 + c4); }
#pragma unroll
  for (int i = 0; i < 4; ++i) { const int ci = tid + 512 * i, r = ci >> 5, ch = ci & 31; R.vv[i] = *(const u32x4*)(WSP(bf16_t, WS_PROJ) + (size_t)(row0 + r) * PSTR + 1024 + hd * 256 + ch * 8); }
#pragma unroll
  for (int i = 0; i < 2; ++i) {
    const int ci = tid + 512 * i, r = ci >> 4, ch = ci & 15;
    const bf16_t* rowp = WSP(bf16_t, WS_PROJ) + (size_t)(row0 + r) * PSTR + hd * 128;
    if (!FULL) R.ks[i] = *(const u32x4*)(rowp + 512 + ch * 8);
  }
}
template <bool FULL>
__device__ __forceinline__ void gla_commit(const Params& p, LAS unsigned char* lds, int row0, int hd, int c, int tid_, const ChunkRegs& R) {
  WS_LOCAL
  int tid = tid_; asm volatile("" : "+v"(tid));
  { const int r = tid >> 3, c4 = (tid & 7) * 4; LAS float* lt = (LAS float*)(lds + G_LRS) + c4 * 64 + r; lt[0] = R.lv[0]; lt[64] = R.lv[1]; lt[128] = R.lv[2]; lt[192] = R.lv[3]; }
  const bool isctx = c < 4; const int cl = c - 4;
#pragma unroll
  for (int i = 0; i < 2; ++i) {
    const int ci = tid + 512 * i, r = ci >> 4, ch = ci & 15, chp = ch ^ 4;
    const bool lower = (ch & 7) < 4;
    const float* tb = WSP(float, WS_ROPE) + ((size_t)((ch < 8) ? cl : r) * 32 + ((8 * ch) & 31)) * 2;
    const bf16_t* rowp = WSP(bf16_t, WS_PROJ) + (size_t)(row0 + r) * PSTR + hd * 128;
    u32x4 ks = FULL ? *(const u32x4*)(rowp + 512 + ch * 8) : R.ks[i];
    if (!isctx) ks = rope8(ks, *(const u32x4*)(rowp + 512 + chp * 8), tb, lower, 1.f);
    *(LAS u32x4*)(lds + G_RK + ci * 16) = ks;
    if (FULL) {
      u32x4 qs = *(const u32x4*)(rowp + ch * 8);
      if (!isctx) qs = rope8(qs, *(const u32x4*)(rowp + chp * 8), tb, lower, 0.08838834764831845f);
      else {
#pragma unroll
        for (int q = 0; q < 4; ++q) qs[q] = pk2(bflo(qs[q]) * 0.08838834764831845f, bfhi(qs[q]) * 0.08838834764831845f);
      }
      *(LAS u32x4*)(lds + G_RQ + ci * 16) = qs;
    }
  }
#pragma unroll
  for (int i = 0; i < 4; ++i) { const int ci = tid + 512 * i, r = ci >> 5, ch = ci & 31; *(LAS u32x4*)(lds + G_VT + r * VRS + ch * 16) = R.vv[i]; }
}
__device__ __forceinline__ bf16x8 tr8(const LAS unsigned char* base, int rs, int r0, int q4, int cbyte) {
  const s16x4 lo = ds_tr(base + (r0 + q4) * rs + cbyte), hi = ds_tr(base + (r0 + 4 + q4) * rs + cbyte);
  bf16x8 v; v[0] = lo[0]; v[1] = lo[1]; v[2] = lo[2]; v[3] = lo[3]; v[4] = hi[0]; v[5] = hi[1]; v[6] = hi[2]; v[7] = hi[3];
  return v;
}
__device__ void gla_passA(const Params& p, int l, LAS unsigned char* lds, int bid, int nb) {
  WS_LOCAL
  const int tid = otid(), wave = tid >> 6, lane = tid & 63, fr = lane & 15, g = lane >> 4, q4 = fr >> 2, p4 = fr & 3;
  bf16_t* SB = (bf16_t*)WSP(float, WS_RG);
  ChunkRegs R; float wv[2][17];
  if (bid < 1056) {
    const int c = bid % 132, bh = bid / 132, b = bh >> 2, hd = bh & 3;
    gla_issue<false>(p, (c < 4) ? (NL + b * 256 + c * 64) : (b * 8192 + (c - 4) * 64), hd, c, tid, R);
  }
  for (int task = bid; task < 1056; task += nb) {
    const int c = task % 132, bh = task / 132, b = bh >> 2, hd = bh & 3;
    gla_load_w(p, l, hd, tid, wv);
    gla_commit<false>(p, lds, (c < 4) ? (NL + b * 256 + c * 64) : (b * 8192 + (c - 4) * 64), hd, c, tid, R);
    __syncthreads();
#pragma unroll
    for (int dir = 0; dir < 2; ++dir) {
      float wd[17];
#pragma unroll
      for (int r = 0; r < 17; ++r) wd[r] = wv[dir][r];
      gla_prep<false>(p, l, lds, hd, dir, tid, wd, WSP(float, WS_DB) + (size_t)((bh * 2 + dir) * 132 + c) * 128, dir ? G_QB : G_KT, dir ? G_RED : G_TOT);
    }
    __syncthreads();
    if (task + nb < 1056) {
      const int tn = task + nb, cn = tn % 132, bhn = tn / 132, bn = bhn >> 2, hdn = bhn & 3;
      gla_issue<false>(p, (cn < 4) ? (NL + bn * 256 + cn * 64) : (bn * 8192 + (cn - 4) * 64), hdn, cn, tid, R);
    }
    {
      bf16x8 af[2][2];
#pragma unroll
      for (int ks = 0; ks < 2; ++ks) { af[0][ks] = tr8(lds + G_KT, KRS, 32 * ks + 8 * g, q4, (16 * wave + 4 * p4) * 2); af[1][ks] = tr8(lds + G_QB, KRS, 32 * ks + 8 * g, q4, (16 * wave + 4 * p4) * 2); }
      bf16_t* dst0 = SB + ((size_t)((bh * 2) * 132 + c) * 256 + fr) * 128 + 16 * wave + 4 * g;
      bf16_t* dst1 = dst0 + (size_t)132 * 256 * 128;
#pragma unroll 4
      for (int n = 0; n < 16; ++n) {
        f32x4 a0 = {0.f, 0.f, 0.f, 0.f}, a1 = a0;
#pragma unroll
        for (int ks = 0; ks < 2; ++ks) {
          const bf16x8 bfr = tr8(lds + G_VT, VRS, 32 * ks + 8 * g, q4, (16 * n + 4 * p4) * 2);
          a0 = __builtin_amdgcn_mfma_f32_16x16x32_bf16(af[0][ks], bfr, a0, 0, 0, 0);
          a1 = __builtin_amdgcn_mfma_f32_16x16x32_bf16(af[1][ks], bfr, a1, 0, 0, 0);
        }
        u32x2 w0; w0.x = pk2(a0[0], a0[1]); w0.y = pk2(a0[2], a0[3]);
        u32x2 w1; w1.x = pk2(a1[0], a1[1]); w1.y = pk2(a1[2], a1[3]);
        *(u32x2*)(dst0 + (size_t)(16 * n) * 128) = w0;
        *(u32x2*)(dst1 + (size_t)(16 * n) * 128) = w1;
      }
    }
    __syncthreads();
  }
}
__device__ void gla_passB(const Params& p, int bid, int nb) {
  WS_LOCAL
  const int tid = otid();
  bf16_t* SB = (bf16_t*)WSP(float, WS_RG);
  for (int item = bid * NTHR + tid; item < 131072; item += nb * NTHR) {
    const int dq = item & 31, e = (item >> 5) & 255, chain = item >> 13, dir = chain & 1;
    f32x4 S = {0.f, 0.f, 0.f, 0.f};
    bf16_t* base = SB + ((size_t)chain * 132 * 256 + e) * 128 + dq * 4;
    const float* dbase = WSP(float, WS_DB) + (size_t)chain * 132 * 128 + dq * 4;
#pragma unroll 1
    for (int i0 = 0; i0 < 132; i0 += 12) {
      u32x2 u[12]; f32x4 dd[12]; int cc[12];
#pragma unroll
      for (int k = 0; k < 12; ++k) {
        const int i = i0 + k;
        cc[k] = dir ? ((i < 4) ? 3 - i : 135 - i) : i;
        u[k] = __builtin_nontemporal_load((const u32x2*)(base + (size_t)cc[k] * 32768));
        dd[k] = *(const f32x4*)(dbase + cc[k] * 128);
      }
#pragma unroll
      for (int k = 0; k < 12; ++k) {
        u32x2 o; o.x = pk2(S[0], S[1]); o.y = pk2(S[2], S[3]);
        *(u32x2*)(base + (size_t)cc[k] * 32768) = o;
        S[0] = S[0] * dd[k][0] + bflo(u[k].x); S[1] = S[1] * dd[k][1] + bfhi(u[k].x);
        S[2] = S[2] * dd[k][2] + bflo(u[k].y); S[3] = S[3] * dd[k][3] + bfhi(u[k].y);
      }
    }
  }
}
__device__ void gla_passC(const Params& p, int l, LAS unsigned char* lds, int bid, int nb) {
  WS_LOCAL
  const int tid = otid(), wave = tid >> 6, lane = tid & 63, fr = lane & 15, g = lane >> 4, q4 = fr >> 2, p4 = fr & 3;
  const bf16_t* SB = (const bf16_t*)WSP(float, WS_RG);
  const int c_lo = (l == 0) ? 0 : 4, nc = 132 - c_lo, ntask = 8 * nc;
  ChunkRegs R; float wv[2][17];
  if (bid < ntask) {
    const int c = c_lo + bid % nc, bh = bid / nc, b = bh >> 2, hd = bh & 3;
    gla_issue<true>(p, (c < 4) ? (NL + b * 256 + c * 64) : (b * 8192 + (c - 4) * 64), hd, c, tid, R);
  }
  for (int task = bid; task < ntask; task += nb) {
    const int c = c_lo + task % nc, bh = task / nc, b = bh >> 2, hd = bh & 3;
    const int row0 = (c < 4) ? (NL + b * 256 + c * 64) : (b * 8192 + (c - 4) * 64);
    gla_load_w(p, l, hd, tid, wv);
    gla_commit<true>(p, lds, row0, hd, c, tid, R);
    __syncthreads();
    f32x4 acc[2][4];
#pragma unroll
    for (int eb = 0; eb < 2; ++eb)
#pragma unroll
      for (int tb = 0; tb < 4; ++tb) acc[eb][tb] = (f32x4){0.f, 0.f, 0.f, 0.f};
    f32x4 attacc[2];
    attacc[0] = (f32x4){0.f, 0.f, 0.f, 0.f}; attacc[1] = attacc[0];
#pragma unroll 1
    for (int dir = 0; dir < 2; ++dir) {
      const int chain = bh * 2 + dir;
      { float wd[17];
#pragma unroll
        for (int r = 0; r < 17; ++r) wd[r] = dir ? wv[1][r] : wv[0][r];
        gla_prep<true>(p, l, lds, hd, dir, tid, wd, nullptr, G_KT, G_TOT); __syncthreads(); }
      {
        const int sb = wave >> 1;
        bf16x8 ka[4];
#pragma unroll
        for (int ks = 0; ks < 4; ++ks) ka[ks] = *(const LAS bf16x8*)(lds + G_KT + (16 * sb + fr) * KRS + (32 * ks + 8 * g) * 2);
#pragma unroll
        for (int t2 = 0; t2 < 2; ++t2) {
          const int tb = 2 * (wave & 1) + t2;
          f32x4 a = {0.f, 0.f, 0.f, 0.f};
#pragma unroll
          for (int ks = 0; ks < 4; ++ks) {
            const bf16x8 qf = *(const LAS bf16x8*)(lds + G_QE + (16 * tb + fr) * KRS + (32 * ks + 8 * g) * 2);
            a = __builtin_amdgcn_mfma_f32_16x16x32_bf16(ka[ks], qf, a, 0, 0, 0);
          }
          const int t = 16 * tb + fr;
#pragma unroll
          for (int jj = 0; jj < 4; ++jj) { const int s = 16 * sb + 4 * g + jj; const bool keep = dir ? (s >= t) : (s <= t); attacc[t2][jj] += keep ? a[jj] : 0.f; }
          if (dir == 1) {
            u32x2 w2; w2.x = pk2(attacc[t2][0], attacc[t2][1]); w2.y = pk2(attacc[t2][2], attacc[t2][3]);
            *(LAS u32x2*)(lds + G_ATT + t * ARS + (16 * sb + 4 * g) * 2) = w2;
          }
        }
      }
      {
        const bf16_t* sp = SB + ((size_t)(chain * 132 + c) * 256 + 32 * wave + fr) * 128 + 8 * g;
#pragma unroll
        for (int kh = 0; kh < 2; ++kh) {
          bf16x8 sf[2][2];
#pragma unroll
          for (int eb = 0; eb < 2; ++eb)
#pragma unroll
            for (int k2 = 0; k2 < 2; ++k2) sf[eb][k2] = *(const bf16x8*)(sp + (size_t)(16 * eb) * 128 + 32 * (2 * kh + k2));
#pragma unroll
          for (int tb = 0; tb < 4; ++tb)
#pragma unroll
            for (int k2 = 0; k2 < 2; ++k2) {
              const bf16x8 qf = *(const LAS bf16x8*)(lds + G_QB + (16 * tb + fr) * KRS + (32 * (2 * kh + k2) + 8 * g) * 2);
#pragma unroll
              for (int eb = 0; eb < 2; ++eb) acc[eb][tb] = __builtin_amdgcn_mfma_f32_16x16x32_bf16(sf[eb][k2], qf, acc[eb][tb], 0, 0, 0);
            }
          __builtin_amdgcn_sched_barrier(0);
        }
      }
      __syncthreads();
    }
#pragma unroll
    for (int ks = 0; ks < 2; ++ks) {
      bf16x8 vf[2];
#pragma unroll
      for (int eb = 0; eb < 2; ++eb) vf[eb] = tr8(lds + G_VT, VRS, 32 * ks + 8 * g, q4, (16 * (2 * wave + eb) + 4 * p4) * 2);
#pragma unroll
      for (int tb = 0; tb < 4; ++tb) {
        const bf16x8 af = *(const LAS bf16x8*)(lds + G_ATT + (16 * tb + fr) * ARS + (32 * ks + 8 * g) * 2);
#pragma unroll
        for (int eb = 0; eb < 2; ++eb) acc[eb][tb] = __builtin_amdgcn_mfma_f32_16x16x32_bf16(vf[eb], af, acc[eb][tb], 0, 0, 0);
      }
    }
    if (task + nb < ntask) {
      const int tn = task + nb, cn = c_lo + tn % nc, bhn = tn / nc, bn = bhn >> 2, hdn = bhn & 3;
      gla_issue<true>(p, (cn < 4) ? (NL + bn * 256 + cn * 64) : (bn * 8192 + (cn - 4) * 64), hdn, cn, tid, R);
    }
    u32x2 og[2][4]; f32x4 nwv[2];
#pragma unroll
    for (int eb = 0; eb < 2; ++eb) {
      const int e0 = 16 * (2 * wave + eb) + 4 * g;
      nwv[eb] = *(const f32x4*)(KARG(const float, 11) + l * 256 + e0);
#pragma unroll
      for (int tb = 0; tb < 4; ++tb) og[eb][tb] = *(const u32x2*)(WSP(bf16_t, WS_PROJ) + (size_t)(row0 + 16 * tb + fr) * PSTR + 2048 + hd * 256 + e0);
    }
    LAS float* red = (LAS float*)(lds + G_RED);
    float rstd[4];
#pragma unroll
    for (int tb = 0; tb < 4; ++tb) {
      float ss = 0.f;
#pragma unroll
      for (int eb = 0; eb < 2; ++eb)
#pragma unroll
        for (int jj = 0; jj < 4; ++jj) ss += acc[eb][tb][jj] * acc[eb][tb][jj];
      ss += __shfl_xor(ss, 16, 64); ss += __shfl_xor(ss, 32, 64);
      if (g == 0) red[wave * 64 + 16 * tb + fr] = ss;
    }
    __syncthreads();
#pragma unroll
    for (int tb = 0; tb < 4; ++tb) {
      float ss = 0.f;
#pragma unroll
      for (int w8 = 0; w8 < 8; ++w8) ss += red[w8 * 64 + 16 * tb + fr];
      rstd[tb] = rsqrtf(ss * (1.f / 256.f) + 1e-6f);
    }
#pragma unroll
    for (int eb = 0; eb < 2; ++eb) {
      const int e0 = 16 * (2 * wave + eb) + 4 * g;
      const f32x4 nw = nwv[eb];
#pragma unroll
      for (int tb = 0; tb < 4; ++tb) {
        const int row = row0 + 16 * tb + fr;
        const u32x2 ogv = og[eb][tb];
        const float y0 = acc[eb][tb][0] * rstd[tb] * nw[0] * siluf_(bflo(ogv.x)), y1 = acc[eb][tb][1] * rstd[tb] * nw[1] * siluf_(bfhi(ogv.x));
        const float y2 = acc[eb][tb][2] * rstd[tb] * nw[2] * siluf_(bflo(ogv.y)), y3 = acc[eb][tb][3] * rstd[tb] * nw[3] * siluf_(bfhi(ogv.y));
        u32x2 w2; w2.x = pk2(y0, y1); w2.y = pk2(y2, y3);
        *(u32x2*)(WSP(bf16_t, WS_GM) + (size_t)row * GSTR + hd * 256 + e0) = w2;
      }
    }
  }
}
__device__ __forceinline__ void route_top2(float affl, float sell, int& e1, int& e2, float& w1, float& w2) {
  float aff[16], sel[16];
#pragma unroll
  for (int e = 0; e < 16; ++e) { aff[e] = __int_as_float(__builtin_amdgcn_readlane(__float_as_int(affl), 4 * e)); sel[e] = __int_as_float(__builtin_amdgcn_readlane(__float_as_int(sell), 4 * e)); }
  float best = -INFINITY; int gb = 0;
  float bs[4], ba[4];
#pragma unroll
  for (int q = 0; q < 4; ++q) { bs[q] = 0.f; ba[q] = 0.f; }
#pragma unroll
  for (int g = 0; g < 4; ++g) {
    const float s0 = sel[4 * g], s1 = sel[4 * g + 1], s2 = sel[4 * g + 2], s3 = sel[4 * g + 3];
    const float m1 = fmaxf(fmaxf(s0, s1), fmaxf(s2, s3));
    const int f = (s0 == m1) ? 0 : (s1 == m1) ? 1 : (s2 == m1) ? 2 : 3;
    float m2 = -INFINITY;
    if (f != 0) m2 = fmaxf(m2, s0);
    if (f != 1) m2 = fmaxf(m2, s1);
    if (f != 2) m2 = fmaxf(m2, s2);
    if (f != 3) m2 = fmaxf(m2, s3);
    const float gs = m1 + m2;
    if (gs > best) {
      best = gs; gb = g;
      bs[0] = s0; bs[1] = s1; bs[2] = s2; bs[3] = s3;
      ba[0] = aff[4 * g]; ba[1] = aff[4 * g + 1]; ba[2] = aff[4 * g + 2]; ba[3] = aff[4 * g + 3];
    }
  }
  const float m1 = fmaxf(fmaxf(bs[0], bs[1]), fmaxf(bs[2], bs[3]));
  const int i1 = (bs[0] == m1) ? 0 : (bs[1] == m1) ? 1 : (bs[2] == m1) ? 2 : 3;
  float m2 = -INFINITY; int i2 = 0;
#pragma unroll
  for (int q = 3; q >= 0; --q)
    if (q != i1 && bs[q] >= m2) { m2 = bs[q]; i2 = q; }
  const float a1 = (i1 == 0) ? ba[0] : (i1 == 1) ? ba[1] : (i1 == 2) ? ba[2] : ba[3];
  const float a2 = (i2 == 0) ? ba[0] : (i2 == 1) ? ba[1] : (i2 == 2) ? ba[2] : ba[3];
  const float inv = 1.f / (a1 + a2);
  e1 = gb * 4 + i1; e2 = gb * 4 + i2; w1 = a1 * inv; w2 = a2 * inv;
}
__device__ void ph_norm2(const Params& p, int l, LAS unsigned char* lds, int bid, int nb) {
  WS_LOCAL
  const int tid = otid(), wave = tid >> 6, lane = tid & 63, fr = lane & 15, g = lane >> 4;
  const int M = (l == 0) ? NT : NL;
  const int R = (M + nb - 1) / nb, rbeg = bid * R, rend = min(rbeg + R, M);
  LAS int* lcnt = (LAS int*)lds;
  LAS int* lbase = lcnt + 16;
  LAS int* rec = lcnt + 64;
  LAS float* Hs = (LAS float*)(lds + 4096);
  LAS float* part = (LAS float*)(lds + 4096 + 16 * 1028 * 4);
  if (tid < 32) lcnt[tid] = 0;
  for (int k = tid; k < R; k += NTHR) rec[k * 8] = -1;
  float wreg[32];
#pragma unroll
  for (int t = 0; t < 32; ++t) wreg[t] = KARG(const float, 16)[(size_t)(128 * wave + 4 * t + g) * 16 + fr];
  const bf16_t* Yb = WSP(bf16_t, WS_Y);
  const float* nw = KARG(const float, 7) + l * 1024;
  const float brt = KARG(const float, 17)[(lane >> 2) & 15];
  __syncthreads();
  for (int r0 = rbeg; r0 < rend; r0 += 16) {
    int rows[2]; bool val[2];
#pragma unroll
    for (int u = 0; u < 2; ++u) { rows[u] = r0 + 2 * wave + u; val[u] = rows[u] < rend; if (!val[u]) rows[u] = rend - 1; }
    f32x4 v[2][4]; u32x2 yv[2][4];
#pragma unroll
    for (int u = 0; u < 2; ++u) {
      const int row = rows[u];
      const float* src = (l == 0) ? ((row < NL) ? KARG(const float, 0) + (size_t)row * 1024 : KARG(const float, 2) + (size_t)(row - NL) * 1024)
                                  : (const float*)(WSP(float, WS_XBUF) + (size_t)row * 1024);
#pragma unroll
      for (int i = 0; i < 4; ++i) { v[u][i] = *(const f32x4*)(src + i * 256 + lane * 4); yv[u][i] = *(const u32x2*)(Yb + (size_t)row * 1024 + i * 256 + lane * 4); }
    }
#pragma unroll
    for (int u = 0; u < 2; ++u) {
      const int row = rows[u];
      const float* md = WSP(float, WS_MOD) + (l * 3 + ((row < NL) ? (row >> 13) : 2)) * 6144;
      float ss = 0.f;
#pragma unroll
      for (int i = 0; i < 4; ++i) {
        const f32x4 m2 = *(const f32x4*)(md + 2048 + i * 256 + lane * 4);
        v[u][i][0] += m2[0] * bflo(yv[u][i].x); v[u][i][1] += m2[1] * bfhi(yv[u][i].x); v[u][i][2] += m2[2] * bflo(yv[u][i].y); v[u][i][3] += m2[3] * bfhi(yv[u][i].y);
        if (val[u]) *(f32x4*)(WSP(float, WS_XBUF) + (size_t)row * 1024 + i * 256 + lane * 4) = v[u][i];
        ss += v[u][i][0] * v[u][i][0] + v[u][i][1] * v[u][i][1] + v[u][i][2] * v[u][i][2] + v[u][i][3] * v[u][i][3];
      }
      const float rstd = rsqrtf(wave_sum(ss) * (1.f / 1024.f) + 1e-6f);
#pragma unroll
      for (int i = 0; i < 4; ++i) {
        const int j = i * 256 + lane * 4;
        const f32x4 w = *(const f32x4*)(nw + j), m4 = *(const f32x4*)(md + 4096 + j), m3 = *(const f32x4*)(md + 3072 + j);
        f32x4 h;
#pragma unroll
        for (int q = 0; q < 4; ++q) h[q] = v[u][i][q] * rstd * w[q] * (1.f + m4[q]) + m3[q];
        if (val[u]) *(unsigned*)(WSP(unsigned char, WS_H8) + (size_t)row * 1024 + j) = pk4_fp8(h[0], h[1], h[2], h[3]);
        *(LAS f32x4*)(Hs + (2 * wave + u) * 1028 + j) = h;
      }
    }
    __syncthreads();
    {
      f32x4 acc = {0.f, 0.f, 0.f, 0.f};
      const LAS float* hp = Hs + fr * 1028 + 128 * wave + g;
#pragma unroll
      for (int t = 0; t < 32; ++t) acc = __builtin_amdgcn_mfma_f32_16x16x4f32(hp[4 * t], wreg[t], acc, 0, 0, 0);
#pragma unroll
      for (int jj = 0; jj < 4; ++jj) part[(wave * 16 + 4 * g + jj) * 16 + fr] = acc[jj];
    }
    __syncthreads();
#pragma unroll
    for (int u = 0; u < 2; ++u) {
      const int rl = 2 * wave + u, em = (lane >> 2) & 15;
      float lg = 0.f;
#pragma unroll
      for (int w8 = 0; w8 < 8; ++w8) lg += part[(w8 * 16 + rl) * 16 + em];
      const float affl = 1.f / (1.f + expf(-lg)), sell = affl + brt;
      int e1, e2; float w1, w2;
      route_top2(affl, sell, e1, e2, w1, w2);
      if (lane == 0 && val[u]) {
        const int s1 = __hip_atomic_fetch_add(&lcnt[e1], 1, __ATOMIC_RELAXED, __HIP_MEMORY_SCOPE_WORKGROUP);
        const int s2 = __hip_atomic_fetch_add(&lcnt[e2], 1, __ATOMIC_RELAXED, __HIP_MEMORY_SCOPE_WORKGROUP);
        LAS int* rc = rec + (rows[u] - rbeg) * 8;
        rc[0] = rows[u]; rc[1] = e1; rc[2] = s1; rc[3] = e2; rc[4] = s2; rc[5] = __float_as_int(w1); rc[6] = __float_as_int(w2);
      }
    }
  }
  __syncthreads();
  if (tid < 16) { const int n = lcnt[tid]; lbase[tid] = n ? atomicAdd(&WSP(int, WS_CTL + 4096 * 4)[(l * 16 + tid) * 64], n) : 0; }
  __syncthreads();
  for (int k = tid; k < R; k += NTHR) {
    const LAS int* rc = rec + k * 8;
    const int row = rc[0];
    if (row >= 0) {
      const int e1 = rc[1], s1 = lbase[e1] + rc[2], e2 = rc[3], s2 = lbase[e2] + rc[4];
      WSP(int, WS_LIST)[e1 * NT + s1] = row * 2; WSP(float, WS_TOPW)[row * 2] = __int_as_float(rc[5]);
      WSP(int, WS_LIST)[e2 * NT + s2] = row * 2 + 1; WSP(float, WS_TOPW)[row * 2 + 1] = __int_as_float(rc[6]);
    }
  }
}
__device__ __forceinline__ void moe_tables(const Params& p, int l, volatile LAS int* tab, int nN) {
  WS_LOCAL
  if (threadIdx.x == 0) {
    int up = 0, tb = 0;
    for (int e = 0; e < 16; ++e) {
      const int c = __hip_atomic_load(&WSP(int, WS_CTL + 4096 * 4)[(l * 16 + e) * 64], __ATOMIC_RELAXED, __HIP_MEMORY_SCOPE_AGENT), mt = (c + 255) >> 8;
      tab[e] = up; tab[32 + e] = mt > 0 ? mt : 1; tab[64 + e] = tb; tab[96 + e] = c;
      up += mt * nN; tb += mt;
    }
    tab[16] = up;
  }
  __syncthreads();
}
__device__ void ph_proj(const Params& p, int l, LAS unsigned char* lds, int bid, int nb) {
  WS_LOCAL
  pg8::DenseSched S; S.init(NT / 256, PSTR / 256, nb, bid, WSP(bf16_t, WS_HM), WSP(bf16_t, WS_WINT) + (size_t)l * PSTR * 1024, 1024);
  EpiProj E{WSP(bf16_t, WS_PROJ), WSP(float, WS_LR32)};
  pg8::gemm_phase<EpiProj, pg8::DenseSched, 0>(lds, 1024, S, E);
}
__device__ void ph_merge(const Params& p, int l, LAS unsigned char* lds, int bid, int nb) {
  WS_LOCAL
  if (l == 0 && bid < 8) {
    const int pm = 64 + (bid >> 2), pn = bid & 3;
    unsigned* ctr = WSP(unsigned, WS_CTL + 6400 * 4) + (bid >> 2) * 64;
    pg8::SingleSched S; S.u0.pm = pm; S.u0.pn = pn; S.u0.e = 0; S.u0.aux = 0;
    S.u0.A = (const char*)WSP(bf16_t, WS_GM) + (size_t)pm * 256 * GSTR * 2; S.u0.B = (const char*)WSP(bf16_t, WS_WMT) + (size_t)pn * 256 * GSTR * 2;
    EpiMerge E{WSP(bf16_t, WS_PROJ), WSP(bf16_t, WS_HM)};
    pg8::gemm_phase<EpiMerge, pg8::SingleSched, 16>(lds, GSTR, S, E);
    asm volatile("s_waitcnt vmcnt(0)" ::: "memory");
    __syncthreads();
    if (threadIdx.x == 0) {
      __builtin_amdgcn_fence(__ATOMIC_RELEASE, "agent");
      asm volatile("s_waitcnt vmcnt(0)" ::: "memory");
      (void)__hip_atomic_fetch_add(ctr, 1u, __ATOMIC_RELAXED, __HIP_MEMORY_SCOPE_AGENT);
    }
  }
  {
    pg8::DenseSched S; S.init(NL / 256, 4, nb, bid, WSP(bf16_t, WS_GM), WSP(bf16_t, WS_WMT) + (size_t)l * 1024 * GSTR, GSTR);
    EpiMerge E{WSP(bf16_t, WS_PROJ), WSP(bf16_t, WS_HM)};
    pg8::gemm_phase<EpiMerge, pg8::DenseSched, 16>(lds, GSTR, S, E);
  }
  if (l == 0 && bid >= 8 && bid < 16) {
    const int j = bid - 8, pm = 64 + (j >> 2), pn = j & 3;
    unsigned* ctr = WSP(unsigned, WS_CTL + 6400 * 4) + (j >> 2) * 64;
    if (threadIdx.x == 0) {
      unsigned sp = 0;
      while (__hip_atomic_load(ctr, __ATOMIC_RELAXED, __HIP_MEMORY_SCOPE_AGENT) < 4u) { __builtin_amdgcn_s_sleep(2); if (++sp > (1u << 24)) break; }
      __builtin_amdgcn_fence(__ATOMIC_ACQUIRE, "agent");
      asm volatile("s_waitcnt vmcnt(0)" ::: "memory");
    }
    __syncthreads();
    pg8::SingleSched S; S.u0.pm = pm; S.u0.pn = pn; S.u0.e = 0; S.u0.aux = 0;
    S.u0.A = (const char*)WSP(bf16_t, WS_HM) + (size_t)pm * 256 * 1024 * 2; S.u0.B = (const char*)WSP(bf16_t, WS_WOT) + (size_t)pn * 256 * 1024 * 2;
    EpiOut E{WSP(bf16_t, WS_Y)};
    pg8::gemm_phase<EpiOut, pg8::SingleSched, 0>(lds, 1024, S, E);
  }
}
__device__ void ph_out(const Params& p, int l, LAS unsigned char* lds, int bid, int nb) {
  WS_LOCAL
  pg8::DenseSched S; S.init(NL / 256, 4, nb, bid, WSP(bf16_t, WS_HM), WSP(bf16_t, WS_WOT) + (size_t)l * 1024 * 1024, 1024);
  EpiOut E{WSP(bf16_t, WS_Y)};
  pg8::gemm_phase<EpiOut, pg8::DenseSched, 0>(lds, 1024, S, E);
}
__device__ void ph_moe1(const Params& p, int l, LAS unsigned char* lds, int bid, int nb) {
  WS_LOCAL
  volatile LAS int* tab = (volatile LAS int*)(lds + MISC_OFF + 256);
  moe_tables(p, l, tab, 8);
  pg8::MoeSched S; S.U = tab[16]; S.nN = 8; S.G = nb; S.c = bid; S.A = (const char*)WSP(unsigned char, WS_H8); S.B = (const char*)WSP(unsigned char, WS_RG);
  S.tstep = (size_t)256 * 1024; S.estep = (size_t)2048 * 1024; S.tab = tab; S.list = WSP(int, WS_LIST); S.gather = true;
  EpiMoe1 E{WSP(unsigned char, WS_PROJ + PROWS * 2048)};
  pg8::gemm_phase<EpiMoe1, pg8::MoeSched, 0, true, true>(lds, 512, S, E);
}
__device__ void ph_moe2(const Params& p, int l, LAS unsigned char* lds, int bid, int nb) {
  WS_LOCAL
  volatile LAS int* tab = (volatile LAS int*)(lds + MISC_OFF + 256);
  __syncthreads();
  moe_tables(p, l, tab, 4);
  pg8::MoeSched S; S.U = tab[16]; S.nN = 4; S.G = nb; S.c = bid; S.A = (const char*)WSP(unsigned char, WS_PROJ + PROWS * 2048); S.B = (const char*)WSP(unsigned char, WS_W2F8);
  S.tstep = (size_t)256 * 1024; S.estep = (size_t)1024 * 1024; S.tab = tab; S.list = WSP(int, WS_LIST); S.gather = false;
  EpiMoe2 E{WSP(bf16_t, WS_PROJ + 2 * PROWS * 2048), WSP(int, WS_LIST), WSP(float, WS_TOPW), tab};
  pg8::gemm_phase<EpiMoe2, pg8::MoeSched, 0, false, true>(lds, 512, S, E);
}
__device__ void ph_final(const Params& p, int bid, int nb) {
  WS_LOCAL
  const int tid = otid(), wave = tid >> 6, lane = tid & 63;
  const int NGW = nb * NWAVES;
  for (int rowa = bid * NWAVES + wave; rowa < NL; rowa += 2 * NGW) {
    int rows[2]; rows[0] = rowa; rows[1] = rowa + NGW;
    const bool has2 = rows[1] < NL;
    if (!has2) rows[1] = rowa;
    f32x4 v[2][4]; float ss[2] = {0.f, 0.f};
#pragma unroll
    for (int u = 0; u < 2; ++u) {
      const int row = rows[u];
      const float* src = WSP(float, WS_XBUF) + (size_t)row * 1024;
      const float* m5 = WSP(float, WS_MOD) + (1 * 3 + (row >> 13)) * 6144 + 5 * 1024;
      const bf16_t* y0 = WSP(bf16_t, WS_PROJ + 2 * PROWS * 2048) + (size_t)(row * 2) * 1024;
#pragma unroll
      for (int i = 0; i < 4; ++i) {
        const int j = i * 256 + lane * 4;
        v[u][i] = __builtin_nontemporal_load((const f32x4*)(src + j));
        const u32x2 ya = __builtin_nontemporal_load((const u32x2*)(y0 + j)), yb = __builtin_nontemporal_load((const u32x2*)(y0 + 1024 + j));
        const f32x4 g = *(const f32x4*)(m5 + j);
        v[u][i][0] += g[0] * (bflo(ya.x) + bflo(yb.x)); v[u][i][1] += g[1] * (bfhi(ya.x) + bfhi(yb.x));
        v[u][i][2] += g[2] * (bflo(ya.y) + bflo(yb.y)); v[u][i][3] += g[3] * (bfhi(ya.y) + bfhi(yb.y));
        ss[u] += v[u][i][0] * v[u][i][0] + v[u][i][1] * v[u][i][1] + v[u][i][2] * v[u][i][2] + v[u][i][3] * v[u][i][3];
      }
    }
#pragma unroll
    for (int u = 0; u < 2; ++u) {
      if (u == 1 && !has2) break;
      const float rstd = rsqrtf(wave_sum(ss[u]) * (1.f / 1024.f) + 1e-6f);
#pragma unroll
      for (int i = 0; i < 4; ++i) {
        const int j = i * 256 + lane * 4;
        const f32x4 w = *(const f32x4*)(KARG(const float, 21) + j);
        __builtin_nontemporal_store(v[u][i] * rstd * w, (f32x4*)(KARG(float, 22) + (size_t)rows[u] * 1024 + j));
      }
    }
  }
}

__global__ void __launch_bounds__(NTHR, 2) k_mega(Params p) {
  extern __shared__ __attribute__((aligned(16))) unsigned char lds_raw[];
  LAS unsigned char* lds0 = (LAS unsigned char*)lds_raw;
  cg::grid_group grid = cg::this_grid();
  const int bid0 = blockIdx.x, nb0 = gridDim.x;
  volatile LAS unsigned* misc = (volatile LAS unsigned*)(lds0 + MISC_OFF);
  if (threadIdx.x < 64) misc[threadIdx.x] = 0u;
  __syncthreads();
  XcdBarrier bar = xcd_barrier_post((unsigned*)(p.ws + WS_CTL), misc);
  if (p.ws == nullptr) grid.sync();
#pragma unroll 1
  for (int step = 0; step < 23; ++step) {
    const int t = step - 2, l = (t >= 0) ? t / 10 : 0, ph = (step == 0) ? -1 : ((step == 1) ? -2 : ((step == 22) ? 11 : t % 10));
    int bid = bid0, nb = nb0; unsigned ldsu = (unsigned)(size_t)lds0;
    asm volatile("" : "+s"(bid), "+s"(nb), "+s"(ldsu));
    LAS unsigned char* lds = (LAS unsigned char*)(size_t)ldsu;
    switch (ph) {
      case -1: ph_init(p, lds, bid, nb); break;
      case -2: ph_ada_reduce(p, bid, nb); break;
      case 0: ph_norm1(p, l, bid, nb); break;
      case 1: ph_proj(p, l, lds, bid, nb); break;
      case 2: case 3: if (ph == 2) gla_passA(p, l, lds, bid, nb); else gla_passB(p, bid, nb);
              na_phase(p, l, lds, bid, nb, ph == 2 ? 1 : 0); break;
      case 4: gla_passC(p, l, lds, bid, nb); break;
      case 5: ph_experts(p, l, lds, bid, nb); __syncthreads(); ph_merge(p, l, lds, bid, nb); break;
      case 6: ph_out(p, l, lds, bid, nb); break;
      case 7: ph_norm2(p, l, lds, bid, nb); break;
      case 8: ph_moe1(p, l, lds, bid, nb); break;
      case 9: ph_moe2(p, l, lds, bid, nb); break;
      default: ph_final(p, bid, nb); break;
    }
    if (step == 22) break;
    xcd_barrier(bar);
  }
}

extern "C" void kernel_launch(void* const* d_in, const int* in_sizes, int n_in, void* d_out, int out_size, void* d_ws,
                              size_t ws_size, hipStream_t stream) {
  Params p{};
  const float** fp = (const float**)&p;
  for (int i = 0; i < 22; ++i) fp[i] = (const float*)d_in[i];
  p.out = (float*)d_out;
  p.ws = (char*)d_ws;
  if (WS_END > ws_size) { fprintf(stderr, "workspace too small: need %zu have %zu\n", (size_t)WS_END, ws_size); return; }

  static int grid_blocks = 0;
  if (!grid_blocks) {
    int dev = 0, cus = 0, per_cu = 0;
    (void)hipGetDevice(&dev);
    (void)hipDeviceGetAttribute(&cus, hipDeviceAttributeMultiprocessorCount, dev);
    (void)hipFuncSetAttribute((const void*)k_mega, hipFuncAttributeMaxDynamicSharedMemorySize, LDS_BYTES);
    (void)hipOccupancyMaxActiveBlocksPerMultiprocessor(&per_cu, k_mega, NTHR, LDS_BYTES);
    if (per_cu < 1) fprintf(stderr, "occupancy query reports %d blocks per CU\n", per_cu);
    grid_blocks = cus > 0 ? cus : 256;
  }
  (void)hipMemsetAsync(p.ws + WS_CTL, 0, 32768, stream);
  void* args[] = {&p};
  hipError_t e = hipLaunchCooperativeKernel((void*)k_mega, dim3(grid_blocks), dim3(NTHR), args, LDS_BYTES, stream);
  if (e != hipSuccess) fprintf(stderr, "cooperative launch failed: %s (grid %d)\n", hipGetErrorString(e), grid_blocks);
}
```

```cpp
#include <hip/hip_runtime.h>
#include <hip/hip_cooperative_groups.h>
#include <cstdio>
#include <cstdint>
namespace cg = cooperative_groups;

typedef unsigned short bf16_t;
typedef short bf16x8 __attribute__((ext_vector_type(8)));
typedef float f32x4 __attribute__((ext_vector_type(4)));
typedef unsigned u32x4 __attribute__((ext_vector_type(4)));
typedef unsigned u32x2 __attribute__((ext_vector_type(2)));
#define LAS __attribute__((address_space(3)))

#define NT 16896
#define NL 16384
#define PSTR 6912
#define INC 6688
#define GSTR 1536
#define NTHR 512
#define NWAVES 8
#define RING_BYTES 131072
#define LDS_BYTES 151552
#define MISC_OFF 131072

__device__ __forceinline__ float bf2f(bf16_t v) { return __uint_as_float(((unsigned)v) << 16); }
typedef __bf16 hwbf16x2 __attribute__((ext_vector_type(2)));
typedef float f32x2 __attribute__((ext_vector_type(2)));
__device__ __forceinline__ unsigned pk2(float lo, float hi) { const f32x2 v = {lo, hi}; return __builtin_bit_cast(unsigned, __builtin_convertvector(v, hwbf16x2)); }
__device__ __forceinline__ bf16_t f2bf(float f) { return (bf16_t)(pk2(f, 0.f) & 0xffffu); }
__device__ __forceinline__ float bflo(unsigned u) { return __uint_as_float(u << 16); }
__device__ __forceinline__ float bfhi(unsigned u) { return __uint_as_float(u & 0xffff0000u); }
__device__ __forceinline__ float sigmoidf_(float x) { return 1.f / (1.f + __expf(-x)); }
__device__ __forceinline__ float siluf_(float x) { return x / (1.f + __expf(-x)); }
__device__ __forceinline__ float wave_sum(float v) {
#pragma unroll
  for (int o = 32; o > 0; o >>= 1) v += __shfl_xor(v, o, 64);
  return v;
}
__device__ __forceinline__ float wave_max(float v) {
#pragma unroll
  for (int o = 32; o > 0; o >>= 1) v = fmaxf(v, __shfl_xor(v, o, 64));
  return v;
}
__device__ __forceinline__ int otid() { int t = threadIdx.x; asm volatile("" : "+v"(t)); return t; }

constexpr size_t al256(size_t x) { return (x + 255) & ~(size_t)255; }
constexpr size_t WS_CTL = 0;
constexpr size_t WS_MOD = WS_CTL + 32768;
constexpr size_t WS_ROPE = WS_MOD + al256(2 * 3 * 6144 * 4);
constexpr size_t WS_LR32 = WS_ROPE + al256(128 * 32 * 2 * 4);
constexpr size_t WS_TOPW = WS_LR32 + al256((size_t)NT * 32 * 4);
constexpr size_t WS_POS = WS_TOPW + al256((size_t)NT * 2 * 4);
constexpr size_t WS_LIST = WS_POS + al256((size_t)NT * 2 * 4);
constexpr size_t WS_DB = WS_LIST + al256((size_t)16 * NT * 4);
constexpr size_t WS_APART = WS_DB + al256((size_t)16 * 132 * 128 * 4);
constexpr size_t WS_XBUF = WS_APART + al256((size_t)2 * 32 * 3 * 6144 * 4);
constexpr size_t WS_WINT = WS_XBUF + al256((size_t)NT * 1024 * 4);
constexpr size_t WS_WMT = WS_WINT + al256((size_t)2 * PSTR * 1024 * 2);
constexpr size_t WS_WOT = WS_WMT + al256((size_t)2 * 1024 * GSTR * 2);
constexpr size_t WS_HM = WS_WOT + al256((size_t)2 * 1024 * 1024 * 2);
constexpr size_t WS_GM = WS_HM + al256((size_t)NT * 1024 * 2);
constexpr size_t WS_RG = WS_GM + al256((size_t)NT * GSTR * 2);
constexpr size_t WS_PROJ = WS_RG + al256((size_t)NT * 1024 * 4 * 2);
constexpr size_t WS_END = WS_PROJ + al256((size_t)NT * PSTR * 2);
constexpr size_t PROWS = 37888;
constexpr size_t WS_W2F8 = WS_RG + (size_t)16 * 2048 * 1024;
constexpr size_t WS_H8 = WS_HM;
constexpr size_t WS_Y = WS_RG + (size_t)16 * 3 * 1024 * 1024 * 2;
static_assert((size_t)16 * 3 * 1024 * 1024 * 2 + (size_t)NT * 1024 * 2 <= (size_t)NT * 1024 * 4 * 2, "y buffer");
static_assert(2 * PROWS * 2048 + (size_t)NT * 2 * 2048 <= (size_t)NT * PSTR * 2, "MoE buffers must fit in the projection region");
static_assert((size_t)16 * 132 * 256 * 128 * 2 <= (size_t)NT * 1024 * 4 * 2, "GLA state buffer");
static_assert((size_t)16 * 3 * 1024 * 1024 * 2 <= (size_t)NT * 1024 * 4 * 2, "expert copies");

struct Params {
  const float *x, *c, *ctx, *c_ctx, *w_ada, *b_ada, *norm1_w, *norm2_w, *w_in, *w_gk_up, *b_gk, *gla_norm_w, *rpb,
      *w_bo_gla, *w_bo_na, *w_out, *w_router, *b_router, *w1, *w3, *w2, *final_norm_w;
  float* out;
  char* ws;
};
#define WSP(T, off) ((T*)(wsb + (off)))
typedef const unsigned long long __attribute__((address_space(4))) karg_t;
#define GAS __attribute__((address_space(1)))
#define WS_LOCAL karg_t* kab = (karg_t*)__builtin_amdgcn_kernarg_segment_ptr(); asm volatile("" : "+s"(kab)); char* wsb = (char*)(GAS char*)kab[23];
#define KARG(T, idx) ((T*)(GAS T*)kab[idx])

#define XB_TMO      128
#define XB_XCNT(j)  (256  + 64 * (j))
#define XB_XSUB(j)  (1280 + 64 * (j))
#define XB_XGEN(j)  (2304 + 64 * (j))
#define XB_TOP      3328
#define XB_TOPGEN   3392
#define XCD_BAR_WORDS 3456
#define XB_SPIN_CAP (1u << 22)
__device__ __forceinline__ unsigned xb_ld(unsigned* p) { return __hip_atomic_load(p, __ATOMIC_RELAXED, __HIP_MEMORY_SCOPE_AGENT); }
__device__ __forceinline__ unsigned xb_add(unsigned* p, unsigned v) { return __hip_atomic_fetch_add(p, v, __ATOMIC_RELAXED, __HIP_MEMORY_SCOPE_AGENT); }
__device__ __forceinline__ unsigned xb_xcc_id() { return (unsigned)__builtin_amdgcn_s_getreg((3 << 11) | 20) & 0xFu; }
#define XB_SPIN(cond, bar) do { unsigned _sp = 0; while (cond) { __builtin_amdgcn_s_sleep(1); \
    if ((++_sp & 255u) == 0u) { if (xb_ld(&(bar)[XB_TMO])) break; if (_sp > XB_SPIN_CAP) { atomicAdd(&(bar)[XB_TMO], 1u); break; } } } } while (0)
struct XcdBarrier { unsigned* bar; unsigned x; volatile LAS unsigned* st; };
__device__ __forceinline__ XcdBarrier xcd_barrier_post(unsigned* bar, volatile LAS unsigned* st) {
  XcdBarrier b; b.bar = bar; b.x = xb_xcc_id(); b.st = st;
  if (threadIdx.x == 0) (void)xb_add(&bar[XB_XCNT(b.x)], 1u);
  return b;
}
__device__ __forceinline__ void xcd_barrier_complete(unsigned* bar, unsigned x, unsigned& nloc, unsigned& nx) {
  const unsigned G = gridDim.x * gridDim.y * gridDim.z;
  unsigned sum, cnt, mine, sp = 0u;
  for (;;) {
    sum = 0u; cnt = 0u; mine = 0u;
#pragma unroll
    for (unsigned j = 0; j < 16; ++j) { const unsigned c = xb_ld(&bar[XB_XCNT(j)]); sum += c; cnt += (c > 0u) ? 1u : 0u; mine = (j == x) ? c : mine; }
    if (sum == G) break;
    __builtin_amdgcn_s_sleep(1);
    if ((++sp & 255u) == 0u) { if (xb_ld(&bar[XB_TMO])) break; if (sp > XB_SPIN_CAP) { atomicAdd(&bar[XB_TMO], 1u); break; } }
  }
  nloc = mine > 0u ? mine : 1u; nx = cnt > 0u ? cnt : 1u;
}
__device__ __forceinline__ void xcd_barrier1(const XcdBarrier& b);
__device__ __forceinline__ void xcd_barrier(const XcdBarrier& b) { xcd_barrier1(b); }
__device__ __forceinline__ void xcd_barrier1(const XcdBarrier& b0) {
  asm volatile("s_waitcnt vmcnt(0)" ::: "memory");
  __syncthreads();
  if (threadIdx.x == 0) {
    XcdBarrier b = b0;
    { unsigned long long a_ = (unsigned long long)b.bar; unsigned lo_ = (unsigned)a_, hi_ = (unsigned)(a_ >> 32), x_ = b.x, st_ = (unsigned)(size_t)b.st;
      asm volatile("" : "+s"(lo_), "+s"(hi_), "+s"(x_), "+s"(st_));
      b.bar = (unsigned*)(((unsigned long long)hi_ << 32) | lo_); b.x = x_; b.st = (volatile LAS unsigned*)(size_t)st_; }
    unsigned* bar = b.bar;
    __builtin_amdgcn_s_waitcnt(0);
    unsigned nloc = b.st[0], nx = b.st[1];
    if (nloc == 0u) { xcd_barrier_complete(bar, b.x, nloc, nx); b.st[0] = nloc; b.st[1] = nx; }
    const unsigned old = xb_add(&bar[XB_XSUB(b.x)], 1u);
    const unsigned gen = old / nloc;
    if (old + 1u == (gen + 1u) * nloc) {
      __builtin_amdgcn_fence(__ATOMIC_RELEASE, "agent");
      asm volatile("s_waitcnt vmcnt(0)" ::: "memory");
      const unsigned og = xb_add(&bar[XB_TOP], 1u);
      const unsigned tg = og / nx;
      if (og + 1u == (tg + 1u) * nx) xb_add(&bar[XB_TOPGEN], 1u);
      else XB_SPIN(xb_ld(&bar[XB_TOPGEN]) == tg, bar);
      __builtin_amdgcn_fence(__ATOMIC_ACQUIRE, "agent");
      xb_add(&bar[XB_XGEN(b.x)], 1u);
      asm volatile("s_waitcnt vmcnt(0)" ::: "memory");
    } else {
      XB_SPIN(xb_ld(&bar[XB_XGEN(b.x)]) == gen, bar);
      __builtin_amdgcn_fence(__ATOMIC_ACQUIRE, "agent");
      asm volatile("s_waitcnt vmcnt(0)" ::: "memory");
    }
  }
  __syncthreads();
}

typedef int v4i32 __attribute__((ext_vector_type(4)));
typedef int v8i32 __attribute__((ext_vector_type(8)));
__device__ __forceinline__ v8i32 cat8(bf16x8 lo, bf16x8 hi) { return __builtin_shufflevector(__builtin_bit_cast(v4i32, lo), __builtin_bit_cast(v4i32, hi), 0, 1, 2, 3, 4, 5, 6, 7); }
__device__ __forceinline__ unsigned pk4_fp8(float a, float b, float c, float d) {
  int v = __builtin_amdgcn_cvt_pk_fp8_f32(a, b, 0, false);
  v = __builtin_amdgcn_cvt_pk_fp8_f32(c, d, v, true);
  return (unsigned)v;
}
namespace pg8 {
constexpr int BM = 256, BK = 64, HALF = 128, HTB = HALF * BK * 2, NXCD = 8, WGM = 8;
__device__ __forceinline__ int lds_byte(int r, int c) { const int st = (r >> 4) * 2 + (c >> 5), rr = r & 15, cc = c & 31, ob = rr * 64 + cc * 2; return st * 1024 + (ob ^ (((ob >> 9) & 1) << 5)); }
__device__ __forceinline__ void stage_rc(int b, int& R, int& C) { const int st = b / 1024, sb = b % 1024, swz = sb ^ (((sb >> 9) & 1) << 5); R = (st >> 1) * 16 + swz / 64; C = (st & 1) * 32 + (swz % 64) / 2; }
__device__ __forceinline__ int perm32(int rho) { const int n = rho >> 4, i = rho & 15; return 8 * (i >> 2) + 4 * n + (i & 3); }
struct Unit { const char* A; const char* B; int pm, pn, e, aux; };

template <class Epi, class Sched, int HOOK_T, bool GATHER = false, bool FP8 = false>
__device__ __forceinline__ void gemm_phase(LAS unsigned char* lds, const int K, const Sched& S, const Epi& E) {
  const int tid = otid(), wid = __builtin_amdgcn_readfirstlane(tid >> 6), lane = tid & 63, wr = wid >> 2, wc = wid & 3, fr = lane & 15, fq = lane >> 4;
  const int nt = K / BK;
  unsigned voffA[2], voffB[2];
#pragma unroll
  for (int i = 0; i < 2; ++i) { int R, C; stage_rc(tid * 16 + i * 8192, R, C); const int Rb = Epi::PERM ? ((R & ~31) + perm32(R & 31)) : R;
    voffA[i] = (unsigned)(R * K + C) * 2u; voffB[i] = (unsigned)(Rb * K + C) * 2u; }
  const size_t kstep = (size_t)(BK * 2);
  const size_t hstep = (size_t)HALF * K * 2;
  int gR[2]; unsigned gC[2];
#pragma unroll
  for (int i = 0; i < 2; ++i) { int R, C; stage_rc(tid * 16 + i * 8192, R, C); gR[i] = R; gC[i] = (unsigned)C * 2u; }
  unsigned vC[2][2], vN[2][2], vX[2][2];
  const unsigned ldsw = (unsigned)wid * 1024u;
  const int aoff = lds_byte(wr * 64 + fr, fq * 8), boff = lds_byte(wc * 32 + fr, fq * 8);
#define PG8_SA(b, h) (((b) * 2 + (h)) * HTB)
#define PG8_SB(b, h) ((4 + (b) * 2 + (h)) * HTB)
#define PG8_STAGE(bufoff, gbase, voff) do { _Pragma("unroll") for (int _i = 0; _i < 2; ++_i) \
        __builtin_amdgcn_global_load_lds((const unsigned*)((const char*)(gbase) + (voff)[_i]), (LAS unsigned*)(lds + (bufoff) + ldsw + _i * 8192), 16, 0, 0); } while (0)
#define PG8_STAGE_A(bufoff, gbase, h, V) do { if constexpr (GATHER) { PG8_STAGE(bufoff, gbase, (V)[h]); } else { PG8_STAGE(bufoff, (gbase) + (h) * hstep, voffA); } } while (0)
#define PG8_GOFF(V, U) do { if constexpr (GATHER) { _Pragma("unroll") for (int _h = 0; _h < 2; ++_h) _Pragma("unroll") for (int _i = 0; _i < 2; ++_i) \
        (V)[_h][_i] = (unsigned)S.arow(U, gR[_i] + 128 * _h) * (unsigned)(K * 2) + gC[_i]; } } while (0)
#define PG8_LDA(dst, b, h) do { _Pragma("unroll") for (int m = 0; m < 4; ++m) _Pragma("unroll") for (int k = 0; k < 2; ++k) dst[m][k] = *(const LAS bf16x8*)(lds + PG8_SA(b, h) + aoff + m * 2048 + k * 1024); } while (0)
#define PG8_LDB(dst, b, h) do { _Pragma("unroll") for (int n = 0; n < 2; ++n) _Pragma("unroll") for (int k = 0; k < 2; ++k) dst[n][k] = *(const LAS bf16x8*)(lds + PG8_SB(b, h) + boff + n * 2048 + k * 1024); } while (0)
#define PG8_MMA(ai, bj, At, Bt) do { __builtin_amdgcn_s_setprio(1); \
      if constexpr (FP8) { _Pragma("unroll") for (int m = 0; m < 4; ++m) _Pragma("unroll") for (int n = 0; n < 2; ++n) \
        asm volatile("v_mfma_f32_16x16x128_f8f6f4 %0, %1, %2, %0" : "+v"(acc[ai][bj][m][n]) : "v"(cat8(Bt[n][0], Bt[n][1])), "v"(cat8(At[m][0], At[m][1]))); } \
      else { _Pragma("unroll") for (int m = 0; m < 4; ++m) _Pragma("unroll") for (int n = 0; n < 2; ++n) _Pragma("unroll") for (int k = 0; k < 2; ++k) \
        acc[ai][bj][m][n] = __builtin_amdgcn_mfma_f32_16x16x32_bf16(Bt[n][k], At[m][k], acc[ai][bj][m][n], 0, 0, 0); } \
      __builtin_amdgcn_s_setprio(0); } while (0)
#define PG8_WAIT_V(n) asm volatile("s_waitcnt vmcnt(" #n ")" ::: "memory")
#define PG8_WAIT_L(n) asm volatile("s_waitcnt lgkmcnt(" #n ")" ::: "memory")
#define PG8_BAR __builtin_amdgcn_s_barrier()
#define PG8_SCHED __builtin_amdgcn_sched_barrier(0)
#define PG8_KBODY \
      const bool last = (t == nt - 2); \
      const char* a1 = cA + (size_t)(t + 1) * kstep; \
      const char* a2 = last ? nA : cA + (size_t)(t + 2) * kstep; const char* b2 = last ? nB : cB + (size_t)(t + 2) * kstep; \
      const char* a3 = a2 + kstep; const char* b3 = b2 + kstep; \
      if constexpr (GATHER) { _Pragma("unroll") for (int _h = 0; _h < 2; ++_h) _Pragma("unroll") for (int _i = 0; _i < 2; ++_i) vX[_h][_i] = last ? vN[_h][_i] : vC[_h][_i]; } \
      PG8_LDB(B0, 0, 0); PG8_LDB(B1, 0, 1); PG8_SCHED; PG8_LDA(At, 0, 0); PG8_STAGE_A(PG8_SA(1, 1), a1, 1, vC); \
      PG8_WAIT_V(8); PG8_WAIT_L(0); PG8_BAR; PG8_MMA(0, 0, At, B0); PG8_MMA(0, 1, At, B1); PG8_BAR; PG8_SCHED; \
      PG8_LDA(At, 0, 1); PG8_STAGE(PG8_SB(0, 0), b2, voffB); PG8_STAGE(PG8_SB(0, 1), b2 + hstep, voffB); PG8_STAGE_A(PG8_SA(0, 0), a2, 0, vX); \
      PG8_WAIT_V(8); PG8_WAIT_L(0); PG8_BAR; PG8_MMA(1, 0, At, B0); PG8_MMA(1, 1, At, B1); PG8_BAR; PG8_SCHED; \
      PG8_LDB(B0, 1, 0); PG8_LDB(B1, 1, 1); PG8_SCHED; PG8_LDA(At, 1, 0); PG8_STAGE_A(PG8_SA(0, 1), a2, 1, vX); \
      PG8_WAIT_V(8); PG8_WAIT_L(0); PG8_BAR; PG8_MMA(0, 0, At, B0); PG8_MMA(0, 1, At, B1); PG8_BAR; PG8_SCHED; \
      PG8_LDA(At, 1, 1); PG8_STAGE(PG8_SB(1, 0), b3, voffB); PG8_STAGE(PG8_SB(1, 1), b3 + hstep, voffB); PG8_STAGE_A(PG8_SA(1, 0), a3, 0, vX); \
      PG8_WAIT_V(8); PG8_WAIT_L(0); PG8_BAR; PG8_MMA(1, 0, At, B0); PG8_MMA(1, 1, At, B1); PG8_BAR; PG8_SCHED;
  Unit cur, nxt; int ui = 0;
  if (!S.next(0, cur)) return;
  f32x4 acc[2][2][4][2];
#pragma unroll
  for (int a = 0; a < 2; ++a)
#pragma unroll
    for (int b = 0; b < 2; ++b)
#pragma unroll
      for (int m = 0; m < 4; ++m)
#pragma unroll
        for (int n = 0; n < 2; ++n) acc[a][b][m][n] = (f32x4){0.f, 0.f, 0.f, 0.f};
  bf16x8 At[4][2], B0[2][2], B1[2][2];
  const char* cA = cur.A; const char* cB = cur.B;
  PG8_GOFF(vC, cur);
  PG8_STAGE(PG8_SB(0, 0), cB, voffB); PG8_STAGE(PG8_SB(0, 1), cB + hstep, voffB); PG8_STAGE_A(PG8_SA(0, 0), cA, 0, vC); PG8_STAGE_A(PG8_SA(0, 1), cA, 1, vC);
  if (wr == 1) PG8_BAR;
  PG8_WAIT_V(2); PG8_BAR;
  PG8_STAGE(PG8_SB(1, 0), cB + kstep, voffB); PG8_STAGE_A(PG8_SA(1, 0), cA + kstep, 0, vC); PG8_STAGE(PG8_SB(1, 1), cB + hstep + kstep, voffB);
  PG8_WAIT_V(6); PG8_BAR;
  for (;;) {
    const bool has_next = S.next(ui + 1, nxt);
    const char* nA = has_next ? nxt.A : cA; const char* nB = has_next ? nxt.B : cB;
    if constexpr (GATHER) { if (has_next) { PG8_GOFF(vN, nxt); } else { _Pragma("unroll") for (int _h = 0; _h < 2; ++_h) _Pragma("unroll") for (int _i = 0; _i < 2; ++_i) vN[_h][_i] = vC[_h][_i]; } }
    if constexpr (HOOK_T > 0) {
      _Pragma("unroll 1") for (int t = 0; t < HOOK_T; t += 2) { PG8_KBODY }
      E.hook(acc, cur, wr, wc, fr, fq);
      _Pragma("unroll 1") for (int t = HOOK_T; t < nt; t += 2) { PG8_KBODY }
    } else {
      _Pragma("unroll 1") for (int t = 0; t < nt; t += 2) { PG8_KBODY }
    }
    if constexpr (FP8) asm volatile("s_nop 15\n\ts_nop 15" ::: "memory");
    if (wr == 0) PG8_BAR;
    E(acc, cur, wr, wc, fr, fq);
    if (!has_next) break;
#pragma unroll
    for (int a = 0; a < 2; ++a)
#pragma unroll
      for (int b = 0; b < 2; ++b)
#pragma unroll
        for (int m = 0; m < 4; ++m)
#pragma unroll
          for (int n = 0; n < 2; ++n) acc[a][b][m][n] = (f32x4){0.f, 0.f, 0.f, 0.f};
    cur = nxt; cA = nA; cB = nB; ++ui;
    if constexpr (GATHER) { _Pragma("unroll") for (int _h = 0; _h < 2; ++_h) _Pragma("unroll") for (int _i = 0; _i < 2; ++_i) vC[_h][_i] = vN[_h][_i]; }
    if (wr == 1) PG8_BAR;
  }
  PG8_WAIT_V(0);
  PG8_BAR;
#undef PG8_SA
#undef PG8_SB
#undef PG8_STAGE
#undef PG8_STAGE_A
#undef PG8_GOFF
#undef PG8_LDA
#undef PG8_LDB
#undef PG8_MMA
#undef PG8_WAIT_V
#undef PG8_WAIT_L
#undef PG8_BAR
#undef PG8_SCHED
#undef PG8_KBODY
}

struct DenseSched {
  __device__ __forceinline__ int arow(const Unit&, int) const { return 0; }
  int nM, nN, nwg, G, c; const char* A; const char* B; size_t tstep;
  __device__ __forceinline__ void init(int nM_, int nN_, int G_, int c_, const void* A_, const void* B_, int K) { nM = nM_; nN = nN_; nwg = nM * nN; G = G_; c = c_; A = (const char*)A_; B = (const char*)B_; tstep = (size_t)BM * K * 2; }
  __device__ __forceinline__ bool next(int i, Unit& u) const {
    const long L = (long)i * G + c; if (L >= nwg) return false;
    int wgid = (int)L; { const int q = nwg / NXCD, r = nwg % NXCD, xcd = wgid % NXCD, off = wgid / NXCD; wgid = (xcd < r ? xcd * (q + 1) : r * (q + 1) + (xcd - r) * q) + off; }
    const int nig = WGM * nN, gid = wgid / nig, fm = gid * WGM, gsz = (nM - fm) < WGM ? (nM - fm) : WGM;
    u.pm = fm + ((wgid % nig) % gsz); u.pn = (wgid % nig) / gsz; u.e = 0; u.aux = 0;
    u.A = A + (size_t)u.pm * tstep; u.B = B + (size_t)u.pn * tstep; return true;
  }
};
struct SingleSched {
  Unit u0;
  __device__ __forceinline__ int arow(const Unit&, int) const { return 0; }
  __device__ __forceinline__ bool next(int i, Unit& u) const { if (i != 0) return false; u = u0; return true; }
};
struct MoeSched {
  int U, nN, G, c; const char* A; const char* B; size_t tstep, estep; volatile LAS int* tab; const int* list; bool gather;
  __device__ __forceinline__ int arow(const Unit& u, int r) const { const int rl = u.aux * 256 + r; return (rl < tab[96 + u.e]) ? (list[(size_t)u.e * NT + rl] >> 1) : 0; }
  __device__ __forceinline__ bool next(int i, Unit& u) const {
    const long L = (long)i * G + c; if (L >= U) return false;
    int w = (int)L; { const int q = U / NXCD, r = U % NXCD, xcd = w % NXCD, off = w / NXCD; w = (xcd < r ? xcd * (q + 1) : r * (q + 1) + (xcd - r) * q) + off; }
    int e = 0;
#pragma unroll 1
    for (int k = 1; k < 16; ++k) e += (w >= tab[k]) ? 1 : 0;
    const int local = w - tab[e], mt = tab[32 + e], tb = tab[64 + e];
    const int pn = local / mt, pml = local - pn * mt;
    u.e = __builtin_amdgcn_readfirstlane(e); u.aux = __builtin_amdgcn_readfirstlane(pml);
    u.pm = __builtin_amdgcn_readfirstlane(tb + pml); u.pn = __builtin_amdgcn_readfirstlane(pn);
    u.A = gather ? A : A + (size_t)u.pm * tstep; u.B = B + (size_t)u.e * estep + (size_t)u.pn * tstep; return true;
  }
};
}
using pg8::Unit;
typedef f32x4 AccT[2][2][4][2];

struct EpiProj {
  static constexpr bool PERM = true;
  bf16_t* O; float* lr32;
  __device__ __forceinline__ void operator()(const AccT& acc, const Unit& u, int wr, int wc, int fr, int fq) const {
    const int row0 = u.pm * 256 + wr * 64 + fr, col0 = u.pn * 256 + wc * 32 + 8 * fq;
    const bool lrt = (u.pn == 12) && (wc == 0);
#pragma unroll
    for (int ai = 0; ai < 2; ++ai)
#pragma unroll
      for (int m = 0; m < 4; ++m) {
        const int row = row0 + ai * 128 + m * 16;
        bf16_t* rowp = O + (size_t)row * PSTR + col0;
#pragma unroll
        for (int bj = 0; bj < 2; ++bj) {
          const f32x4 v0 = acc[ai][bj][m][0] * 0.0625f, v1 = acc[ai][bj][m][1] * 0.0625f;
          u32x4 w; w.x = pk2(v0[0], v0[1]); w.y = pk2(v0[2], v0[3]); w.z = pk2(v1[0], v1[1]); w.w = pk2(v1[2], v1[3]);
          *(u32x4*)(rowp + bj * 128) = w;
          if (bj == 0 && lrt) { float* lp = lr32 + (size_t)row * 32 + 8 * fq; *(f32x4*)lp = v0; *(f32x4*)(lp + 4) = v1; }
        }
      }
  }
  __device__ __forceinline__ void hook(AccT&, const Unit&, int, int, int, int) const {}
};
struct EpiMerge {
  static constexpr bool PERM = true;
  const bf16_t* proj; bf16_t* O;
  __device__ __forceinline__ void hook(AccT& acc, const Unit& u, int wr, int wc, int fr, int fq) const {
    const int row0 = u.pm * 256 + wr * 64 + fr, col0 = u.pn * 256 + wc * 32 + 8 * fq;
#pragma unroll
    for (int ai = 0; ai < 2; ++ai) {
      u32x4 g0[4][2], g1[4][2];
#pragma unroll
      for (int m = 0; m < 4; ++m) {
        const bf16_t* gp = proj + (size_t)(row0 + ai * 128 + m * 16) * PSTR + col0;
#pragma unroll
        for (int bj = 0; bj < 2; ++bj) { g0[m][bj] = *(const u32x4*)(gp + 4640 + bj * 128); g1[m][bj] = *(const u32x4*)(gp + 5664 + bj * 128); }
      }
#pragma unroll
      for (int m = 0; m < 4; ++m)
#pragma unroll
        for (int bj = 0; bj < 2; ++bj)
#pragma unroll
          for (int q = 0; q < 4; ++q) {
            const float a0 = bflo(g0[m][bj][q]), a1 = bfhi(g0[m][bj][q]), b0 = bflo(g1[m][bj][q]), b1 = bfhi(g1[m][bj][q]);
            const float r0 = (1.f + __expf(-b0)) * __builtin_amdgcn_rcpf(1.f + __expf(-a0)), r1 = (1.f + __expf(-b1)) * __builtin_amdgcn_rcpf(1.f + __expf(-a1));
            acc[ai][bj][m][q >> 1][(q & 1) * 2] *= r0; acc[ai][bj][m][q >> 1][(q & 1) * 2 + 1] *= r1;
          }
      __builtin_amdgcn_sched_barrier(0);
    }
  }
  __device__ __forceinline__ void operator()(const AccT& acc, const Unit& u, int wr, int wc, int fr, int fq) const {
    int row0 = u.pm * 256 + wr * 64 + fr; const int col0 = u.pn * 256 + wc * 32 + 8 * fq;
    asm volatile("" : "+v"(row0));
#pragma unroll
    for (int ai = 0; ai < 2; ++ai)
#pragma unroll
      for (int m = 0; m < 4; ++m) {
        const int row = row0 + ai * 128 + m * 16;
        const bf16_t* gp = proj + (size_t)row * PSTR + col0 + 5664;
        bf16_t* op = O + (size_t)row * 1024 + col0;
#pragma unroll
        for (int bj = 0; bj < 2; ++bj) {
          const u32x4 g1 = *(const u32x4*)(gp + bj * 128);
          float o[8];
#pragma unroll
          for (int q = 0; q < 4; ++q) {
            o[2 * q] = acc[ai][bj][m][q >> 1][(q & 1) * 2] * sigmoidf_(bflo(g1[q]));
            o[2 * q + 1] = acc[ai][bj][m][q >> 1][(q & 1) * 2 + 1] * sigmoidf_(bfhi(g1[q]));
          }
          u32x4 w; w.x = pk2(o[0], o[1]); w.y = pk2(o[2], o[3]); w.z = pk2(o[4], o[5]); w.w = pk2(o[6], o[7]);
          *(u32x4*)(op + bj * 128) = w;
        }
      }
  }
};
struct EpiOut {
  static constexpr bool PERM = true;
  bf16_t* Y;
  __device__ __forceinline__ void operator()(const AccT& acc, const Unit& u, int wr, int wc, int fr, int fq) const {
    const int row0 = u.pm * 256 + wr * 64 + fr, col0 = u.pn * 256 + wc * 32 + 8 * fq;
#pragma unroll
    for (int ai = 0; ai < 2; ++ai)
#pragma unroll
      for (int m = 0; m < 4; ++m) {
        bf16_t* yp = Y + (size_t)(row0 + ai * 128 + m * 16) * 1024 + col0;
#pragma unroll
        for (int bj = 0; bj < 2; ++bj) {
          const f32x4 v0 = acc[ai][bj][m][0], v1 = acc[ai][bj][m][1];
          u32x4 w; w.x = pk2(v0[0], v0[1]); w.y = pk2(v0[2], v0[3]); w.z = pk2(v1[0], v1[1]); w.w = pk2(v1[2], v1[3]);
          *(u32x4*)(yp + bj * 128) = w;
        }
      }
  }
  __device__ __forceinline__ void hook(AccT&, const Unit&, int, int, int, int) const {}
};
struct EpiMoe1 {
  static constexpr bool PERM = true;
  unsigned char* hid;
  __device__ __forceinline__ void operator()(const AccT& acc, const Unit& u, int wr, int wc, int fr, int fq) const {
    const int row0 = u.pm * 256 + wr * 64 + fr, hc0 = u.pn * 128 + wc * 16 + 4 * fq;
#pragma unroll
    for (int ai = 0; ai < 2; ++ai)
#pragma unroll
      for (int m = 0; m < 4; ++m) {
        unsigned char* hp = hid + (size_t)(row0 + ai * 128 + m * 16) * 1024 + hc0;
#pragma unroll
        for (int bj = 0; bj < 2; ++bj) {
          const f32x4 a = acc[ai][bj][m][0], b = acc[ai][bj][m][1];
          float hv[4];
#pragma unroll
          for (int j = 0; j < 4; ++j) hv[j] = __builtin_amdgcn_fmed3f(siluf_(a[j] * 0.0625f) * (b[j] * 0.5f), -440.f, 440.f);
          *(unsigned*)(hp + bj * 64) = pk4_fp8(hv[0], hv[1], hv[2], hv[3]);
        }
      }
  }
  __device__ __forceinline__ void hook(AccT&, const Unit&, int, int, int, int) const {}
};
struct EpiMoe2 {
  static constexpr bool PERM = true;
  bf16_t* yb; const int* list; const float* topw; volatile LAS int* tab;
  __device__ __forceinline__ void operator()(const AccT& acc, const Unit& u, int wr, int wc, int fr, int fq) const {
    const int rl0 = u.aux * 256 + wr * 64 + fr, col0 = u.pn * 256 + wc * 32 + 8 * fq;
    const int cnt = tab[96 + u.e];
    const int* lst = list + (size_t)u.e * NT;
#pragma unroll
    for (int ai = 0; ai < 2; ++ai)
#pragma unroll
      for (int m = 0; m < 4; ++m) {
        const int rl = rl0 + ai * 128 + m * 16;
        if (rl < cnt) {
          const int pr = lst[rl];
          const float tw = topw[pr] * (1.f / 128.f);
          bf16_t* op = yb + (size_t)pr * 1024 + col0;
#pragma unroll
          for (int bj = 0; bj < 2; ++bj) {
            const f32x4 v0 = acc[ai][bj][m][0] * tw, v1 = acc[ai][bj][m][1] * tw;
            u32x4 w; w.x = pk2(v0[0], v0[1]); w.y = pk2(v0[2], v0[3]); w.z = pk2(v1[0], v1[1]); w.w = pk2(v1[2], v1[3]);
            *(u32x4*)(op + bj * 128) = w;
          }
        }
      }
  }
  __device__ __forceinline__ void hook(AccT&, const Unit&, int, int, int, int) const {}
};

template <int MODE>
__device__ __forceinline__ void transpose_item(const float* W, int ldw, bf16_t* WT, int ldt, int koff, LAS float* scr, int kb, int nb, int lane) {
  const int k0 = 64 * kb, n0 = 32 * nb;
  {
    const int n4 = (lane & 7) * 4;
    f32x4 v[8];
#pragma unroll
    for (int i = 0; i < 8; ++i) v[i] = *(const f32x4*)(W + (size_t)(k0 + 8 * i + (lane >> 3)) * ldw + n0 + n4);
#pragma unroll
    for (int i = 0; i < 8; ++i) { LAS float* d = scr + (8 * i + (lane >> 3)) * 33 + n4; d[0] = v[i][0]; d[1] = v[i][1]; d[2] = v[i][2]; d[3] = v[i][3]; }
  }
  asm volatile("s_waitcnt lgkmcnt(0)" ::: "memory");
  const int c = lane & 7;
#pragma unroll
  for (int j = 0; j < 4; ++j) {
    const int n = (lane >> 3) + 8 * j; const LAS float* s = scr + (8 * c) * 33 + n;
    u32x4 o; o.x = pk2(s[0 * 33], s[1 * 33]); o.y = pk2(s[2 * 33], s[3 * 33]); o.z = pk2(s[4 * 33], s[5 * 33]); o.w = pk2(s[6 * 33], s[7 * 33]);
    const int ng = n0 + n;
    const int dr = (MODE == 0) ? ng : ((ng >> 2) * 8 + (ng & 3) + (MODE == 2 ? 4 : 0));
    *(u32x4*)(WT + (size_t)dr * ldt + koff + k0 + 8 * c) = o;
  }
  asm volatile("s_waitcnt lgkmcnt(0)" ::: "memory");
}

template <int MODE>
__device__ __forceinline__ void transpose_item_fp8(const float* W, int ldw, unsigned char* WT, int ldt, LAS float* scr, int kb, int nb, int lane) {
  const int k0 = 64 * kb, n0 = 32 * nb;
  {
    const int n4 = (lane & 7) * 4;
    f32x4 v[8];
#pragma unroll
    for (int i = 0; i < 8; ++i) v[i] = *(const f32x4*)(W + (size_t)(k0 + 8 * i + (lane >> 3)) * ldw + n0 + n4);
#pragma unroll
    for (int i = 0; i < 8; ++i) { LAS float* d = scr + (8 * i + (lane >> 3)) * 33 + n4; d[0] = v[i][0]; d[1] = v[i][1]; d[2] = v[i][2]; d[3] = v[i][3]; }
  }
  asm volatile("s_waitcnt lgkmcnt(0)" ::: "memory");
  const int c = lane & 7;
#pragma unroll
  for (int j = 0; j < 4; ++j) {
    const int n = (lane >> 3) + 8 * j; const LAS float* sp = scr + (8 * c) * 33 + n;
    u32x2 o; o.x = pk4_fp8(16.f * sp[0 * 33], 16.f * sp[1 * 33], 16.f * sp[2 * 33], 16.f * sp[3 * 33]); o.y = pk4_fp8(16.f * sp[4 * 33], 16.f * sp[5 * 33], 16.f * sp[6 * 33], 16.f * sp[7 * 33]);
    const int ng = n0 + n;
    const int dr = (MODE == 0) ? ng : ((ng >> 2) * 8 + (ng & 3) + (MODE == 2 ? 4 : 0));
    *(u32x2*)(WT + (size_t)dr * ldt + k0 + 8 * c) = o;
  }
  asm volatile("s_waitcnt lgkmcnt(0)" ::: "memory");
}
__device__ void ph_init(const Params& p, LAS unsigned char* lds, int bid, int nb) {
  WS_LOCAL
  const int tid = otid(), wave = tid >> 6, lane = tid & 63;
  LAS float* sc = (LAS float*)(lds + 8 * 8448);
  for (int i = tid; i < 3 * 1024; i += NTHR) {
    int r = i >> 10, k = i & 1023;
    float v = (r < 2) ? KARG(const float, 1)[r * 1024 + k] : KARG(const float, 3)[k];
    sc[i] = v / (1.f + expf(-v));
  }
  __syncthreads();
  LAS float* scr = (LAS float*)(lds + wave * 8448);
  const int gw = bid * NWAVES + wave, NGW = nb * NWAVES;
  constexpr int I_ADA = 2 * 24 * 32, I_IN = 16 * 209, I_MG = 16 * 32, I_MN = 8 * 32, I_O = 16 * 32, I_PAD = 224, I_ROPE = 64;
  constexpr int NITEMS = I_ADA + 2 * (I_IN + I_MG + I_MN + I_O + I_PAD) + I_ROPE;
  for (int it = gw; it < NITEMS; it += NGW) {
    int r = it;
    if (r < I_ADA) {
      const int l = r / 768, cb = (r % 768) >> 5, ks = r & 31, col0 = cb * 256 + lane * 4;
      const float* w = KARG(const float, 4) + ((size_t)l * 1024 + ks * 32) * 6144 + col0;
      f32x4 wv[32];
#pragma unroll
      for (int i = 0; i < 32; ++i) wv[i] = __builtin_nontemporal_load((const f32x4*)(w + (size_t)i * 6144));
      f32x4 a0 = {0.f, 0.f, 0.f, 0.f}, a1 = a0, a2 = a0;
#pragma unroll
      for (int i = 0; i < 32; ++i) { const int k = ks * 32 + i; a0 += sc[k] * wv[i]; a1 += sc[1024 + k] * wv[i]; a2 += sc[2048 + k] * wv[i]; }
      float* part = WSP(float, WS_APART) + ((size_t)(l * 32 + ks) * 3) * 6144 + col0;
      *(f32x4*)(part) = a0; *(f32x4*)(part + 6144) = a1; *(f32x4*)(part + 2 * 6144) = a2;
      continue;
    }
    r -= I_ADA;
    if (r < I_ROPE) {
      const int idx = r * 64 + lane, pos = idx >> 5, i = idx & 31;
      const float inv = exp2f(-(float)i * (13.287712379549449f / 32.f)), ang = (float)pos * inv;
      const float kk = rintf(ang * 0.15915494309189535f);
      float rr = fmaf(-kk, 6.2831854820251465f, ang); rr = fmaf(-kk, -1.7484556000744883e-07f, rr);
      WSP(float, WS_ROPE)[idx * 2] = cosf(rr); WSP(float, WS_ROPE)[idx * 2 + 1] = sinf(rr);
      continue;
    }
    r -= I_ROPE;
    const int per = I_IN + I_MG + I_MN + I_O + I_PAD;
    const int l = r / per; r -= l * per;
    if (r < I_IN) { transpose_item_fp8<0>(KARG(const float, 8) + (size_t)l * 1024 * INC, INC, WSP(unsigned char, WS_WINT) + (size_t)l * PSTR * 1024, 1024, scr, r / 209, r % 209, lane); continue; } r -= I_IN;
    if (r < I_MG) { transpose_item<0>(KARG(const float, 13) + (size_t)l * 1024 * 1024, 1024, WSP(bf16_t, WS_WMT) + (size_t)l * 1024 * GSTR, GSTR, 0, scr, r / 32, r % 32, lane); continue; } r -= I_MG;
    if (r < I_MN) { transpose_item<0>(KARG(const float, 14) + (size_t)l * 512 * 1024, 1024, WSP(bf16_t, WS_WMT) + (size_t)l * 1024 * GSTR, GSTR, 1024, scr, r / 32, r % 32, lane); continue; } r -= I_MN;
    if (r < I_O) { transpose_item<0>(KARG(const float, 15) + (size_t)l * 1024 * 1024, 1024, WSP(bf16_t, WS_WOT) + (size_t)l * 1024 * 1024, 1024, 0, scr, r / 32, r % 32, lane); continue; } r -= I_O;
    {
      unsigned zz = 0u; asm volatile("" : "+v"(zz));
      u32x4 z = {zz, zz, zz, zz};
      u32x4* dst = (u32x4*)(WSP(unsigned char, WS_WINT) + (size_t)l * PSTR * 1024 + (size_t)(INC + r) * 1024);
      dst[lane] = z;
    }
  }
}
__device__ void ph_ada_reduce(const Params& p, int bid, int nb) {
  WS_LOCAL
  const int tid = otid(), wave = tid >> 6, lane = tid & 63;
  for (int it = bid * NWAVES + wave; it < 48; it += nb * NWAVES) {
    const int l = it / 24, cb = it % 24, col0 = cb * 256 + lane * 4;
    const float* pb = WSP(float, WS_APART) + ((size_t)(l * 32) * 3) * 6144 + col0;
    const f32x4 bb = *(const f32x4*)(KARG(const float, 5) + l * 6144 + col0);
#pragma unroll
    for (int rr = 0; rr < 3; ++rr) {
      f32x4 sum = bb;
#pragma unroll
      for (int k8 = 0; k8 < 32; ++k8) sum += *(const f32x4*)(pb + ((size_t)k8 * 3 + rr) * 6144);
      *(f32x4*)(WSP(float, WS_MOD) + (l * 3 + rr) * 6144 + col0) = sum;
    }
  }
}
__device__ void ph_experts(const Params& p, int l, LAS unsigned char* lds, int bid, int nb) {
  WS_LOCAL
  const int tid = otid(), wave = tid >> 6, lane = tid & 63;
  LAS float* scr = (LAS float*)(lds + wave * 8448);
  const int skipb = (l == 0) ? 16 : 0;
  if (bid < skipb) return;
  const int gw = (bid - skipb) * NWAVES + wave, NGW = (nb - skipb) * NWAVES;
  for (int it = gw; it < 16 * 3 * 512; it += NGW) {
    const int e = it / 1536, r = it % 1536, mat = r / 512, q = r % 512;
    const size_t eo = ((size_t)(l * 16 + e)) << 20;
    if (mat == 0) transpose_item_fp8<1>(KARG(const float, 18) + eo, 1024, WSP(unsigned char, WS_RG) + ((size_t)e << 21), 1024, scr, q / 32, q % 32, lane);
    else if (mat == 1) transpose_item_fp8<2>(KARG(const float, 19) + eo, 1024, WSP(unsigned char, WS_RG) + ((size_t)e << 21), 1024, scr, q / 32, q % 32, lane);
    else transpose_item_fp8<0>(KARG(const float, 20) + eo, 1024, WSP(unsigned char, WS_W2F8) + ((size_t)e << 20), 1024, scr, q / 32, q % 32, lane);
  }
}

__device__ void ph_norm1(const Params& p, int l, int bid, int nb) {
  WS_LOCAL
  const int tid = otid(), wave = tid >> 6, lane = tid & 63;
  const int NGW = nb * NWAVES;
  for (int rowa = bid * NWAVES + wave; rowa < NT; rowa += 2 * NGW) {
    f32x4 v[2][4];
    int rows[2]; rows[0] = rowa; rows[1] = rowa + NGW;
    const bool has2 = rows[1] < NT;
    if (!has2) rows[1] = rowa;
#pragma unroll
    for (int u = 0; u < 2; ++u) {
      const int row = rows[u];
      if (l == 0) {
        const float* src = (row < NL) ? KARG(const float, 0) + (size_t)row * 1024 : KARG(const float, 2) + (size_t)(row - NL) * 1024;
#pragma unroll
        for (int i = 0; i < 4; ++i) v[u][i] = __builtin_nontemporal_load((const f32x4*)(src + i * 256 + lane * 4));
      } else {
        const int r = (row < NL) ? (row >> 13) : 2;
        const float* src = WSP(float, WS_XBUF) + (size_t)row * 1024;
        const float* m5 = WSP(float, WS_MOD) + (0 * 3 + r) * 6144 + 5 * 1024;
        const bf16_t* y0 = WSP(bf16_t, WS_PROJ + 2 * PROWS * 2048) + (size_t)(row * 2) * 1024;
#pragma unroll
        for (int i = 0; i < 4; ++i) {
          const int j = i * 256 + lane * 4;
          v[u][i] = *(const f32x4*)(src + j);
          const u32x2 ya = __builtin_nontemporal_load((const u32x2*)(y0 + j)), yb = __builtin_nontemporal_load((const u32x2*)(y0 + 1024 + j));
          const f32x4 g = *(const f32x4*)(m5 + j);
          v[u][i][0] += g[0] * (bflo(ya.x) + bflo(yb.x)); v[u][i][1] += g[1] * (bfhi(ya.x) + bfhi(yb.x));
          v[u][i][2] += g[2] * (bflo(ya.y) + bflo(yb.y)); v[u][i][3] += g[3] * (bfhi(ya.y) + bfhi(yb.y));
        }
      }
    }
#pragma unroll
    for (int u = 0; u < 2; ++u) {
      if (u == 1 && !has2) break;
      const int row = rows[u];
      const int r = (row < NL) ? (row >> 13) : 2;
      float ss = 0.f;
#pragma unroll
      for (int i = 0; i < 4; ++i) ss += v[u][i][0] * v[u][i][0] + v[u][i][1] * v[u][i][1] + v[u][i][2] * v[u][i][2] + v[u][i][3] * v[u][i][3];
      ss = wave_sum(ss);
      const float rstd = rsqrtf(ss * (1.f / 1024.f) + 1e-6f);
      const float* md = WSP(float, WS_MOD) + (l * 3 + r) * 6144;
      const float* nw = KARG(const float, 6) + l * 1024;
#pragma unroll
      for (int i = 0; i < 4; ++i) {
        const int j = i * 256 + lane * 4;
        const f32x4 w = *(const f32x4*)(nw + j), m1 = *(const f32x4*)(md + 1024 + j), m0 = *(const f32x4*)(md + j);
        f32x4 h;
#pragma unroll
        for (int q = 0; q < 4; ++q) h[q] = v[u][i][q] * rstd * w[q] * (1.f + m1[q]) + m0[q];
        *(unsigned*)(WSP(unsigned char, WS_HM) + (size_t)row * 1024 + j) = pk4_fp8(h[0], h[1], h[2], h[3]);
        if (l != 0) *(f32x4*)(WSP(float, WS_XBUF) + (size_t)row * 1024 + j) = v[u][i];
      }
    }
  }
}

typedef short s16x4 __attribute__((ext_vector_type(4)));
__device__ __forceinline__ s16x4 ds_tr(const LAS unsigned char* p) { return __builtin_amdgcn_ds_read_tr16_b64_v4i16((LAS s16x4*)p); }
#define NA_RS 144
#define NAU 4
__device__ void na_wave_task(const Params& p, int l, LAS unsigned char* vlb, LAS unsigned char* vl, int task, int lane) {
  WS_LOCAL
  const int fr = lane & 15, g = lane >> 4, q4 = fr >> 2, p4 = fr & 3;
  constexpr int NLAT = 2 * (128 / NAU) * 4 * 8;
  int b, h, nloc, jg = 0, cb = 0, rbase = 0, rmin = 0;
  int qrow[NAU], ru[NAU], r0u[NAU];
  if (task < NLAT) {
    h = task & 7; jg = (task >> 3) & 3; const int rg = (task >> 5) % (128 / NAU); b = task / (32 * (128 / NAU));
    rbase = rg * NAU; cb = (jg == 0) ? 0 : (jg == 1) ? 8 : (jg == 2) ? 24 : 32;
#pragma unroll
    for (int u = 0; u < NAU; ++u) { ru[u] = rbase + u; r0u[u] = min(max(ru[u] - 4, 0), 120); qrow[u] = b * 8192 + ru[u] * 64 + 16 * jg; }
    rmin = r0u[0]; nloc = r0u[NAU - 1] + 8 - rmin;
  } else {
    const int t2 = task - NLAT; h = t2 & 7; const int qg = (t2 >> 3) % (16 / NAU); b = t2 / (8 * (16 / NAU));
#pragma unroll
    for (int u = 0; u < NAU; ++u) { ru[u] = 0; r0u[u] = 0; qrow[u] = NL + b * 256 + (qg * NAU + u) * 16; }
    nloc = 0;
  }
  const bf16_t* pj = WSP(bf16_t, WS_PROJ);
  bf16x8 qf[NAU][2];
#pragma unroll
  for (int u = 0; u < NAU; ++u)
#pragma unroll
    for (int ks = 0; ks < 2; ++ks) qf[u][ks] = *(const bf16x8*)(pj + (size_t)(qrow[u] + fr) * PSTR + 3104 + h * 64 + 32 * ks + 8 * g);
  const LAS float* rp = (const LAS float*)(vlb + 40960) + h * 465;
  const int cq = 16 * jg + fr, c0 = min(max(cq - 8, 0), 48);
  f32x4 oacc[NAU][4];
#pragma unroll
  for (int u = 0; u < NAU; ++u)
#pragma unroll
    for (int c = 0; c < 4; ++c) oacc[u][c] = (f32x4){0.f, 0.f, 0.f, 0.f};
  float mrun[NAU], lsum[NAU];
#pragma unroll
  for (int u = 0; u < NAU; ++u) { mrun[u] = -1e30f; lsum[u] = 0.f; }
  const int nst = nloc + 8;
#pragma unroll 1
  for (int st = 0; st < nst; ++st) {
    const bool loc = st < nloc;
    const int kr = rmin + st;
    const int kbase = loc ? (b * 8192 + kr * 64 + cb) : (NL + b * 256 + (st - nloc) * 32);
    bf16x8 kf[2][2]; u32x4 vv[4];
#pragma unroll
    for (int tb = 0; tb < 2; ++tb)
#pragma unroll
      for (int ks = 0; ks < 2; ++ks) kf[tb][ks] = *(const bf16x8*)(pj + (size_t)(kbase + 16 * tb + fr) * PSTR + 3616 + h * 64 + 32 * ks + 8 * g);
#pragma unroll
    for (int i = 0; i < 4; ++i) { const int ci = lane + 64 * i, key = ci >> 3, dch = ci & 7; vv[i] = *(const u32x4*)(pj + (size_t)(kbase + key) * PSTR + 4128 + h * 64 + dch * 8); }
    bool okc[8]; int cix[8];
#pragma unroll
    for (int k = 0; k < 8; ++k) { const int kc = cb + 16 * (k >> 2) + 4 * g + (k & 3); okc[k] = (kc >= c0) && (kc < c0 + 16); cix[k] = min(max(kc - cq + 15, 0), 30); }
#pragma unroll
    for (int i = 0; i < 4; ++i) { const int ci = lane + 64 * i, key = ci >> 3, dch = ci & 7; *(LAS u32x4*)(vl + key * NA_RS + dch * 16) = vv[i]; }
    bf16x8 pf[NAU];
#pragma unroll
    for (int u = 0; u < NAU; ++u) {
      f32x4 sc[2];
#pragma unroll
      for (int tb = 0; tb < 2; ++tb) {
        sc[tb] = __builtin_amdgcn_mfma_f32_16x16x32_bf16(kf[tb][0], qf[u][0], (f32x4){0.f, 0.f, 0.f, 0.f}, 0, 0, 0);
        sc[tb] = __builtin_amdgcn_mfma_f32_16x16x32_bf16(kf[tb][1], qf[u][1], sc[tb], 0, 0, 0);
      }
      float sv[8]; float mst = -1e30f;
      if (loc) {
        const bool rowok = (kr >= r0u[u]) && (kr < r0u[u] + 8);
        const LAS float* rrow = rp + min(max(kr - ru[u] + 7, 0), 14) * 31;
        float bias[8];
#pragma unroll
        for (int k = 0; k < 8; ++k) bias[k] = rrow[cix[k]];
        asm volatile("" : "+v"(bias[0]), "+v"(bias[1]), "+v"(bias[2]), "+v"(bias[3]), "+v"(bias[4]), "+v"(bias[5]), "+v"(bias[6]), "+v"(bias[7]));
#pragma unroll
        for (int k = 0; k < 8; ++k) { const float v = (okc[k] && rowok) ? sc[k >> 2][k & 3] * 0.125f + bias[k] : -INFINITY; sv[k] = v; mst = fmaxf(mst, v); }
      } else {
#pragma unroll
        for (int k = 0; k < 8; ++k) { const float v = sc[k >> 2][k & 3] * 0.125f; sv[k] = v; mst = fmaxf(mst, v); }
      }
      mst = fmaxf(mst, __shfl_xor(mst, 16, 64)); mst = fmaxf(mst, __shfl_xor(mst, 32, 64));
      const float mnew = fmaxf(mrun[u], mst); const float alpha = __expf(mrun[u] - mnew); mrun[u] = mnew;
      float ps = 0.f; float pv[8];
#pragma unroll
      for (int k = 0; k < 8; ++k) { const float e = __expf(sv[k] - mnew); pv[k] = e; ps += e; }
      lsum[u] = lsum[u] * alpha + ps;
#pragma unroll
      for (int c = 0; c < 4; ++c) oacc[u][c] *= alpha;
#pragma unroll
      for (int q = 0; q < 4; ++q) { const unsigned w = pk2(pv[2 * q], pv[2 * q + 1]); pf[u][2 * q] = (short)(w & 0xffffu); pf[u][2 * q + 1] = (short)(w >> 16); }
    }
    asm volatile("s_waitcnt lgkmcnt(0)" ::: "memory");
#pragma unroll
    for (int c = 0; c < 4; ++c) {
      const s16x4 lo = ds_tr(vl + (4 * g + q4) * NA_RS + (16 * c + 4 * p4) * 2);
      const s16x4 hi = ds_tr(vl + (16 + 4 * g + q4) * NA_RS + (16 * c + 4 * p4) * 2);
      bf16x8 vf; vf[0] = lo[0]; vf[1] = lo[1]; vf[2] = lo[2]; vf[3] = lo[3]; vf[4] = hi[0]; vf[5] = hi[1]; vf[6] = hi[2]; vf[7] = hi[3];
#pragma unroll
      for (int u = 0; u < NAU; ++u) oacc[u][c] = __builtin_amdgcn_mfma_f32_16x16x32_bf16(vf, pf[u], oacc[u][c], 0, 0, 0);
    }
    asm volatile("s_waitcnt lgkmcnt(0)" ::: "memory");
  }
#pragma unroll
  for (int u = 0; u < NAU; ++u) {
    float ls = lsum[u];
    ls += __shfl_xor(ls, 16, 64); ls += __shfl_xor(ls, 32, 64);
    const float inv = 1.f / ls;
    bf16_t* op = WSP(bf16_t, WS_GM) + (size_t)(qrow[u] + fr) * GSTR + 1024 + h * 64 + 4 * g;
#pragma unroll
    for (int c = 0; c < 4; ++c) {
      u32x2 w; w.x = pk2(oacc[u][c][0] * inv, oacc[u][c][1] * inv); w.y = pk2(oacc[u][c][2] * inv, oacc[u][c][3] * inv);
      *(u32x2*)(op + 16 * c) = w;
    }
  }
}
__device__ void na_phase(const Params& p, int l, LAS unsigned char* lds, int bid, int nb, int mode) {
  WS_LOCAL
  const int tid = otid(), wave = tid >> 6, lane = tid & 63;
  LAS unsigned char* vlb = lds + 4096;
  LAS unsigned char* vl = vlb + wave * 4608;
  constexpr int NLAT = 2 * (128 / NAU) * 4 * 8, NCTX = 2 * (16 / NAU) * 8;
  int t0, t1, ts;
  if (mode == 0) {
    LAS float* rl = (LAS float*)(vlb + 40960);
    const float* rg = KARG(const float, 12) + (size_t)l * 8 * 465;
    for (int k = tid; k < 8 * 465; k += NTHR) rl[k] = rg[k];
    t0 = bid * NWAVES + wave; t1 = NLAT; ts = nb * NWAVES;
  } else {
    const bool on = (l == 0) && (bid >= 32) && (bid < 32 + NCTX / NWAVES);
    t0 = NLAT + (bid - 32) * NWAVES + wave; t1 = on ? NLAT + NCTX : 0; ts = NLAT + NCTX;
  }
  __syncthreads();
  for (int t = t0; t < t1; t += ts) na_wave_task(p, l, vlb, vl, t, lane);
  __syncthreads();
}
#define G_LRS 0
#define G_TOT 8192
#define G_RED 10240
#define G_VT 12288
#define G_KT 46080
#define G_QB 63488
#define G_QE 80896
#define G_ATT 98304
#define G_RK 107520
#define G_RQ (MISC_OFF + 2048)
#define VRS 528
#define KRS 272
#define ARS 144
__device__ __forceinline__ void gla_load_w(const Params& p, int l, int hd, int tid, float (&w)[2][17]) {
  WS_LOCAL
  const int d = tid & 127;
#pragma unroll
  for (int dir = 0; dir < 2; ++dir) {
#pragma unroll
    for (int r = 0; r < 16; ++r) w[dir][r] = KARG(const float, 9)[((size_t)(l * 2 + dir) * 16 + r) * 512 + hd * 128 + d];
    w[dir][16] = KARG(const float, 10)[(l * 2 + dir) * 512 + hd * 128 + d];
  }
}
template <bool FULL>
__device__ __forceinline__ void gla_prep(const Params& p, int l, LAS unsigned char* lds, int hd, int dir, int tid, const float (&w)[17], float* dbout, int kt_off, int tot_off) {
  WS_LOCAL
  const int d = tid & 127, sq = tid >> 7;
  LAS float* lrs = (LAS float*)(lds + G_LRS); LAS float* tot = (LAS float*)(lds + tot_off);
  const float bgk = w[16];
  float pre[16];
#pragma unroll
  for (int i = 0; i < 16; i += 2) {
    const LAS float* lr = lrs + (dir * 16) * 64 + 16 * sq + i;
    f32x2 z = {bgk, bgk};
#pragma unroll
    for (int r = 0; r < 16; ++r) z += *(const LAS f32x2*)(lr + r * 64) * w[r];
    pre[i] = (fminf(z[0], 0.f) - __logf(1.f + __expf(-fabsf(z[0])))) * (1.f / 16.f);
    pre[i + 1] = (fminf(z[1], 0.f) - __logf(1.f + __expf(-fabsf(z[1])))) * (1.f / 16.f);
  }
  if (dir == 0) {
#pragma unroll
    for (int i = 1; i < 16; ++i) pre[i] += pre[i - 1];
  } else {
#pragma unroll
    for (int i = 14; i >= 0; --i) pre[i] += pre[i + 1];
  }
  tot[sq * 128 + d] = (dir == 0) ? pre[15] : pre[0];
  __syncthreads();
  const float t0 = tot[d], t1 = tot[128 + d], t2 = tot[256 + d], t3 = tot[384 + d];
  const float Btot = (t0 + t1) + (t2 + t3);
  float offs;
  if (dir == 0) offs = (sq > 0 ? t0 : 0.f) + (sq > 1 ? t1 : 0.f) + (sq > 2 ? t2 : 0.f);
  else offs = (sq < 3 ? t3 : 0.f) + (sq < 2 ? t2 : 0.f) + (sq < 1 ? t1 : 0.f);
  if (dbout != nullptr && sq == 0) dbout[d] = __expf(Btot);
  LAS unsigned char* kt = lds + kt_off; LAS unsigned char* qb = lds + G_QB; LAS unsigned char* qe = lds + G_QE;
#pragma unroll
  for (int i = 0; i < 16; ++i) {
    const int s = 16 * sq + i;
    const float bs = offs + pre[i];
    *(LAS bf16_t*)(kt + s * KRS + d * 2) = f2bf(bf2f(*(const LAS bf16_t*)(lds + G_RK + (s * 128 + d) * 2)) * __expf(Btot - bs));
    if (FULL) {
      const float qv = bf2f(*(const LAS bf16_t*)(lds + G_RQ + (s * 128 + d) * 2));
      *(LAS bf16_t*)(qb + s * KRS + d * 2) = f2bf(qv * __expf(bs));
      *(LAS bf16_t*)(qe + s * KRS + d * 2) = f2bf(qv * __expf(bs - Btot));
    }
  }
}
__device__ __forceinline__ u32x4 rope8(u32x4 self, u32x4 part, const float* tb, bool lower, float scale) {
  u32x4 o;
#pragma unroll
  for (int q = 0; q < 4; ++q) {
    const f32x4 cssn = *(const f32x4*)(tb + 4 * q);
    const float s0 = bflo(self[q]), s1 = bfhi(self[q]), p0 = bflo(part[q]), p1 = bfhi(part[q]);
    const float r0 = lower ? (s0 * cssn[0] - p0 * cssn[1]) : (p0 * cssn[1] + s0 * cssn[0]);
    const float r1 = lower ? (s1 * cssn[2] - p1 * cssn[3]) : (p1 * cssn[3] + s1 * cssn[2]);
    o[q] = pk2(r0 * scale, r1 * scale);
  }
  return o;
}
struct ChunkRegs { f32x4 lv; u32x4 vv[4], ks[2]; };
template <bool FULL>
__device__ __forceinline__ void gla_issue(const Params& p, int row0, int hd, int c, int tid_, ChunkRegs& R) {
  WS_LOCAL
  int tid = tid_; asm volatile("" : "+v"(tid));
  { const int r = tid >> 3, c4 = (tid & 7) * 4; R.lv = *(const f32x4*)(WSP(float, WS_LR32) + (size_t)(row0 + r) * 32 + c4); }
#pragma unroll
  for (int i = 0; i < 4; ++i) { const int ci = tid + 512 * i, r = ci >> 5, ch = ci & 31; R.vv[i] = *(const u32x4*)(WSP(bf16_t, WS_PROJ) + (size_t)(row0 + r) * PSTR + 1024 + hd * 256 + ch * 8); }
#pragma unroll
  for (int i = 0; i < 2; ++i) {
    const int ci = tid + 512 * i, r = ci >> 4, ch = ci & 15;
    const bf16_t* rowp = WSP(bf16_t, WS_PROJ) + (size_t)(row0 + r) * PSTR + hd * 128;
    if (!FULL) R.ks[i] = *(const u32x4*)(rowp + 512 + ch * 8);
  }
}
template <bool FULL>
__device__ __forceinline__ void gla_commit(const Params& p, LAS unsigned char* lds, int row0, int hd, int c, int tid_, const ChunkRegs& R) {
  WS_LOCAL
  int tid = tid_; asm volatile("" : "+v"(tid));
  { const int r = tid >> 3, c4 = (tid & 7) * 4; LAS float* lt = (LAS float*)(lds + G_LRS) + c4 * 64 + r; lt[0] = R.lv[0]; lt[64] = R.lv[1]; lt[128] = R.lv[2]; lt[192] = R.lv[3]; }
  const bool isctx = c < 4; const int cl = c - 4;
#pragma unroll
  for (int i = 0; i < 2; ++i) {
    const int ci = tid + 512 * i, r = ci >> 4, ch = ci & 15, chp = ch ^ 4;
    const bool lower = (ch & 7) < 4;
    const float* tb = WSP(float, WS_ROPE) + ((size_t)((ch < 8) ? cl : r) * 32 + ((8 * ch) & 31)) * 2;
    const bf16_t* rowp = WSP(bf16_t, WS_PROJ) + (size_t)(row0 + r) * PSTR + hd * 128;
    u32x4 ks = FULL ? *(const u32x4*)(rowp + 512 + ch * 8) : R.ks[i];
    if (!isctx) ks = rope8(ks, *(const u32x4*)(rowp + 512 + chp * 8), tb, lower, 1.f);
    *(LAS u32x4*)(lds + G_RK + ci * 16) = ks;
    if (FULL) {
      u32x4 qs = *(const u32x4*)(rowp + ch * 8);
      if (!isctx) qs = rope8(qs, *(const u32x4*)(rowp + chp * 8), tb, lower, 0.08838834764831845f);
      else {
#pragma unroll
        for (int q = 0; q < 4; ++q) qs[q] = pk2(bflo(qs[q]) * 0.08838834764831845f, bfhi(qs[q]) * 0.08838834764831845f);
      }
      *(LAS u32x4*)(lds + G_RQ + ci * 16) = qs;
    }
  }
#pragma unroll
  for (int i = 0; i < 4; ++i) { const int ci = tid + 512 * i, r = ci >> 5, ch = ci & 31; *(LAS u32x4*)(lds + G_VT + r * VRS + ch * 16) = R.vv[i]; }
}
__device__ __forceinline__ bf16x8 tr8(const LAS unsigned char* base, int rs, int r0, int q4, int cbyte) {
  const s16x4 lo = ds_tr(base + (r0 + q4) * rs + cbyte), hi = ds_tr(base + (r0 + 4 + q4) * rs + cbyte);
  bf16x8 v; v[0] = lo[0]; v[1] = lo[1]; v[2] = lo[2]; v[3] = lo[3]; v[4] = hi[0]; v[5] = hi[1]; v[6] = hi[2]; v[7] = hi[3];
  return v;
}
__device__ void gla_passA(const Params& p, int l, LAS unsigned char* lds, int bid, int nb) {
  WS_LOCAL
  const int tid = otid(), wave = tid >> 6, lane = tid & 63, fr = lane & 15, g = lane >> 4, q4 = fr >> 2, p4 = fr & 3;
  bf16_t* SB = (bf16_t*)WSP(float, WS_RG);
  ChunkRegs R; float wv[2][17];
  if (bid < 1056) {
    const int c = bid % 132, bh = bid / 132, b = bh >> 2, hd = bh & 3;
    gla_issue<false>(p, (c < 4) ? (NL + b * 256 + c * 64) : (b * 8192 + (c - 4) * 64), hd, c, tid, R);
  }
  for (int task = bid; task < 1056; task += nb) {
    const int c = task % 132, bh = task / 132, b = bh >> 2, hd = bh & 3;
    gla_load_w(p, l, hd, tid, wv);
    gla_commit<false>(p, lds, (c < 4) ? (NL + b * 256 + c * 64) : (b * 8192 + (c - 4) * 64), hd, c, tid, R);
    __syncthreads();
#pragma unroll
    for (int dir = 0; dir < 2; ++dir) {
      float wd[17];
#pragma unroll
      for (int r = 0; r < 17; ++r) wd[r] = wv[dir][r];
      gla_prep<false>(p, l, lds, hd, dir, tid, wd, WSP(float, WS_DB) + (size_t)((bh * 2 + dir) * 132 + c) * 128, dir ? G_QB : G_KT, dir ? G_RED : G_TOT);
    }
    __syncthreads();
    if (task + nb < 1056) {
      const int tn = task + nb, cn = tn % 132, bhn = tn / 132, bn = bhn >> 2, hdn = bhn & 3;
      gla_issue<false>(p, (cn < 4) ? (NL + bn * 256 + cn * 64) : (bn * 8192 + (cn - 4) * 64), hdn, cn, tid, R);
    }
    {
      bf16x8 af[2][2];
#pragma unroll
      for (int ks = 0; ks < 2; ++ks) { af[0][ks] = tr8(lds + G_KT, KRS, 32 * ks + 8 * g, q4, (16 * wave + 4 * p4) * 2); af[1][ks] = tr8(lds + G_QB, KRS, 32 * ks + 8 * g, q4, (16 * wave + 4 * p4) * 2); }
      bf16_t* dst0 = SB + ((size_t)((bh * 2) * 132 + c) * 256 + fr) * 128 + 16 * wave + 4 * g;
      bf16_t* dst1 = dst0 + (size_t)132 * 256 * 128;
#pragma unroll 4
      for (int n = 0; n < 16; ++n) {
        f32x4 a0 = {0.f, 0.f, 0.f, 0.f}, a1 = a0;
#pragma unroll
        for (int ks = 0; ks < 2; ++ks) {
          const bf16x8 bfr = tr8(lds + G_VT, VRS, 32 * ks + 8 * g, q4, (16 * n + 4 * p4) * 2);
          a0 = __builtin_amdgcn_mfma_f32_16x16x32_bf16(af[0][ks], bfr, a0, 0, 0, 0);
          a1 = __builtin_amdgcn_mfma_f32_16x16x32_bf16(af[1][ks], bfr, a1, 0, 0, 0);
        }
        u32x2 w0; w0.x = pk2(a0[0], a0[1]); w0.y = pk2(a0[2], a0[3]);
        u32x2 w1; w1.x = pk2(a1[0], a1[1]); w1.y = pk2(a1[2], a1[3]);
        *(u32x2*)(dst0 + (size_t)(16 * n) * 128) = w0;
        *(u32x2*)(dst1 + (size_t)(16 * n) * 128) = w1;
      }
    }
    __syncthreads();
  }
}
__device__ void gla_passB(const Params& p, int bid, int nb) {
  WS_LOCAL
  const int tid = otid();
  bf16_t* SB = (bf16_t*)WSP(float, WS_RG);
  for (int item = bid * NTHR + tid; item < 131072; item += nb * NTHR) {
    const int dq = item & 31, e = (item >> 5) & 255, chain = item >> 13, dir = chain & 1;
    f32x4 S = {0.f, 0.f, 0.f, 0.f};
    bf16_t* base = SB + ((size_t)chain * 132 * 256 + e) * 128 + dq * 4;
    const float* dbase = WSP(float, WS_DB) + (size_t)chain * 132 * 128 + dq * 4;
#pragma unroll 1
    for (int i0 = 0; i0 < 132; i0 += 12) {
      u32x2 u[12]; f32x4 dd[12]; int cc[12];
#pragma unroll
      for (int k = 0; k < 12; ++k) {
        const int i = i0 + k;
        cc[k] = dir ? ((i < 4) ? 3 - i : 135 - i) : i;
        u[k] = __builtin_nontemporal_load((const u32x2*)(base + (size_t)cc[k] * 32768));
        dd[k] = *(const f32x4*)(dbase + cc[k] * 128);
      }
#pragma unroll
      for (int k = 0; k < 12; ++k) {
        u32x2 o; o.x = pk2(S[0], S[1]); o.y = pk2(S[2], S[3]);
        *(u32x2*)(base + (size_t)cc[k] * 32768) = o;
        S[0] = S[0] * dd[k][0] + bflo(u[k].x); S[1] = S[1] * dd[k][1] + bfhi(u[k].x);
        S[2] = S[2] * dd[k][2] + bflo(u[k].y); S[3] = S[3] * dd[k][3] + bfhi(u[k].y);
      }
    }
  }
}
__device__ void gla_passC(const Params& p, int l, LAS unsigned char* lds, int bid, int nb) {
  WS_LOCAL
  const int tid = otid(), wave = tid >> 6, lane = tid & 63, fr = lane & 15, g = lane >> 4, q4 = fr >> 2, p4 = fr & 3;
  const bf16_t* SB = (const bf16_t*)WSP(float, WS_RG);
  const int c_lo = (l == 0) ? 0 : 4, nc = 132 - c_lo, ntask = 8 * nc;
  ChunkRegs R; float wv[2][17];
  if (bid < ntask) {
    const int c = c_lo + bid % nc, bh = bid / nc, b = bh >> 2, hd = bh & 3;
    gla_issue<true>(p, (c < 4) ? (NL + b * 256 + c * 64) : (b * 8192 + (c - 4) * 64), hd, c, tid, R);
  }
  for (int task = bid; task < ntask; task += nb) {
    const int c = c_lo + task % nc, bh = task / nc, b = bh >> 2, hd = bh & 3;
    const int row0 = (c < 4) ? (NL + b * 256 + c * 64) : (b * 8192 + (c - 4) * 64);
    gla_load_w(p, l, hd, tid, wv);
    gla_commit<true>(p, lds, row0, hd, c, tid, R);
    __syncthreads();
    f32x4 acc[2][4];
#pragma unroll
    for (int eb = 0; eb < 2; ++eb)
#pragma unroll
      for (int tb = 0; tb < 4; ++tb) acc[eb][tb] = (f32x4){0.f, 0.f, 0.f, 0.f};
    f32x4 attacc[2];
    attacc[0] = (f32x4){0.f, 0.f, 0.f, 0.f}; attacc[1] = attacc[0];
#pragma unroll 1
    for (int dir = 0; dir < 2; ++dir) {
      const int chain = bh * 2 + dir;
      { float wd[17];
#pragma unroll
        for (int r = 0; r < 17; ++r) wd[r] = dir ? wv[1][r] : wv[0][r];
        gla_prep<true>(p, l, lds, hd, dir, tid, wd, nullptr, G_KT, G_TOT); __syncthreads(); }
      {
        const int sb = wave >> 1;
        bf16x8 ka[4];
#pragma unroll
        for (int ks = 0; ks < 4; ++ks) ka[ks] = *(const LAS bf16x8*)(lds + G_KT + (16 * sb + fr) * KRS + (32 * ks + 8 * g) * 2);
#pragma unroll
        for (int t2 = 0; t2 < 2; ++t2) {
          const int tb = 2 * (wave & 1) + t2;
          f32x4 a = {0.f, 0.f, 0.f, 0.f};
#pragma unroll
          for (int ks = 0; ks < 4; ++ks) {
            const bf16x8 qf = *(const LAS bf16x8*)(lds + G_QE + (16 * tb + fr) * KRS + (32 * ks + 8 * g) * 2);
            a = __builtin_amdgcn_mfma_f32_16x16x32_bf16(ka[ks], qf, a, 0, 0, 0);
          }
          const int t = 16 * tb + fr;
#pragma unroll
          for (int jj = 0; jj < 4; ++jj) { const int s = 16 * sb + 4 * g + jj; const bool keep = dir ? (s >= t) : (s <= t); attacc[t2][jj] += keep ? a[jj] : 0.f; }
          if (dir == 1) {
            u32x2 w2; w2.x = pk2(attacc[t2][0], attacc[t2][1]); w2.y = pk2(attacc[t2][2], attacc[t2][3]);
            *(LAS u32x2*)(lds + G_ATT + t * ARS + (16 * sb + 4 * g) * 2) = w2;
          }
        }
      }
      {
        const bf16_t* sp = SB + ((size_t)(chain * 132 + c) * 256 + 32 * wave + fr) * 128 + 8 * g;
#pragma unroll
        for (int kh = 0; kh < 2; ++kh) {
          bf16x8 sf[2][2];
#pragma unroll
          for (int eb = 0; eb < 2; ++eb)
#pragma unroll
            for (int k2 = 0; k2 < 2; ++k2) sf[eb][k2] = *(const bf16x8*)(sp + (size_t)(16 * eb) * 128 + 32 * (2 * kh + k2));
#pragma unroll
          for (int tb = 0; tb < 4; ++tb)
#pragma unroll
            for (int k2 = 0; k2 < 2; ++k2) {
              const bf16x8 qf = *(const LAS bf16x8*)(lds + G_QB + (16 * tb + fr) * KRS + (32 * (2 * kh + k2) + 8 * g) * 2);
#pragma unroll
              for (int eb = 0; eb < 2; ++eb) acc[eb][tb] = __builtin_amdgcn_mfma_f32_16x16x32_bf16(sf[eb][k2], qf, acc[eb][tb], 0, 0, 0);
            }
          __builtin_amdgcn_sched_barrier(0);
        }
      }
      __syncthreads();
    }
#pragma unroll
    for (int ks = 0; ks < 2; ++ks) {
      bf16x8 vf[2];
#pragma unroll
      for (int eb = 0; eb < 2; ++eb) vf[eb] = tr8(lds + G_VT, VRS, 32 * ks + 8 * g, q4, (16 * (2 * wave + eb) + 4 * p4) * 2);
#pragma unroll
      for (int tb = 0; tb < 4; ++tb) {
        const bf16x8 af = *(const LAS bf16x8*)(lds + G_ATT + (16 * tb + fr) * ARS + (32 * ks + 8 * g) * 2);
#pragma unroll
        for (int eb = 0; eb < 2; ++eb) acc[eb][tb] = __builtin_amdgcn_mfma_f32_16x16x32_bf16(vf[eb], af, acc[eb][tb], 0, 0, 0);
      }
    }
    if (task + nb < ntask) {
      const int tn = task + nb, cn = c_lo + tn % nc, bhn = tn / nc, bn = bhn >> 2, hdn = bhn & 3;
      gla_issue<true>(p, (cn < 4) ? (NL + bn * 256 + cn * 64) : (bn * 8192 + (cn - 4) * 64), hdn, cn, tid, R);
    }
    u32x2 og[2][4]; f32x4 nwv[2];
#pragma unroll
    for (int eb = 0; eb < 2; ++eb) {
      const int e0 = 16 * (2 * wave + eb) + 4 * g;
      nwv[eb] = *(const f32x4*)(KARG(const float, 11) + l * 256 + e0);
#pragma unroll
      for (int tb = 0; tb < 4; ++tb) og[eb][tb] = *(const u32x2*)(WSP(bf16_t, WS_PROJ) + (size_t)(row0 + 16 * tb + fr) * PSTR + 2048 + hd * 256 + e0);
    }
    LAS float* red = (LAS float*)(lds + G_RED);
    float rstd[4];
#pragma unroll
    for (int tb = 0; tb < 4; ++tb) {
      float ss = 0.f;
#pragma unroll
      for (int eb = 0; eb < 2; ++eb)
#pragma unroll
        for (int jj = 0; jj < 4; ++jj) ss += acc[eb][tb][jj] * acc[eb][tb][jj];
      ss += __shfl_xor(ss, 16, 64); ss += __shfl_xor(ss, 32, 64);
      if (g == 0) red[wave * 64 + 16 * tb + fr] = ss;
    }
    __syncthreads();
#pragma unroll
    for (int tb = 0; tb < 4; ++tb) {
      float ss = 0.f;
#pragma unroll
      for (int w8 = 0; w8 < 8; ++w8) ss += red[w8 * 64 + 16 * tb + fr];
      rstd[tb] = rsqrtf(ss * (1.f / 256.f) + 1e-6f);
    }
#pragma unroll
    for (int eb = 0; eb < 2; ++eb) {
      const int e0 = 16 * (2 * wave + eb) + 4 * g;
      const f32x4 nw = nwv[eb];
#pragma unroll
      for (int tb = 0; tb < 4; ++tb) {
        const int row = row0 + 16 * tb + fr;
        const u32x2 ogv = og[eb][tb];
        const float y0 = acc[eb][tb][0] * rstd[tb] * nw[0] * siluf_(bflo(ogv.x)), y1 = acc[eb][tb][1] * rstd[tb] * nw[1] * siluf_(bfhi(ogv.x));
        const float y2 = acc[eb][tb][2] * rstd[tb] * nw[2] * siluf_(bflo(ogv.y)), y3 = acc[eb][tb][3] * rstd[tb] * nw[3] * siluf_(bfhi(ogv.y));
        u32x2 w2; w2.x = pk2(y0, y1); w2.y = pk2(y2, y3);
        *(u32x2*)(WSP(bf16_t, WS_GM) + (size_t)row * GSTR + hd * 256 + e0) = w2;
      }
    }
  }
}
__device__ __forceinline__ void route_top2(float affl, float sell, int& e1, int& e2, float& w1, float& w2) {
  float aff[16], sel[16];
#pragma unroll
  for (int e = 0; e < 16; ++e) { aff[e] = __int_as_float(__builtin_amdgcn_readlane(__float_as_int(affl), 4 * e)); sel[e] = __int_as_float(__builtin_amdgcn_readlane(__float_as_int(sell), 4 * e)); }
  float best = -INFINITY; int gb = 0;
  float bs[4], ba[4];
#pragma unroll
  for (int q = 0; q < 4; ++q) { bs[q] = 0.f; ba[q] = 0.f; }
#pragma unroll
  for (int g = 0; g < 4; ++g) {
    const float s0 = sel[4 * g], s1 = sel[4 * g + 1], s2 = sel[4 * g + 2], s3 = sel[4 * g + 3];
    const float m1 = fmaxf(fmaxf(s0, s1), fmaxf(s2, s3));
    const int f = (s0 == m1) ? 0 : (s1 == m1) ? 1 : (s2 == m1) ? 2 : 3;
    float m2 = -INFINITY;
    if (f != 0) m2 = fmaxf(m2, s0);
    if (f != 1) m2 = fmaxf(m2, s1);
    if (f != 2) m2 = fmaxf(m2, s2);
    if (f != 3) m2 = fmaxf(m2, s3);
    const float gs = m1 + m2;
    if (gs > best) {
      best = gs; gb = g;
      bs[0] = s0; bs[1] = s1; bs[2] = s2; bs[3] = s3;
      ba[0] = aff[4 * g]; ba[1] = aff[4 * g + 1]; ba[2] = aff[4 * g + 2]; ba[3] = aff[4 * g + 3];
    }
  }
  const float m1 = fmaxf(fmaxf(bs[0], bs[1]), fmaxf(bs[2], bs[3]));
  const int i1 = (bs[0] == m1) ? 0 : (bs[1] == m1) ? 1 : (bs[2] == m1) ? 2 : 3;
  float m2 = -INFINITY; int i2 = 0;
#pragma unroll
  for (int q = 3; q >= 0; --q)
    if (q != i1 && bs[q] >= m2) { m2 = bs[q]; i2 = q; }
  const float a1 = (i1 == 0) ? ba[0] : (i1 == 1) ? ba[1] : (i1 == 2) ? ba[2] : ba[3];
  const float a2 = (i2 == 0) ? ba[0] : (i2 == 1) ? ba[1] : (i2 == 2) ? ba[2] : ba[3];
  const float inv = 1.f / (a1 + a2);
  e1 = gb * 4 + i1; e2 = gb * 4 + i2; w1 = a1 * inv; w2 = a2 * inv;
}
__device__ void ph_norm2(const Params& p, int l, LAS unsigned char* lds, int bid, int nb) {
  WS_LOCAL
  const int tid = otid(), wave = tid >> 6, lane = tid & 63, fr = lane & 15, g = lane >> 4;
  const int M = (l == 0) ? NT : NL;
  const int R = (M + nb - 1) / nb, rbeg = bid * R, rend = min(rbeg + R, M);
  LAS int* lcnt = (LAS int*)lds;
  LAS int* lbase = lcnt + 16;
  LAS int* rec = lcnt + 64;
  LAS float* Hs = (LAS float*)(lds + 4096);
  LAS float* part = (LAS float*)(lds + 4096 + 16 * 1028 * 4);
  if (tid < 32) lcnt[tid] = 0;
  for (int k = tid; k < R; k += NTHR) rec[k * 8] = -1;
  float wreg[32];
#pragma unroll
  for (int t = 0; t < 32; ++t) wreg[t] = KARG(const float, 16)[(size_t)(128 * wave + 4 * t + g) * 16 + fr];
  const bf16_t* Yb = WSP(bf16_t, WS_Y);
  const float* nw = KARG(const float, 7) + l * 1024;
  const float brt = KARG(const float, 17)[(lane >> 2) & 15];
  __syncthreads();
  for (int r0 = rbeg; r0 < rend; r0 += 16) {
    int rows[2]; bool val[2];
#pragma unroll
    for (int u = 0; u < 2; ++u) { rows[u] = r0 + 2 * wave + u; val[u] = rows[u] < rend; if (!val[u]) rows[u] = rend - 1; }
    f32x4 v[2][4]; u32x2 yv[2][4];
#pragma unroll
    for (int u = 0; u < 2; ++u) {
      const int row = rows[u];
      const float* src = (l == 0) ? ((row < NL) ? KARG(const float, 0) + (size_t)row * 1024 : KARG(const float, 2) + (size_t)(row - NL) * 1024)
                                  : (const float*)(WSP(float, WS_XBUF) + (size_t)row * 1024);
#pragma unroll
      for (int i = 0; i < 4; ++i) { v[u][i] = *(const f32x4*)(src + i * 256 + lane * 4); yv[u][i] = *(const u32x2*)(Yb + (size_t)row * 1024 + i * 256 + lane * 4); }
    }
#pragma unroll
    for (int u = 0; u < 2; ++u) {
      const int row = rows[u];
      const float* md = WSP(float, WS_MOD) + (l * 3 + ((row < NL) ? (row >> 13) : 2)) * 6144;
      float ss = 0.f;
#pragma unroll
      for (int i = 0; i < 4; ++i) {
        const f32x4 m2 = *(const f32x4*)(md + 2048 + i * 256 + lane * 4);
        v[u][i][0] += m2[0] * bflo(yv[u][i].x); v[u][i][1] += m2[1] * bfhi(yv[u][i].x); v[u][i][2] += m2[2] * bflo(yv[u][i].y); v[u][i][3] += m2[3] * bfhi(yv[u][i].y);
        if (val[u]) *(f32x4*)(WSP(float, WS_XBUF) + (size_t)row * 1024 + i * 256 + lane * 4) = v[u][i];
        ss += v[u][i][0] * v[u][i][0] + v[u][i][1] * v[u][i][1] + v[u][i][2] * v[u][i][2] + v[u][i][3] * v[u][i][3];
      }
      const float rstd = rsqrtf(wave_sum(ss) * (1.f / 1024.f) + 1e-6f);
#pragma unroll
      for (int i = 0; i < 4; ++i) {
        const int j = i * 256 + lane * 4;
        const f32x4 w = *(const f32x4*)(nw + j), m4 = *(const f32x4*)(md + 4096 + j), m3 = *(const f32x4*)(md + 3072 + j);
        f32x4 h;
#pragma unroll
        for (int q = 0; q < 4; ++q) h[q] = v[u][i][q] * rstd * w[q] * (1.f + m4[q]) + m3[q];
        if (val[u]) *(unsigned*)(WSP(unsigned char, WS_H8) + (size_t)row * 1024 + j) = pk4_fp8(h[0], h[1], h[2], h[3]);
        *(LAS f32x4*)(Hs + (2 * wave + u) * 1028 + j) = h;
      }
    }
    __syncthreads();
    {
      f32x4 acc = {0.f, 0.f, 0.f, 0.f};
      const LAS float* hp = Hs + fr * 1028 + 128 * wave + g;
#pragma unroll
      for (int t = 0; t < 32; ++t) acc = __builtin_amdgcn_mfma_f32_16x16x4f32(hp[4 * t], wreg[t], acc, 0, 0, 0);
#pragma unroll
      for (int jj = 0; jj < 4; ++jj) part[(wave * 16 + 4 * g + jj) * 16 + fr] = acc[jj];
    }
    __syncthreads();
#pragma unroll
    for (int u = 0; u < 2; ++u) {
      const int rl = 2 * wave + u, em = (lane >> 2) & 15;
      float lg = 0.f;
#pragma unroll
      for (int w8 = 0; w8 < 8; ++w8) lg += part[(w8 * 16 + rl) * 16 + em];
      const float affl = 1.f / (1.f + expf(-lg)), sell = affl + brt;
      int e1, e2; float w1, w2;
      route_top2(affl, sell, e1, e2, w1, w2);
      if (lane == 0 && val[u]) {
        const int s1 = __hip_atomic_fetch_add(&lcnt[e1], 1, __ATOMIC_RELAXED, __HIP_MEMORY_SCOPE_WORKGROUP);
        const int s2 = __hip_atomic_fetch_add(&lcnt[e2], 1, __ATOMIC_RELAXED, __HIP_MEMORY_SCOPE_WORKGROUP);
        LAS int* rc = rec + (rows[u] - rbeg) * 8;
        rc[0] = rows[u]; rc[1] = e1; rc[2] = s1; rc[3] = e2; rc[4] = s2; rc[5] = __float_as_int(w1); rc[6] = __float_as_int(w2);
      }
    }
  }
  __syncthreads();
  if (tid < 16) { const int n = lcnt[tid]; lbase[tid] = n ? atomicAdd(&WSP(int, WS_CTL + 4096 * 4)[(l * 16 + tid) * 64], n) : 0; }
  __syncthreads();
  for (int k = tid; k < R; k += NTHR) {
    const LAS int* rc = rec + k * 8;
    const int row = rc[0];
    if (row >= 0) {
      const int e1 = rc[1], s1 = lbase[e1] + rc[2], e2 = rc[3], s2 = lbase[e2] + rc[4];
      WSP(int, WS_LIST)[e1 * NT + s1] = row * 2; WSP(float, WS_TOPW)[row * 2] = __int_as_float(rc[5]);
      WSP(int, WS_LIST)[e2 * NT + s2] = row * 2 + 1; WSP(float, WS_TOPW)[row * 2 + 1] = __int_as_float(rc[6]);
    }
  }
}
__device__ __forceinline__ void moe_tables(const Params& p, int l, volatile LAS int* tab, int nN) {
  WS_LOCAL
  if (threadIdx.x == 0) {
    int up = 0, tb = 0;
    for (int e = 0; e < 16; ++e) {
      const int c = __hip_atomic_load(&WSP(int, WS_CTL + 4096 * 4)[(l * 16 + e) * 64], __ATOMIC_RELAXED, __HIP_MEMORY_SCOPE_AGENT), mt = (c + 255) >> 8;
      tab[e] = up; tab[32 + e] = mt > 0 ? mt : 1; tab[64 + e] = tb; tab[96 + e] = c;
      up += mt * nN; tb += mt;
    }
    tab[16] = up;
  }
  __syncthreads();
}
__device__ void ph_proj(const Params& p, int l, LAS unsigned char* lds, int bid, int nb) {
  WS_LOCAL
  pg8::DenseSched S; S.init(NT / 256, PSTR / 256, nb, bid, WSP(unsigned char, WS_HM), WSP(unsigned char, WS_WINT) + (size_t)l * PSTR * 1024, 512);
  EpiProj E{WSP(bf16_t, WS_PROJ), WSP(float, WS_LR32)};
  pg8::gemm_phase<EpiProj, pg8::DenseSched, 0, false, true>(lds, 512, S, E);
}
__device__ void ph_merge(const Params& p, int l, LAS unsigned char* lds, int bid, int nb) {
  WS_LOCAL
  if (l == 0 && bid < 8) {
    const int pm = 64 + (bid >> 2), pn = bid & 3;
    unsigned* ctr = WSP(unsigned, WS_CTL + 6400 * 4) + (bid >> 2) * 64;
    pg8::SingleSched S; S.u0.pm = pm; S.u0.pn = pn; S.u0.e = 0; S.u0.aux = 0;
    S.u0.A = (const char*)WSP(bf16_t, WS_GM) + (size_t)pm * 256 * GSTR * 2; S.u0.B = (const char*)WSP(bf16_t, WS_WMT) + (size_t)pn * 256 * GSTR * 2;
    EpiMerge E{WSP(bf16_t, WS_PROJ), WSP(bf16_t, WS_HM)};
    pg8::gemm_phase<EpiMerge, pg8::SingleSched, 16>(lds, GSTR, S, E);
    asm volatile("s_waitcnt vmcnt(0)" ::: "memory");
    __syncthreads();
    if (threadIdx.x == 0) {
      __builtin_amdgcn_fence(__ATOMIC_RELEASE, "agent");
      asm volatile("s_waitcnt vmcnt(0)" ::: "memory");
      (void)__hip_atomic_fetch_add(ctr, 1u, __ATOMIC_RELAXED, __HIP_MEMORY_SCOPE_AGENT);
    }
  }
  {
    pg8::DenseSched S; S.init(NL / 256, 4, nb, bid, WSP(bf16_t, WS_GM), WSP(bf16_t, WS_WMT) + (size_t)l * 1024 * GSTR, GSTR);
    EpiMerge E{WSP(bf16_t, WS_PROJ), WSP(bf16_t, WS_HM)};
    pg8::gemm_phase<EpiMerge, pg8::DenseSched, 16>(lds, GSTR, S, E);
  }
  if (l == 0 && bid >= 8 && bid < 16) {
    const int j = bid - 8, pm = 64 + (j >> 2), pn = j & 3;
    unsigned* ctr = WSP(unsigned, WS_CTL + 6400 * 4) + (j >> 2) * 64;
    if (threadIdx.x == 0) {
      unsigned sp = 0;
      while (__hip_atomic_load(ctr, __ATOMIC_RELAXED, __HIP_MEMORY_SCOPE_AGENT) < 4u) { __builtin_amdgcn_s_sleep(2); if (++sp > (1u << 24)) break; }
      __builtin_amdgcn_fence(__ATOMIC_ACQUIRE, "agent");
      asm volatile("s_waitcnt vmcnt(0)" ::: "memory");
    }
    __syncthreads();
    pg8::SingleSched S; S.u0.pm = pm; S.u0.pn = pn; S.u0.e = 0; S.u0.aux = 0;
    S.u0.A = (const char*)WSP(bf16_t, WS_HM) + (size_t)pm * 256 * 1024 * 2; S.u0.B = (const char*)WSP(bf16_t, WS_WOT) + (size_t)pn * 256 * 1024 * 2;
    EpiOut E{WSP(bf16_t, WS_Y)};
    pg8::gemm_phase<EpiOut, pg8::SingleSched, 0>(lds, 1024, S, E);
  }
}
__device__ void ph_out(const Params& p, int l, LAS unsigned char* lds, int bid, int nb) {
  WS_LOCAL
  pg8::DenseSched S; S.init(NL / 256, 4, nb, bid, WSP(bf16_t, WS_HM), WSP(bf16_t, WS_WOT) + (size_t)l * 1024 * 1024, 1024);
  EpiOut E{WSP(bf16_t, WS_Y)};
  pg8::gemm_phase<EpiOut, pg8::DenseSched, 0>(lds, 1024, S, E);
}
__device__ void ph_moe1(const Params& p, int l, LAS unsigned char* lds, int bid, int nb) {
  WS_LOCAL
  volatile LAS int* tab = (volatile LAS int*)(lds + MISC_OFF + 256);
  moe_tables(p, l, tab, 8);
  pg8::MoeSched S; S.U = tab[16]; S.nN = 8; S.G = nb; S.c = bid; S.A = (const char*)WSP(unsigned char, WS_H8); S.B = (const char*)WSP(unsigned char, WS_RG);
  S.tstep = (size_t)256 * 1024; S.estep = (size_t)2048 * 1024; S.tab = tab; S.list = WSP(int, WS_LIST); S.gather = true;
  EpiMoe1 E{WSP(unsigned char, WS_PROJ + PROWS * 2048)};
  pg8::gemm_phase<EpiMoe1, pg8::MoeSched, 0, true, true>(lds, 512, S, E);
}
__device__ void ph_moe2(const Params& p, int l, LAS unsigned char* lds, int bid, int nb) {
  WS_LOCAL
  volatile LAS int* tab = (volatile LAS int*)(lds + MISC_OFF + 256);
  __syncthreads();
  moe_tables(p, l, tab, 4);
  pg8::MoeSched S; S.U = tab[16]; S.nN = 4; S.G = nb; S.c = bid; S.A = (const char*)WSP(unsigned char, WS_PROJ + PROWS * 2048); S.B = (const char*)WSP(unsigned char, WS_W2F8);
  S.tstep = (size_t)256 * 1024; S.estep = (size_t)1024 * 1024; S.tab = tab; S.list = WSP(int, WS_LIST); S.gather = false;
  EpiMoe2 E{WSP(bf16_t, WS_PROJ + 2 * PROWS * 2048), WSP(int, WS_LIST), WSP(float, WS_TOPW), tab};
  pg8::gemm_phase<EpiMoe2, pg8::MoeSched, 0, false, true>(lds, 512, S, E);
}
__device__ void ph_final(const Params& p, int bid, int nb) {
  WS_LOCAL
  const int tid = otid(), wave = tid >> 6, lane = tid & 63;
  const int NGW = nb * NWAVES;
  for (int rowa = bid * NWAVES + wave; rowa < NL; rowa += 2 * NGW) {
    int rows[2]; rows[0] = rowa; rows[1] = rowa + NGW;
    const bool has2 = rows[1] < NL;
    if (!has2) rows[1] = rowa;
    f32x4 v[2][4]; float ss[2] = {0.f, 0.f};
#pragma unroll
    for (int u = 0; u < 2; ++u) {
      const int row = rows[u];
      const float* src = WSP(float, WS_XBUF) + (size_t)row * 1024;
      const float* m5 = WSP(float, WS_MOD) + (1 * 3 + (row >> 13)) * 6144 + 5 * 1024;
      const bf16_t* y0 = WSP(bf16_t, WS_PROJ + 2 * PROWS * 2048) + (size_t)(row * 2) * 1024;
#pragma unroll
      for (int i = 0; i < 4; ++i) {
        const int j = i * 256 + lane * 4;
        v[u][i] = __builtin_nontemporal_load((const f32x4*)(src + j));
        const u32x2 ya = __builtin_nontemporal_load((const u32x2*)(y0 + j)), yb = __builtin_nontemporal_load((const u32x2*)(y0 + 1024 + j));
        const f32x4 g = *(const f32x4*)(m5 + j);
        v[u][i][0] += g[0] * (bflo(ya.x) + bflo(yb.x)); v[u][i][1] += g[1] * (bfhi(ya.x) + bfhi(yb.x));
        v[u][i][2] += g[2] * (bflo(ya.y) + bflo(yb.y)); v[u][i][3] += g[3] * (bfhi(ya.y) + bfhi(yb.y));
        ss[u] += v[u][i][0] * v[u][i][0] + v[u][i][1] * v[u][i][1] + v[u][i][2] * v[u][i][2] + v[u][i][3] * v[u][i][3];
      }
    }
#pragma unroll
    for (int u = 0; u < 2; ++u) {
      if (u == 1 && !has2) break;
      const float rstd = rsqrtf(wave_sum(ss[u]) * (1.f / 1024.f) + 1e-6f);
#pragma unroll
      for (int i = 0; i < 4; ++i) {
        const int j = i * 256 + lane * 4;
        const f32x4 w = *(const f32x4*)(KARG(const float, 21) + j);
        __builtin_nontemporal_store(v[u][i] * rstd * w, (f32x4*)(KARG(float, 22) + (size_t)rows[u] * 1024 + j));
      }
    }
  }
}

__global__ void __launch_bounds__(NTHR, 2) k_mega(Params p) {
  extern __shared__ __attribute__((aligned(16))) unsigned char lds_raw[];
  LAS unsigned char* lds0 = (LAS unsigned char*)lds_raw;
  cg::grid_group grid = cg::this_grid();
  const int bid0 = blockIdx.x, nb0 = gridDim.x;
  volatile LAS unsigned* misc = (volatile LAS unsigned*)(lds0 + MISC_OFF);
  if (threadIdx.x < 64) misc[threadIdx.x] = 0u;
  __syncthreads();
  XcdBarrier bar = xcd_barrier_post((unsigned*)(p.ws + WS_CTL), misc);
  if (p.ws == nullptr) grid.sync();
#pragma unroll 1
  for (int step = 0; step < 23; ++step) {
    const int t = step - 2, l = (t >= 0) ? t / 10 : 0, ph = (step == 0) ? -1 : ((step == 1) ? -2 : ((step == 22) ? 11 : t % 10));
    int bid = bid0, nb = nb0; unsigned ldsu = (unsigned)(size_t)lds0;
    asm volatile("" : "+s"(bid), "+s"(nb), "+s"(ldsu));
    LAS unsigned char* lds = (LAS unsigned char*)(size_t)ldsu;
    switch (ph) {
      case -1: ph_init(p, lds, bid, nb); break;
      case -2: ph_ada_reduce(p, bid, nb); break;
      case 0: ph_norm1(p, l, bid, nb); break;
      case 1: ph_proj(p, l, lds, bid, nb); break;
      case 2: case 3: if (ph == 2) gla_passA(p, l, lds, bid, nb); else gla_passB(p, bid, nb);
              na_phase(p, l, lds, bid, nb, ph == 2 ? 1 : 0); break;
      case 4: gla_passC(p, l, lds, bid, nb); break;
      case 5: ph_experts(p, l, lds, bid, nb); __syncthreads(); ph_merge(p, l, lds, bid, nb); break;
      case 6: ph_out(p, l, lds, bid, nb); break;
      case 7: ph_norm2(p, l, lds, bid, nb); break;
      case 8: ph_moe1(p, l, lds, bid, nb); break;
      case 9: ph_moe2(p, l, lds, bid, nb); break;
      default: ph_final(p, bid, nb); break;
    }
    if (step == 22) break;
    xcd_barrier(bar);
  }
}

extern "C" void kernel_launch(void* const* d_in, const int* in_sizes, int n_in, void* d_out, int out_size, void* d_ws,
                              size_t ws_size, hipStream_t stream) {
  Params p{};
  const float** fp = (const float**)&p;
  for (int i = 0; i < 22; ++i) fp[i] = (const float*)d_in[i];
  p.out = (float*)d_out;
  p.ws = (char*)d_ws;
  if (WS_END > ws_size) { fprintf(stderr, "workspace too small: need %zu have %zu\n", (size_t)WS_END, ws_size); return; }

  static int grid_blocks = 0;
  if (!grid_blocks) {
    int dev = 0, cus = 0, per_cu = 0;
    (void)hipGetDevice(&dev);
    (void)hipDeviceGetAttribute(&cus, hipDeviceAttributeMultiprocessorCount, dev);
    (void)hipFuncSetAttribute((const void*)k_mega, hipFuncAttributeMaxDynamicSharedMemorySize, LDS_BYTES);
    (void)hipOccupancyMaxActiveBlocksPerMultiprocessor(&per_cu, k_mega, NTHR, LDS_BYTES);
    if (per_cu < 1) fprintf(stderr, "occupancy query reports %d blocks per CU\n", per_cu);
    grid_blocks = cus > 0 ? cus : 256;
  }
  (void)hipMemsetAsync(p.ws + WS_CTL, 0, 32768, stream);
  void* args[] = {&p};
  hipError_t e = hipLaunchCooperativeKernel((void*)k_mega, dim3(grid_blocks), dim3(NTHR), args, LDS_BYTES, stream);
  if (e != hipSuccess) fprintf(stderr, "cooperative launch failed: %s (grid %d)\n", hipGetErrorString(e), grid_blocks);
}
```

```cpp
#include <hip/hip_runtime.h>
#include <hip/hip_cooperative_groups.h>
#include <cstdio>
#include <cstdint>
namespace cg = cooperative_groups;

typedef unsigned short bf16_t;
typedef short bf16x8 __attribute__((ext_vector_type(8)));
typedef float f32x4 __attribute__((ext_vector_type(4)));
typedef unsigned u32x4 __attribute__((ext_vector_type(4)));
typedef unsigned u32x2 __attribute__((ext_vector_type(2)));
#define LAS __attribute__((address_space(3)))

#define NT 16896
#define NL 16384
#define PSTR 6912
#define INC 6688
#define GSTR 1536
#define NTHR 512
#define NWAVES 8
#define RING_BYTES 131072
#define LDS_BYTES 151552
#define MISC_OFF 131072

__device__ __forceinline__ float bf2f(bf16_t v) { return __uint_as_float(((unsigned)v) << 16); }
typedef __bf16 hwbf16x2 __attribute__((ext_vector_type(2)));
typedef float f32x2 __attribute__((ext_vector_type(2)));
__device__ __forceinline__ unsigned pk2(float lo, float hi) { const f32x2 v = {lo, hi}; return __builtin_bit_cast(unsigned, __builtin_convertvector(v, hwbf16x2)); }
__device__ __forceinline__ bf16_t f2bf(float f) { return (bf16_t)(pk2(f, 0.f) & 0xffffu); }
__device__ __forceinline__ float bflo(unsigned u) { return __uint_as_float(u << 16); }
__device__ __forceinline__ float bfhi(unsigned u) { return __uint_as_float(u & 0xffff0000u); }
__device__ __forceinline__ float sigmoidf_(float x) { return 1.f / (1.f + __expf(-x)); }
__device__ __forceinline__ float siluf_(float x) { return x / (1.f + __expf(-x)); }
__device__ __forceinline__ float wave_sum(float v) {
#pragma unroll
  for (int o = 32; o > 0; o >>= 1) v += __shfl_xor(v, o, 64);
  return v;
}
__device__ __forceinline__ float wave_max(float v) {
#pragma unroll
  for (int o = 32; o > 0; o >>= 1) v = fmaxf(v, __shfl_xor(v, o, 64));
  return v;
}
__device__ __forceinline__ int otid() { int t = threadIdx.x; asm volatile("" : "+v"(t)); return t; }

constexpr size_t al256(size_t x) { return (x + 255) & ~(size_t)255; }
constexpr size_t WS_CTL = 0;
constexpr size_t WS_MOD = WS_CTL + 32768;
constexpr size_t WS_ROPE = WS_MOD + al256(2 * 3 * 6144 * 4);
constexpr size_t WS_LR32 = WS_ROPE + al256(128 * 32 * 2 * 4);
constexpr size_t WS_TOPW = WS_LR32 + al256((size_t)NT * 32 * 4);
constexpr size_t WS_POS = WS_TOPW + al256((size_t)NT * 2 * 4);
constexpr size_t WS_LIST = WS_POS + al256((size_t)NT * 2 * 4);
constexpr size_t WS_DB = WS_LIST + al256((size_t)16 * NT * 4);
constexpr size_t WS_APART = WS_DB + al256((size_t)16 * 132 * 128 * 4);
constexpr size_t WS_XBUF = WS_APART + al256((size_t)2 * 32 * 3 * 6144 * 4);
constexpr size_t WS_WINT = WS_XBUF + al256((size_t)NT * 1024 * 4);
constexpr size_t WS_WMT = WS_WINT + al256((size_t)2 * PSTR * 1024 * 2);
constexpr size_t WS_WOT = WS_WMT + al256((size_t)2 * 1024 * GSTR * 2);
constexpr size_t WS_HM = WS_WOT + al256((size_t)2 * 1024 * 1024 * 2);
constexpr size_t WS_GM = WS_HM + al256((size_t)NT * 1024 * 2);
constexpr size_t WS_RG = WS_GM + al256((size_t)NT * GSTR * 2);
constexpr size_t WS_PROJ = WS_RG + al256((size_t)NT * 1024 * 4 * 2);
constexpr size_t WS_END = WS_PROJ + al256((size_t)NT * PSTR * 2);
constexpr size_t PROWS = 37888;
constexpr size_t WS_W2F8 = WS_RG + (size_t)16 * 2048 * 1024;
constexpr size_t WS_H8 = WS_HM;
constexpr size_t WS_Y = WS_RG + (size_t)16 * 3 * 1024 * 1024 * 2;
static_assert((size_t)16 * 3 * 1024 * 1024 * 2 + (size_t)NT * 1024 * 2 <= (size_t)NT * 1024 * 4 * 2, "y buffer");
static_assert(2 * PROWS * 2048 + (size_t)NT * 2 * 2048 <= (size_t)NT * PSTR * 2, "MoE buffers must fit in the projection region");
static_assert((size_t)16 * 132 * 256 * 128 * 2 <= (size_t)NT * 1024 * 4 * 2, "GLA state buffer");
static_assert((size_t)16 * 3 * 1024 * 1024 * 2 <= (size_t)NT * 1024 * 4 * 2, "expert copies");

struct Params {
  const float *x, *c, *ctx, *c_ctx, *w_ada, *b_ada, *norm1_w, *norm2_w, *w_in, *w_gk_up, *b_gk, *gla_norm_w, *rpb,
      *w_bo_gla, *w_bo_na, *w_out, *w_router, *b_router, *w1, *w3, *w2, *final_norm_w;
  float* out;
  char* ws;
};
#define WSP(T, off) ((T*)(wsb + (off)))
typedef const unsigned long long __attribute__((address_space(4))) karg_t;
#define GAS __attribute__((address_space(1)))
#define WS_LOCAL karg_t* kab = (karg_t*)__builtin_amdgcn_kernarg_segment_ptr(); asm volatile("" : "+s"(kab)); char* wsb = (char*)(GAS char*)kab[23];
#define KARG(T, idx) ((T*)(GAS T*)kab[idx])

#define XB_TMO      128
#define XB_XCNT(j)  (256  + 64 * (j))
#define XB_XSUB(j)  (1280 + 64 * (j))
#define XB_XGEN(j)  (2304 + 64 * (j))
#define XB_TOP      3328
#define XB_TOPGEN   3392
#define XCD_BAR_WORDS 3456
#define XB_SPIN_CAP (1u << 22)
__device__ __forceinline__ unsigned xb_ld(unsigned* p) { return __hip_atomic_load(p, __ATOMIC_RELAXED, __HIP_MEMORY_SCOPE_AGENT); }
__device__ __forceinline__ unsigned xb_add(unsigned* p, unsigned v) { return __hip_atomic_fetch_add(p, v, __ATOMIC_RELAXED, __HIP_MEMORY_SCOPE_AGENT); }
__device__ __forceinline__ unsigned xb_xcc_id() { return (unsigned)__builtin_amdgcn_s_getreg((3 << 11) | 20) & 0xFu; }
#define XB_SPIN(cond, bar) do { unsigned _sp = 0; while (cond) { __builtin_amdgcn_s_sleep(1); \
    if ((++_sp & 255u) == 0u) { if (xb_ld(&(bar)[XB_TMO])) break; if (_sp > XB_SPIN_CAP) { atomicAdd(&(bar)[XB_TMO], 1u); break; } } } } while (0)
struct XcdBarrier { unsigned* bar; unsigned x; volatile LAS unsigned* st; };
__device__ __forceinline__ XcdBarrier xcd_barrier_post(unsigned* bar, volatile LAS unsigned* st) {
  XcdBarrier b; b.bar = bar; b.x = xb_xcc_id(); b.st = st;
  if (threadIdx.x == 0) (void)xb_add(&bar[XB_XCNT(b.x)], 1u);
  return b;
}
__device__ __forceinline__ void xcd_barrier_complete(unsigned* bar, unsigned x, unsigned& nloc, unsigned& nx) {
  const unsigned G = gridDim.x * gridDim.y * gridDim.z;
  unsigned sum, cnt, mine, sp = 0u;
  for (;;) {
    sum = 0u; cnt = 0u; mine = 0u;
#pragma unroll
    for (unsigned j = 0; j < 16; ++j) { const unsigned c = xb_ld(&bar[XB_XCNT(j)]); sum += c; cnt += (c > 0u) ? 1u : 0u; mine = (j == x) ? c : mine; }
    if (sum == G) break;
    __builtin_amdgcn_s_sleep(1);
    if ((++sp & 255u) == 0u) { if (xb_ld(&bar[XB_TMO])) break; if (sp > XB_SPIN_CAP) { atomicAdd(&bar[XB_TMO], 1u); break; } }
  }
  nloc = mine > 0u ? mine : 1u; nx = cnt > 0u ? cnt : 1u;
}
__device__ __forceinline__ void xcd_barrier1(const XcdBarrier& b);
__device__ __forceinline__ void xcd_barrier(const XcdBarrier& b) { xcd_barrier1(b); }
__device__ __forceinline__ void xcd_barrier1(const XcdBarrier& b0) {
  asm volatile("s_waitcnt vmcnt(0)" ::: "memory");
  __syncthreads();
  if (threadIdx.x == 0) {
    XcdBarrier b = b0;
    { unsigned long long a_ = (unsigned long long)b.bar; unsigned lo_ = (unsigned)a_, hi_ = (unsigned)(a_ >> 32), x_ = b.x, st_ = (unsigned)(size_t)b.st;
      asm volatile("" : "+s"(lo_), "+s"(hi_), "+s"(x_), "+s"(st_));
      b.bar = (unsigned*)(((unsigned long long)hi_ << 32) | lo_); b.x = x_; b.st = (volatile LAS unsigned*)(size_t)st_; }
    unsigned* bar = b.bar;
    __builtin_amdgcn_s_waitcnt(0);
    unsigned nloc = b.st[0], nx = b.st[1];
    if (nloc == 0u) { xcd_barrier_complete(bar, b.x, nloc, nx); b.st[0] = nloc; b.st[1] = nx; }
    const unsigned old = xb_add(&bar[XB_XSUB(b.x)], 1u);
    const unsigned gen = old / nloc;
    if (old + 1u == (gen + 1u) * nloc) {
      __builtin_amdgcn_fence(__ATOMIC_RELEASE, "agent");
      asm volatile("s_waitcnt vmcnt(0)" ::: "memory");
      const unsigned og = xb_add(&bar[XB_TOP], 1u);
      const unsigned tg = og / nx;
      if (og + 1u == (tg + 1u) * nx) xb_add(&bar[XB_TOPGEN], 1u);
      else XB_SPIN(xb_ld(&bar[XB_TOPGEN]) == tg, bar);
      __builtin_amdgcn_fence(__ATOMIC_ACQUIRE, "agent");
      xb_add(&bar[XB_XGEN(b.x)], 1u);
      asm volatile("s_waitcnt vmcnt(0)" ::: "memory");
    } else {
      XB_SPIN(xb_ld(&bar[XB_XGEN(b.x)]) == gen, bar);
      __builtin_amdgcn_fence(__ATOMIC_ACQUIRE, "agent");
      asm volatile("s_waitcnt vmcnt(0)" ::: "memory");
    }
  }
  __syncthreads();
}

typedef int v4i32 __attribute__((ext_vector_type(4)));
typedef int v8i32 __attribute__((ext_vector_type(8)));
__device__ __forceinline__ v8i32 cat8(bf16x8 lo, bf16x8 hi) { return __builtin_shufflevector(__builtin_bit_cast(v4i32, lo), __builtin_bit_cast(v4i32, hi), 0, 1, 2, 3, 4, 5, 6, 7); }
__device__ __forceinline__ unsigned pk4_fp8(float a, float b, float c, float d) {
  int v = __builtin_amdgcn_cvt_pk_fp8_f32(a, b, 0, false);
  v = __builtin_amdgcn_cvt_pk_fp8_f32(c, d, v, true);
  return (unsigned)v;
}
namespace pg8 {
constexpr int BM = 256, BK = 64, HALF = 128, HTB = HALF * BK * 2, NXCD = 8, WGM = 8;
__device__ __forceinline__ int lds_byte(int r, int c) { const int st = (r >> 4) * 2 + (c >> 5), rr = r & 15, cc = c & 31, ob = rr * 64 + cc * 2; return st * 1024 + (ob ^ (((ob >> 9) & 1) << 5)); }
__device__ __forceinline__ void stage_rc(int b, int& R, int& C) { const int st = b / 1024, sb = b % 1024, swz = sb ^ (((sb >> 9) & 1) << 5); R = (st >> 1) * 16 + swz / 64; C = (st & 1) * 32 + (swz % 64) / 2; }
__device__ __forceinline__ int perm32(int rho) { const int n = rho >> 4, i = rho & 15; return 8 * (i >> 2) + 4 * n + (i & 3); }
struct Unit { const char* A; const char* B; int pm, pn, e, aux; };

template <class Epi, class Sched, int HOOK_T, bool GATHER = false, bool FP8 = false>
__device__ __forceinline__ void gemm_phase(LAS unsigned char* lds, const int K, const Sched& S, const Epi& E) {
  const int tid = otid(), wid = __builtin_amdgcn_readfirstlane(tid >> 6), lane = tid & 63, wr = wid >> 2, wc = wid & 3, fr = lane & 15, fq = lane >> 4;
  const int nt = K / BK;
  unsigned voffA[2], voffB[2];
#pragma unroll
  for (int i = 0; i < 2; ++i) { int R, C; stage_rc(tid * 16 + i * 8192, R, C); const int Rb = Epi::PERM ? ((R & ~31) + perm32(R & 31)) : R;
    voffA[i] = (unsigned)(R * K + C) * 2u; voffB[i] = (unsigned)(Rb * K + C) * 2u; }
  const size_t kstep = (size_t)(BK * 2);
  const size_t hstep = (size_t)HALF * K * 2;
  int gR[2]; unsigned gC[2];
#pragma unroll
  for (int i = 0; i < 2; ++i) { int R, C; stage_rc(tid * 16 + i * 8192, R, C); gR[i] = R; gC[i] = (unsigned)C * 2u; }
  unsigned vC[2][2], vN[2][2], vX[2][2];
  const unsigned ldsw = (unsigned)wid * 1024u;
  const int aoff = lds_byte(wr * 64 + fr, fq * 8), boff = lds_byte(wc * 32 + fr, fq * 8);
#define PG8_SA(b, h) (((b) * 2 + (h)) * HTB)
#define PG8_SB(b, h) ((4 + (b) * 2 + (h)) * HTB)
#define PG8_STAGE(bufoff, gbase, voff) do { _Pragma("unroll") for (int _i = 0; _i < 2; ++_i) \
        __builtin_amdgcn_global_load_lds((const unsigned*)((const char*)(gbase) + (voff)[_i]), (LAS unsigned*)(lds + (bufoff) + ldsw + _i * 8192), 16, 0, 0); } while (0)
#define PG8_STAGE_A(bufoff, gbase, h, V) do { if constexpr (GATHER) { PG8_STAGE(bufoff, gbase, (V)[h]); } else { PG8_STAGE(bufoff, (gbase) + (h) * hstep, voffA); } } while (0)
#define PG8_GOFF(V, U) do { if constexpr (GATHER) { _Pragma("unroll") for (int _h = 0; _h < 2; ++_h) _Pragma("unroll") for (int _i = 0; _i < 2; ++_i) \
        (V)[_h][_i] = (unsigned)S.arow(U, gR[_i] + 128 * _h) * (unsigned)(K * 2) + gC[_i]; } } while (0)
#define PG8_LDA(dst, b, h) do { _Pragma("unroll") for (int m = 0; m < 4; ++m) _Pragma("unroll") for (int k = 0; k < 2; ++k) dst[m][k] = *(const LAS bf16x8*)(lds + PG8_SA(b, h) + aoff + m * 2048 + k * 1024); } while (0)
#define PG8_LDB(dst, b, h) do { _Pragma("unroll") for (int n = 0; n < 2; ++n) _Pragma("unroll") for (int k = 0; k < 2; ++k) dst[n][k] = *(const LAS bf16x8*)(lds + PG8_SB(b, h) + boff + n * 2048 + k * 1024); } while (0)
#define PG8_MMA(ai, bj, At, Bt) do { __builtin_amdgcn_s_setprio(1); \
      if constexpr (FP8) { _Pragma("unroll") for (int m = 0; m < 4; ++m) _Pragma("unroll") for (int n = 0; n < 2; ++n) \
        asm volatile("v_mfma_f32_16x16x128_f8f6f4 %0, %1, %2, %0" : "+v"(acc[ai][bj][m][n]) : "v"(cat8(Bt[n][0], Bt[n][1])), "v"(cat8(At[m][0], At[m][1]))); } \
      else { _Pragma("unroll") for (int m = 0; m < 4; ++m) _Pragma("unroll") for (int n = 0; n < 2; ++n) _Pragma("unroll") for (int k = 0; k < 2; ++k) \
        acc[ai][bj][m][n] = __builtin_amdgcn_mfma_f32_16x16x32_bf16(Bt[n][k], At[m][k], acc[ai][bj][m][n], 0, 0, 0); } \
      __builtin_amdgcn_s_setprio(0); } while (0)
#define PG8_WAIT_V(n) asm volatile("s_waitcnt vmcnt(" #n ")" ::: "memory")
#define PG8_WAIT_L(n) asm volatile("s_waitcnt lgkmcnt(" #n ")" ::: "memory")
#define PG8_BAR __builtin_amdgcn_s_barrier()
#define PG8_SCHED __builtin_amdgcn_sched_barrier(0)
#define PG8_KBODY \
      const bool last = (t == nt - 2); \
      const char* a1 = cA + (size_t)(t + 1) * kstep; \
      const char* a2 = last ? nA : cA + (size_t)(t + 2) * kstep; const char* b2 = last ? nB : cB + (size_t)(t + 2) * kstep; \
      const char* a3 = a2 + kstep; const char* b3 = b2 + kstep; \
      if constexpr (GATHER) { _Pragma("unroll") for (int _h = 0; _h < 2; ++_h) _Pragma("unroll") for (int _i = 0; _i < 2; ++_i) vX[_h][_i] = last ? vN[_h][_i] : vC[_h][_i]; } \
      PG8_LDB(B0, 0, 0); PG8_LDB(B1, 0, 1); PG8_SCHED; PG8_LDA(At, 0, 0); PG8_STAGE_A(PG8_SA(1, 1), a1, 1, vC); \
      PG8_WAIT_V(8); PG8_WAIT_L(0); PG8_BAR; PG8_MMA(0, 0, At, B0); PG8_MMA(0, 1, At, B1); PG8_BAR; PG8_SCHED; \
      PG8_LDA(At, 0, 1); PG8_STAGE(PG8_SB(0, 0), b2, voffB); PG8_STAGE(PG8_SB(0, 1), b2 + hstep, voffB); PG8_STAGE_A(PG8_SA(0, 0), a2, 0, vX); \
      PG8_WAIT_V(8); PG8_WAIT_L(0); PG8_BAR; PG8_MMA(1, 0, At, B0); PG8_MMA(1, 1, At, B1); PG8_BAR; PG8_SCHED; \
      PG8_LDB(B0, 1, 0); PG8_LDB(B1, 1, 1); PG8_SCHED; PG8_LDA(At, 1, 0); PG8_STAGE_A(PG8_SA(0, 1), a2, 1, vX); \
      PG8_WAIT_V(8); PG8_WAIT_L(0); PG8_BAR; PG8_MMA(0, 0, At, B0); PG8_MMA(0, 1, At, B1); PG8_BAR; PG8_SCHED; \
      PG8_LDA(At, 1, 1); PG8_STAGE(PG8_SB(1, 0), b3, voffB); PG8_STAGE(PG8_SB(1, 1), b3 + hstep, voffB); PG8_STAGE_A(PG8_SA(1, 0), a3, 0, vX); \
      PG8_WAIT_V(8); PG8_WAIT_L(0); PG8_BAR; PG8_MMA(1, 0, At, B0); PG8_MMA(1, 1, At, B1); PG8_BAR; PG8_SCHED;
  Unit cur, nxt; int ui = 0;
  if (!S.next(0, cur)) return;
  f32x4 acc[2][2][4][2];
#pragma unroll
  for (int a = 0; a < 2; ++a)
#pragma unroll
    for (int b = 0; b < 2; ++b)
#pragma unroll
      for (int m = 0; m < 4; ++m)
#pragma unroll
        for (int n = 0; n < 2; ++n) acc[a][b][m][n] = (f32x4){0.f, 0.f, 0.f, 0.f};
  bf16x8 At[4][2], B0[2][2], B1[2][2];
  const char* cA = cur.A; const char* cB = cur.B;
  PG8_GOFF(vC, cur);
  PG8_STAGE(PG8_SB(0, 0), cB, voffB); PG8_STAGE(PG8_SB(0, 1), cB + hstep, voffB); PG8_STAGE_A(PG8_SA(0, 0), cA, 0, vC); PG8_STAGE_A(PG8_SA(0, 1), cA, 1, vC);
  if (wr == 1) PG8_BAR;
  PG8_WAIT_V(2); PG8_BAR;
  PG8_STAGE(PG8_SB(1, 0), cB + kstep, voffB); PG8_STAGE_A(PG8_SA(1, 0), cA + kstep, 0, vC); PG8_STAGE(PG8_SB(1, 1), cB + hstep + kstep, voffB);
  PG8_WAIT_V(6); PG8_BAR;
  for (;;) {
    const bool has_next = S.next(ui + 1, nxt);
    const char* nA = has_next ? nxt.A : cA; const char* nB = has_next ? nxt.B : cB;
    if constexpr (GATHER) { if (has_next) { PG8_GOFF(vN, nxt); } else { _Pragma("unroll") for (int _h = 0; _h < 2; ++_h) _Pragma("unroll") for (int _i = 0; _i < 2; ++_i) vN[_h][_i] = vC[_h][_i]; } }
    if constexpr (HOOK_T > 0) {
      _Pragma("unroll 1") for (int t = 0; t < HOOK_T; t += 2) { PG8_KBODY }
      E.hook(acc, cur, wr, wc, fr, fq);
      _Pragma("unroll 1") for (int t = HOOK_T; t < nt; t += 2) { PG8_KBODY }
    } else {
      _Pragma("unroll 1") for (int t = 0; t < nt; t += 2) { PG8_KBODY }
    }
    if constexpr (FP8) asm volatile("s_nop 15\n\ts_nop 15" ::: "memory");
    if (wr == 0) PG8_BAR;
    E(acc, cur, wr, wc, fr, fq);
    if (!has_next) break;
#pragma unroll
    for (int a = 0; a < 2; ++a)
#pragma unroll
      for (int b = 0; b < 2; ++b)
#pragma unroll
        for (int m = 0; m < 4; ++m)
#pragma unroll
          for (int n = 0; n < 2; ++n) acc[a][b][m][n] = (f32x4){0.f, 0.f, 0.f, 0.f};
    cur = nxt; cA = nA; cB = nB; ++ui;
    if constexpr (GATHER) { _Pragma("unroll") for (int _h = 0; _h < 2; ++_h) _Pragma("unroll") for (int _i = 0; _i < 2; ++_i) vC[_h][_i] = vN[_h][_i]; }
    if (wr == 1) PG8_BAR;
  }
  PG8_WAIT_V(0);
  PG8_BAR;
#undef PG8_SA
#undef PG8_SB
#undef PG8_STAGE
#undef PG8_STAGE_A
#undef PG8_GOFF
#undef PG8_LDA
#undef PG8_LDB
#undef PG8_MMA
#undef PG8_WAIT_V
#undef PG8_WAIT_L
#undef PG8_BAR
#undef PG8_SCHED
#undef PG8_KBODY
}

struct DenseSched {
  __device__ __forceinline__ int arow(const Unit&, int) const { return 0; }
  int nM, nN, nwg, G, c; const char* A; const char* B; size_t tstep;
  __device__ __forceinline__ void init(int nM_, int nN_, int G_, int c_, const void* A_, const void* B_, int K) { nM = nM_; nN = nN_; nwg = nM * nN; G = G_; c = c_; A = (const char*)A_; B = (const char*)B_; tstep = (size_t)BM * K * 2; }
  __device__ __forceinline__ bool next(int i, Unit& u) const {
    const long L = (long)i * G + c; if (L >= nwg) return false;
    int wgid = (int)L; { const int q = nwg / NXCD, r = nwg % NXCD, xcd = wgid % NXCD, off = wgid / NXCD; wgid = (xcd < r ? xcd * (q + 1) : r * (q + 1) + (xcd - r) * q) + off; }
    const int nig = WGM * nN, gid = wgid / nig, fm = gid * WGM, gsz = (nM - fm) < WGM ? (nM - fm) : WGM;
    u.pm = fm + ((wgid % nig) % gsz); u.pn = (wgid % nig) / gsz; u.e = 0; u.aux = 0;
    u.A = A + (size_t)u.pm * tstep; u.B = B + (size_t)u.pn * tstep; return true;
  }
};
struct SingleSched {
  Unit u0;
  __device__ __forceinline__ int arow(const Unit&, int) const { return 0; }
  __device__ __forceinline__ bool next(int i, Unit& u) const { if (i != 0) return false; u = u0; return true; }
};
struct MoeSched {
  int U, nN, G, c; const char* A; const char* B; size_t tstep, estep; volatile LAS int* tab; const int* list; bool gather;
  __device__ __forceinline__ int arow(const Unit& u, int r) const { const int rl = u.aux * 256 + r; return (rl < tab[96 + u.e]) ? (list[(size_t)u.e * NT + rl] >> 1) : 0; }
  __device__ __forceinline__ bool next(int i, Unit& u) const {
    const long L = (long)i * G + c; if (L >= U) return false;
    int w = (int)L; { const int q = U / NXCD, r = U % NXCD, xcd = w % NXCD, off = w / NXCD; w = (xcd < r ? xcd * (q + 1) : r * (q + 1) + (xcd - r) * q) + off; }
    int e = 0;
#pragma unroll 1
    for (int k = 1; k < 16; ++k) e += (w >= tab[k]) ? 1 : 0;
    const int local = w - tab[e], mt = tab[32 + e], tb = tab[64 + e];
    const int pn = local / mt, pml = local - pn * mt;
    u.e = __builtin_amdgcn_readfirstlane(e); u.aux = __builtin_amdgcn_readfirstlane(pml);
    u.pm = __builtin_amdgcn_readfirstlane(tb + pml); u.pn = __builtin_amdgcn_readfirstlane(pn);
    u.A = gather ? A : A + (size_t)u.pm * tstep; u.B = B + (size_t)u.e * estep + (size_t)u.pn * tstep; return true;
  }
};
}
using pg8::Unit;
typedef f32x4 AccT[2][2][4][2];

struct EpiProj {
  static constexpr bool PERM = true;
  bf16_t* O; float* lr32;
  __device__ __forceinline__ void operator()(const AccT& acc, const Unit& u, int wr, int wc, int fr, int fq) const {
    const int row0 = u.pm * 256 + wr * 64 + fr, col0 = u.pn * 256 + wc * 32 + 8 * fq;
    const bool lrt = (u.pn == 12) && (wc == 0);
#pragma unroll
    for (int ai = 0; ai < 2; ++ai)
#pragma unroll
      for (int m = 0; m < 4; ++m) {
        const int row = row0 + ai * 128 + m * 16;
        bf16_t* rowp = O + (size_t)row * PSTR + col0;
#pragma unroll
        for (int bj = 0; bj < 2; ++bj) {
          const f32x4 v0 = acc[ai][bj][m][0] * 0.0625f, v1 = acc[ai][bj][m][1] * 0.0625f;
          u32x4 w; w.x = pk2(v0[0], v0[1]); w.y = pk2(v0[2], v0[3]); w.z = pk2(v1[0], v1[1]); w.w = pk2(v1[2], v1[3]);
          *(u32x4*)(rowp + bj * 128) = w;
          if (bj == 0 && lrt) { float* lp = lr32 + (size_t)row * 32 + 8 * fq; *(f32x4*)lp = v0; *(f32x4*)(lp + 4) = v1; }
        }
      }
  }
  __device__ __forceinline__ void hook(AccT&, const Unit&, int, int, int, int) const {}
};
struct EpiMerge {
  static constexpr bool PERM = true;
  const bf16_t* proj; bf16_t* O;
  __device__ __forceinline__ void hook(AccT& acc, const Unit& u, int wr, int wc, int fr, int fq) const {
    const int row0 = u.pm * 256 + wr * 64 + fr, col0 = u.pn * 256 + wc * 32 + 8 * fq;
#pragma unroll
    for (int ai = 0; ai < 2; ++ai) {
      u32x4 g0[4][2], g1[4][2];
#pragma unroll
      for (int m = 0; m < 4; ++m) {
        const bf16_t* gp = proj + (size_t)(row0 + ai * 128 + m * 16) * PSTR + col0;
#pragma unroll
        for (int bj = 0; bj < 2; ++bj) { g0[m][bj] = *(const u32x4*)(gp + 4640 + bj * 128); g1[m][bj] = *(const u32x4*)(gp + 5664 + bj * 128); }
      }
#pragma unroll
      for (int m = 0; m < 4; ++m)
#pragma unroll
        for (int bj = 0; bj < 2; ++bj)
#pragma unroll
          for (int q = 0; q < 4; ++q) {
            const float a0 = bflo(g0[m][bj][q]), a1 = bfhi(g0[m][bj][q]), b0 = bflo(g1[m][bj][q]), b1 = bfhi(g1[m][bj][q]);
            const float r0 = (1.f + __expf(-b0)) * __builtin_amdgcn_rcpf(1.f + __expf(-a0)), r1 = (1.f + __expf(-b1)) * __builtin_amdgcn_rcpf(1.f + __expf(-a1));
            acc[ai][bj][m][q >> 1][(q & 1) * 2] *= r0; acc[ai][bj][m][q >> 1][(q & 1) * 2 + 1] *= r1;
          }
      __builtin_amdgcn_sched_barrier(0);
    }
  }
  __device__ __forceinline__ void operator()(const AccT& acc, const Unit& u, int wr, int wc, int fr, int fq) const {
    int row0 = u.pm * 256 + wr * 64 + fr; const int col0 = u.pn * 256 + wc * 32 + 8 * fq;
    asm volatile("" : "+v"(row0));
#pragma unroll
    for (int ai = 0; ai < 2; ++ai)
#pragma unroll
      for (int m = 0; m < 4; ++m) {
        const int row = row0 + ai * 128 + m * 16;
        const bf16_t* gp = proj + (size_t)row * PSTR + col0 + 5664;
        bf16_t* op = O + (size_t)row * 1024 + col0;
#pragma unroll
        for (int bj = 0; bj < 2; ++bj) {
          const u32x4 g1 = *(const u32x4*)(gp + bj * 128);
          float o[8];
#pragma unroll
          for (int q = 0; q < 4; ++q) {
            o[2 * q] = acc[ai][bj][m][q >> 1][(q & 1) * 2] * sigmoidf_(bflo(g1[q]));
            o[2 * q + 1] = acc[ai][bj][m][q >> 1][(q & 1) * 2 + 1] * sigmoidf_(bfhi(g1[q]));
          }
          u32x4 w; w.x = pk2(o[0], o[1]); w.y = pk2(o[2], o[3]); w.z = pk2(o[4], o[5]); w.w = pk2(o[6], o[7]);
          *(u32x4*)(op + bj * 128) = w;
        }
      }
  }
};
struct EpiOut {
  static constexpr bool PERM = true;
  bf16_t* Y;
  __device__ __forceinline__ void operator()(const AccT& acc, const Unit& u, int wr, int wc, int fr, int fq) const {
    const int row0 = u.pm * 256 + wr * 64 + fr, col0 = u.pn * 256 + wc * 32 + 8 * fq;
#pragma unroll
    for (int ai = 0; ai < 2; ++ai)
#pragma unroll
      for (int m = 0; m < 4; ++m) {
        bf16_t* yp = Y + (size_t)(row0 + ai * 128 + m * 16) * 1024 + col0;
#pragma unroll
        for (int bj = 0; bj < 2; ++bj) {
          const f32x4 v0 = acc[ai][bj][m][0], v1 = acc[ai][bj][m][1];
          u32x4 w; w.x = pk2(v0[0], v0[1]); w.y = pk2(v0[2], v0[3]); w.z = pk2(v1[0], v1[1]); w.w = pk2(v1[2], v1[3]);
          *(u32x4*)(yp + bj * 128) = w;
        }
      }
  }
  __device__ __forceinline__ void hook(AccT&, const Unit&, int, int, int, int) const {}
};
struct EpiMoe1 {
  static constexpr bool PERM = true;
  unsigned char* hid;
  __device__ __forceinline__ void operator()(const AccT& acc, const Unit& u, int wr, int wc, int fr, int fq) const {
    const int row0 = u.pm * 256 + wr * 64 + fr, hc0 = u.pn * 128 + wc * 16 + 4 * fq;
#pragma unroll
    for (int ai = 0; ai < 2; ++ai)
#pragma unroll
      for (int m = 0; m < 4; ++m) {
        unsigned char* hp = hid + (size_t)(row0 + ai * 128 + m * 16) * 1024 + hc0;
#pragma unroll
        for (int bj = 0; bj < 2; ++bj) {
          const f32x4 a = acc[ai][bj][m][0], b = acc[ai][bj][m][1];
          float hv[4];
#pragma unroll
          for (int j = 0; j < 4; ++j) hv[j] = __builtin_amdgcn_fmed3f(siluf_(a[j] * 0.0625f) * (b[j] * 0.5f), -440.f, 440.f);
          *(unsigned*)(hp + bj * 64) = pk4_fp8(hv[0], hv[1], hv[2], hv[3]);
        }
      }
  }
  __device__ __forceinline__ void hook(AccT&, const Unit&, int, int, int, int) const {}
};
struct EpiMoe2 {
  static constexpr bool PERM = true;
  bf16_t* yb; const int* list; const float* topw; volatile LAS int* tab;
  __device__ __forceinline__ void operator()(const AccT& acc, const Unit& u, int wr, int wc, int fr, int fq) const {
    const int rl0 = u.aux * 256 + wr * 64 + fr, col0 = u.pn * 256 + wc * 32 + 8 * fq;
    const int cnt = tab[96 + u.e];
    const int* lst = list + (size_t)u.e * NT;
#pragma unroll
    for (int ai = 0; ai < 2; ++ai)
#pragma unroll
      for (int m = 0; m < 4; ++m) {
        const int rl = rl0 + ai * 128 + m * 16;
        if (rl < cnt) {
          const int pr = lst[rl];
          const float tw = topw[pr] * (1.f / 128.f);
          bf16_t* op = yb + (size_t)pr * 1024 + col0;
#pragma unroll
          for (int bj = 0; bj < 2; ++bj) {
            const f32x4 v0 = acc[ai][bj][m][0] * tw, v1 = acc[ai][bj][m][1] * tw;
            u32x4 w; w.x = pk2(v0[0], v0[1]); w.y = pk2(v0[2], v0[3]); w.z = pk2(v1[0], v1[1]); w.w = pk2(v1[2], v1[3]);
            *(u32x4*)(op + bj * 128) = w;
          }
        }
      }
  }
  __device__ __forceinline__ void hook(AccT&, const Unit&, int, int, int, int) const {}
};

template <int MODE>
__device__ __forceinline__ void transpose_item(const float* W, int ldw, bf16_t* WT, int ldt, int koff, LAS float* scr, int kb, int nb, int lane) {
  const int k0 = 64 * kb, n0 = 32 * nb;
  {
    const int n4 = (lane & 7) * 4;
    f32x4 v[8];
#pragma unroll
    for (int i = 0; i < 8; ++i) v[i] = *(const f32x4*)(W + (size_t)(k0 + 8 * i + (lane >> 3)) * ldw + n0 + n4);
#pragma unroll
    for (int i = 0; i < 8; ++i) { LAS float* d = scr + (8 * i + (lane >> 3)) * 33 + n4; d[0] = v[i][0]; d[1] = v[i][1]; d[2] = v[i][2]; d[3] = v[i][3]; }
  }
  asm volatile("s_waitcnt lgkmcnt(0)" ::: "memory");
  const int c = lane & 7;
#pragma unroll
  for (int j = 0; j < 4; ++j) {
    const int n = (lane >> 3) + 8 * j; const LAS float* s = scr + (8 * c) * 33 + n;
    u32x4 o; o.x = pk2(s[0 * 33], s[1 * 33]); o.y = pk2(s[2 * 33], s[3 * 33]); o.z = pk2(s[4 * 33], s[5 * 33]); o.w = pk2(s[6 * 33], s[7 * 33]);
    const int ng = n0 + n;
    const int dr = (MODE == 0) ? ng : ((ng >> 2) * 8 + (ng & 3) + (MODE == 2 ? 4 : 0));
    *(u32x4*)(WT + (size_t)dr * ldt + koff + k0 + 8 * c) = o;
  }
  asm volatile("s_waitcnt lgkmcnt(0)" ::: "memory");
}

template <int MODE>
__device__ __forceinline__ void transpose_item_fp8(const float* W, int ldw, unsigned char* WT, int ldt, LAS float* scr, int kb, int nb, int lane) {
  const int k0 = 64 * kb, n0 = 32 * nb;
  {
    const int n4 = (lane & 7) * 4;
    f32x4 v[8];
#pragma unroll
    for (int i = 0; i < 8; ++i) v[i] = *(const f32x4*)(W + (size_t)(k0 + 8 * i + (lane >> 3)) * ldw + n0 + n4);
#pragma unroll
    for (int i = 0; i < 8; ++i) { LAS float* d = scr + (8 * i + (lane >> 3)) * 33 + n4; d[0] = v[i][0]; d[1] = v[i][1]; d[2] = v[i][2]; d[3] = v[i][3]; }
  }
  asm volatile("s_waitcnt lgkmcnt(0)" ::: "memory");
  const int c = lane & 7;
#pragma unroll
  for (int j = 0; j < 4; ++j) {
    const int n = (lane >> 3) + 8 * j; const LAS float* sp = scr + (8 * c) * 33 + n;
    u32x2 o; o.x = pk4_fp8(16.f * sp[0 * 33], 16.f * sp[1 * 33], 16.f * sp[2 * 33], 16.f * sp[3 * 33]); o.y = pk4_fp8(16.f * sp[4 * 33], 16.f * sp[5 * 33], 16.f * sp[6 * 33], 16.f * sp[7 * 33]);
    const int ng = n0 + n;
    const int dr = (MODE == 0) ? ng : ((ng >> 2) * 8 + (ng & 3) + (MODE == 2 ? 4 : 0));
    *(u32x2*)(WT + (size_t)dr * ldt + k0 + 8 * c) = o;
  }
  asm volatile("s_waitcnt lgkmcnt(0)" ::: "memory");
}
__device__ void ph_init(const Params& p, LAS unsigned char* lds, int bid, int nb) {
  WS_LOCAL
  const int tid = otid(), wave = tid >> 6, lane = tid & 63;
  LAS float* sc = (LAS float*)(lds + 8 * 8448);
  for (int i = tid; i < 3 * 1024; i += NTHR) {
    int r = i >> 10, k = i & 1023;
    float v = (r < 2) ? KARG(const float, 1)[r * 1024 + k] : KARG(const float, 3)[k];
    sc[i] = v / (1.f + expf(-v));
  }
  __syncthreads();
  LAS float* scr = (LAS float*)(lds + wave * 8448);
  const int gw = bid * NWAVES + wave, NGW = nb * NWAVES;
  constexpr int I_ADA = 2 * 24 * 32, I_IN = 16 * 209, I_MG = 16 * 32, I_MN = 8 * 32, I_O = 16 * 32, I_PAD = 224, I_ROPE = 64;
  constexpr int NITEMS = I_ADA + 2 * (I_IN + I_MG + I_MN + I_O + I_PAD) + I_ROPE;
  for (int it = gw; it < NITEMS; it += NGW) {
    int r = it;
    if (r < I_ADA) {
      const int l = r / 768, cb = (r % 768) >> 5, ks = r & 31, col0 = cb * 256 + lane * 4;
      const float* w = KARG(const float, 4) + ((size_t)l * 1024 + ks * 32) * 6144 + col0;
      f32x4 wv[32];
#pragma unroll
      for (int i = 0; i < 32; ++i) wv[i] = __builtin_nontemporal_load((const f32x4*)(w + (size_t)i * 6144));
      f32x4 a0 = {0.f, 0.f, 0.f, 0.f}, a1 = a0, a2 = a0;
#pragma unroll
      for (int i = 0; i < 32; ++i) { const int k = ks * 32 + i; a0 += sc[k] * wv[i]; a1 += sc[1024 + k] * wv[i]; a2 += sc[2048 + k] * wv[i]; }
      float* part = WSP(float, WS_APART) + ((size_t)(l * 32 + ks) * 3) * 6144 + col0;
      *(f32x4*)(part) = a0; *(f32x4*)(part + 6144) = a1; *(f32x4*)(part + 2 * 6144) = a2;
      continue;
    }
    r -= I_ADA;
    if (r < I_ROPE) {
      const int idx = r * 64 + lane, pos = idx >> 5, i = idx & 31;
      const float inv = exp2f(-(float)i * (13.287712379549449f / 32.f)), ang = (float)pos * inv;
      const float kk = rintf(ang * 0.15915494309189535f);
      float rr = fmaf(-kk, 6.2831854820251465f, ang); rr = fmaf(-kk, -1.7484556000744883e-07f, rr);
      WSP(float, WS_ROPE)[idx * 2] = cosf(rr); WSP(float, WS_ROPE)[idx * 2 + 1] = sinf(rr);
      continue;
    }
    r -= I_ROPE;
    const int per = I_IN + I_MG + I_MN + I_O + I_PAD;
    const int l = r / per; r -= l * per;
    if (r < I_IN) { transpose_item_fp8<0>(KARG(const float, 8) + (size_t)l * 1024 * INC, INC, WSP(unsigned char, WS_WINT) + (size_t)l * PSTR * 1024, 1024, scr, r / 209, r % 209, lane); continue; } r -= I_IN;
    if (r < I_MG) { transpose_item<0>(KARG(const float, 13) + (size_t)l * 1024 * 1024, 1024, WSP(bf16_t, WS_WMT) + (size_t)l * 1024 * GSTR, GSTR, 0, scr, r / 32, r % 32, lane); continue; } r -= I_MG;
    if (r < I_MN) { transpose_item<0>(KARG(const float, 14) + (size_t)l * 512 * 1024, 1024, WSP(bf16_t, WS_WMT) + (size_t)l * 1024 * GSTR, GSTR, 1024, scr, r / 32, r % 32, lane); continue; } r -= I_MN;
    if (r < I_O) { transpose_item<0>(KARG(const float, 15) + (size_t)l * 1024 * 1024, 1024, WSP(bf16_t, WS_WOT) + (size_t)l * 1024 * 1024, 1024, 0, scr, r / 32, r % 32, lane); continue; } r -= I_O;
    {
      unsigned zz = 0u; asm volatile("" : "+v"(zz));
      u32x4 z = {zz, zz, zz, zz};
      u32x4* dst = (u32x4*)(WSP(unsigned char, WS_WINT) + (size_t)l * PSTR * 1024 + (size_t)(INC + r) * 1024);
      dst[lane] = z;
    }
  }
}
__device__ void ph_ada_reduce(const Params& p, int bid, int nb) {
  WS_LOCAL
  const int tid = otid(), wave = tid >> 6, lane = tid & 63;
  for (int it = bid * NWAVES + wave; it < 48; it += nb * NWAVES) {
    const int l = it / 24, cb = it % 24, col0 = cb * 256 + lane * 4;
    const float* pb = WSP(float, WS_APART) + ((size_t)(l * 32) * 3) * 6144 + col0;
    const f32x4 bb = *(const f32x4*)(KARG(const float, 5) + l * 6144 + col0);
#pragma unroll
    for (int rr = 0; rr < 3; ++rr) {
      f32x4 sum = bb;
#pragma unroll
      for (int k8 = 0; k8 < 32; ++k8) sum += *(const f32x4*)(pb + ((size_t)k8 * 3 + rr) * 6144);
      *(f32x4*)(WSP(float, WS_MOD) + (l * 3 + rr) * 6144 + col0) = sum;
    }
  }
}
struct XItem { const float* W; unsigned char* WT; int kb, nb, mode; };
__device__ __forceinline__ void xp_decode(const Params& p, int l, int it, XItem& x) {
  WS_LOCAL
  const int e = it / 1536, r = it % 1536, mat = r / 512, q = r % 512;
  const size_t eo = ((size_t)(l * 16 + e)) << 20;
  x.W = (mat == 0 ? KARG(const float, 18) : mat == 1 ? KARG(const float, 19) : KARG(const float, 20)) + eo;
  x.WT = (mat == 2) ? WSP(unsigned char, WS_W2F8) + ((size_t)e << 20) : WSP(unsigned char, WS_RG) + ((size_t)e << 21);
  x.kb = q / 32; x.nb = q % 32; x.mode = (mat == 2) ? 0 : mat + 1;
}
__device__ __forceinline__ void xp_load(const XItem& x, int lane, f32x4 (&v)[8]) {
  const float* src = x.W + (size_t)(64 * x.kb + (lane >> 3)) * 1024 + 32 * x.nb + (lane & 7) * 4;
#pragma unroll
  for (int i = 0; i < 8; ++i) v[i] = __builtin_nontemporal_load((const f32x4*)(src + (size_t)(8 * i) * 1024));
}
__device__ __forceinline__ void xp_finish(const XItem& x, int lane, LAS float* scr, const f32x4 (&v)[8]) {
  {
    const int n4 = (lane & 7) * 4;
#pragma unroll
    for (int i = 0; i < 8; ++i) { LAS float* d = scr + (8 * i + (lane >> 3)) * 33 + n4; d[0] = v[i][0]; d[1] = v[i][1]; d[2] = v[i][2]; d[3] = v[i][3]; }
  }
  asm volatile("s_waitcnt lgkmcnt(0)" ::: "memory");
  const int c = lane & 7;
#pragma unroll
  for (int j = 0; j < 4; ++j) {
    const int n = (lane >> 3) + 8 * j; const LAS float* sp = scr + (8 * c) * 33 + n;
    u32x2 o; o.x = pk4_fp8(16.f * sp[0 * 33], 16.f * sp[1 * 33], 16.f * sp[2 * 33], 16.f * sp[3 * 33]); o.y = pk4_fp8(16.f * sp[4 * 33], 16.f * sp[5 * 33], 16.f * sp[6 * 33], 16.f * sp[7 * 33]);
    const int ng = 32 * x.nb + n;
    const int dr = (x.mode == 0) ? ng : ((ng >> 2) * 8 + (ng & 3) + (x.mode == 2 ? 4 : 0));
    *(u32x2*)(x.WT + (size_t)dr * 1024 + 64 * x.kb + 8 * c) = o;
  }
  asm volatile("s_waitcnt lgkmcnt(0)" ::: "memory");
}
__device__ void ph_experts(const Params& p, int l, LAS unsigned char* lds, int bid, int nb) {
  const int tid = otid(), wave = tid >> 6, lane = tid & 63;
  LAS float* scr = (LAS float*)(lds + wave * 8448);
  const int skipb = (l == 0) ? 16 : 0;
  if (bid < skipb) return;
  const int gw = (bid - skipb) * NWAVES + wave, NGW = (nb - skipb) * NWAVES;
  constexpr int NIT = 16 * 3 * 512;
  f32x4 va[8], vb[8]; XItem xa, xb;
  int it = gw;
  if (it < NIT) { xp_decode(p, l, it, xa); xp_load(xa, lane, va); }
#pragma unroll 1
  for (; it < NIT; it += 2 * NGW) {
    const int it2 = it + NGW, it3 = it2 + NGW;
    if (it2 < NIT) { xp_decode(p, l, it2, xb); xp_load(xb, lane, vb); }
    xp_finish(xa, lane, scr, va);
    if (it3 < NIT) { xp_decode(p, l, it3, xa); xp_load(xa, lane, va); }
    if (it2 < NIT) xp_finish(xb, lane, scr, vb);
  }
}

__device__ void ph_norm1(const Params& p, int l, int bid, int nb) {
  WS_LOCAL
  const int tid = otid(), wave = tid >> 6, lane = tid & 63;
  const int NGW = nb * NWAVES;
  for (int rowa = bid * NWAVES + wave; rowa < NT; rowa += 2 * NGW) {
    f32x4 v[2][4];
    int rows[2]; rows[0] = rowa; rows[1] = rowa + NGW;
    const bool has2 = rows[1] < NT;
    if (!has2) rows[1] = rowa;
#pragma unroll
    for (int u = 0; u < 2; ++u) {
      const int row = rows[u];
      if (l == 0) {
        const float* src = (row < NL) ? KARG(const float, 0) + (size_t)row * 1024 : KARG(const float, 2) + (size_t)(row - NL) * 1024;
#pragma unroll
        for (int i = 0; i < 4; ++i) v[u][i] = __builtin_nontemporal_load((const f32x4*)(src + i * 256 + lane * 4));
      } else {
        const int r = (row < NL) ? (row >> 13) : 2;
        const float* src = WSP(float, WS_XBUF) + (size_t)row * 1024;
        const float* m5 = WSP(float, WS_MOD) + (0 * 3 + r) * 6144 + 5 * 1024;
        const bf16_t* y0 = WSP(bf16_t, WS_PROJ + 2 * PROWS * 2048) + (size_t)(row * 2) * 1024;
#pragma unroll
        for (int i = 0; i < 4; ++i) {
          const int j = i * 256 + lane * 4;
          v[u][i] = *(const f32x4*)(src + j);
          const u32x2 ya = __builtin_nontemporal_load((const u32x2*)(y0 + j)), yb = __builtin_nontemporal_load((const u32x2*)(y0 + 1024 + j));
          const f32x4 g = *(const f32x4*)(m5 + j);
          v[u][i][0] += g[0] * (bflo(ya.x) + bflo(yb.x)); v[u][i][1] += g[1] * (bfhi(ya.x) + bfhi(yb.x));
          v[u][i][2] += g[2] * (bflo(ya.y) + bflo(yb.y)); v[u][i][3] += g[3] * (bfhi(ya.y) + bfhi(yb.y));
        }
      }
    }
#pragma unroll
    for (int u = 0; u < 2; ++u) {
      if (u == 1 && !has2) break;
      const int row = rows[u];
      const int r = (row < NL) ? (row >> 13) : 2;
      float ss = 0.f;
#pragma unroll
      for (int i = 0; i < 4; ++i) ss += v[u][i][0] * v[u][i][0] + v[u][i][1] * v[u][i][1] + v[u][i][2] * v[u][i][2] + v[u][i][3] * v[u][i][3];
      ss = wave_sum(ss);
      const float rstd = rsqrtf(ss * (1.f / 1024.f) + 1e-6f);
      const float* md = WSP(float, WS_MOD) + (l * 3 + r) * 6144;
      const float* nw = KARG(const float, 6) + l * 1024;
#pragma unroll
      for (int i = 0; i < 4; ++i) {
        const int j = i * 256 + lane * 4;
        const f32x4 w = *(const f32x4*)(nw + j), m1 = *(const f32x4*)(md + 1024 + j), m0 = *(const f32x4*)(md + j);
        f32x4 h;
#pragma unroll
        for (int q = 0; q < 4; ++q) h[q] = v[u][i][q] * rstd * w[q] * (1.f + m1[q]) + m0[q];
        *(unsigned*)(WSP(unsigned char, WS_HM) + (size_t)row * 1024 + j) = pk4_fp8(h[0], h[1], h[2], h[3]);
        if (l != 0) *(f32x4*)(WSP(float, WS_XBUF) + (size_t)row * 1024 + j) = v[u][i];
      }
    }
  }
}

typedef short s16x4 __attribute__((ext_vector_type(4)));
__device__ __forceinline__ s16x4 ds_tr(const LAS unsigned char* p) { return __builtin_amdgcn_ds_read_tr16_b64_v4i16((LAS s16x4*)p); }
#define NA_RS 144
#define NAU 4
__device__ void na_wave_task(const Params& p, int l, LAS unsigned char* vlb, LAS unsigned char* vl, int task, int lane) {
  WS_LOCAL
  const int fr = lane & 15, g = lane >> 4, q4 = fr >> 2, p4 = fr & 3;
  constexpr int NLAT = 2 * (128 / NAU) * 4 * 8;
  int b, h, nloc, jg = 0, cb = 0, rbase = 0, rmin = 0;
  int qrow[NAU], ru[NAU], r0u[NAU];
  if (task < NLAT) {
    h = task & 7; jg = (task >> 3) & 3; const int rg = (task >> 5) % (128 / NAU); b = task / (32 * (128 / NAU));
    rbase = rg * NAU; cb = (jg == 0) ? 0 : (jg == 1) ? 8 : (jg == 2) ? 24 : 32;
#pragma unroll
    for (int u = 0; u < NAU; ++u) { ru[u] = rbase + u; r0u[u] = min(max(ru[u] - 4, 0), 120); qrow[u] = b * 8192 + ru[u] * 64 + 16 * jg; }
    rmin = r0u[0]; nloc = r0u[NAU - 1] + 8 - rmin;
  } else {
    const int t2 = task - NLAT; h = t2 & 7; const int qg = (t2 >> 3) % (16 / NAU); b = t2 / (8 * (16 / NAU));
#pragma unroll
    for (int u = 0; u < NAU; ++u) { ru[u] = 0; r0u[u] = 0; qrow[u] = NL + b * 256 + (qg * NAU + u) * 16; }
    nloc = 0;
  }
  const bf16_t* pj = WSP(bf16_t, WS_PROJ);
  bf16x8 qf[NAU][2];
#pragma unroll
  for (int u = 0; u < NAU; ++u)
#pragma unroll
    for (int ks = 0; ks < 2; ++ks) qf[u][ks] = *(const bf16x8*)(pj + (size_t)(qrow[u] + fr) * PSTR + 3104 + h * 64 + 32 * ks + 8 * g);
  const LAS float* rp = (const LAS float*)(vlb + 40960) + h * 465;
  const int cq = 16 * jg + fr, c0 = min(max(cq - 8, 0), 48);
  f32x4 oacc[NAU][4];
#pragma unroll
  for (int u = 0; u < NAU; ++u)
#pragma unroll
    for (int c = 0; c < 4; ++c) oacc[u][c] = (f32x4){0.f, 0.f, 0.f, 0.f};
  float mrun[NAU], lsum[NAU];
#pragma unroll
  for (int u = 0; u < NAU; ++u) { mrun[u] = -1e30f; lsum[u] = 0.f; }
  const int nst = nloc + 8;
#pragma unroll 1
  for (int st = 0; st < nst; ++st) {
    const bool loc = st < nloc;
    const int kr = rmin + st;
    const int kbase = loc ? (b * 8192 + kr * 64 + cb) : (NL + b * 256 + (st - nloc) * 32);
    bf16x8 kf[2][2]; u32x4 vv[4];
#pragma unroll
    for (int tb = 0; tb < 2; ++tb)
#pragma unroll
      for (int ks = 0; ks < 2; ++ks) kf[tb][ks] = *(const bf16x8*)(pj + (size_t)(kbase + 16 * tb + fr) * PSTR + 3616 + h * 64 + 32 * ks + 8 * g);
#pragma unroll
    for (int i = 0; i < 4; ++i) { const int ci = lane + 64 * i, key = ci >> 3, dch = ci & 7; vv[i] = *(const u32x4*)(pj + (size_t)(kbase + key) * PSTR + 4128 + h * 64 + dch * 8); }
    bool okc[8]; int cix[8];
#pragma unroll
    for (int k = 0; k < 8; ++k) { const int kc = cb + 16 * (k >> 2) + 4 * g + (k & 3); okc[k] = (kc >= c0) && (kc < c0 + 16); cix[k] = min(max(kc - cq + 15, 0), 30); }
#pragma unroll
    for (int i = 0; i < 4; ++i) { const int ci = lane + 64 * i, key = ci >> 3, dch = ci & 7; *(LAS u32x4*)(vl + key * NA_RS + dch * 16) = vv[i]; }
    bf16x8 pf[NAU];
#pragma unroll
    for (int u = 0; u < NAU; ++u) {
      f32x4 sc[2];
#pragma unroll
      for (int tb = 0; tb < 2; ++tb) {
        sc[tb] = __builtin_amdgcn_mfma_f32_16x16x32_bf16(kf[tb][0], qf[u][0], (f32x4){0.f, 0.f, 0.f, 0.f}, 0, 0, 0);
        sc[tb] = __builtin_amdgcn_mfma_f32_16x16x32_bf16(kf[tb][1], qf[u][1], sc[tb], 0, 0, 0);
      }
      float sv[8]; float mst = -1e30f;
      if (loc) {
        const bool rowok = (kr >= r0u[u]) && (kr < r0u[u] + 8);
        const LAS float* rrow = rp + min(max(kr - ru[u] + 7, 0), 14) * 31;
        float bias[8];
#pragma unroll
        for (int k = 0; k < 8; ++k) bias[k] = rrow[cix[k]];
        asm volatile("" : "+v"(bias[0]), "+v"(bias[1]), "+v"(bias[2]), "+v"(bias[3]), "+v"(bias[4]), "+v"(bias[5]), "+v"(bias[6]), "+v"(bias[7]));
#pragma unroll
        for (int k = 0; k < 8; ++k) { const float v = (okc[k] && rowok) ? sc[k >> 2][k & 3] * 0.125f + bias[k] : -INFINITY; sv[k] = v; mst = fmaxf(mst, v); }
      } else {
#pragma unroll
        for (int k = 0; k < 8; ++k) { const float v = sc[k >> 2][k & 3] * 0.125f; sv[k] = v; mst = fmaxf(mst, v); }
      }
      mst = fmaxf(mst, __shfl_xor(mst, 16, 64)); mst = fmaxf(mst, __shfl_xor(mst, 32, 64));
      const float mnew = fmaxf(mrun[u], mst); const float alpha = __expf(mrun[u] - mnew); mrun[u] = mnew;
      float ps = 0.f; float pv[8];
#pragma unroll
      for (int k = 0; k < 8; ++k) { const float e = __expf(sv[k] - mnew); pv[k] = e; ps += e; }
      lsum[u] = lsum[u] * alpha + ps;
#pragma unroll
      for (int c = 0; c < 4; ++c) oacc[u][c] *= alpha;
#pragma unroll
      for (int q = 0; q < 4; ++q) { const unsigned w = pk2(pv[2 * q], pv[2 * q + 1]); pf[u][2 * q] = (short)(w & 0xffffu); pf[u][2 * q + 1] = (short)(w >> 16); }
    }
    asm volatile("s_waitcnt lgkmcnt(0)" ::: "memory");
#pragma unroll
    for (int c = 0; c < 4; ++c) {
      const s16x4 lo = ds_tr(vl + (4 * g + q4) * NA_RS + (16 * c + 4 * p4) * 2);
      const s16x4 hi = ds_tr(vl + (16 + 4 * g + q4) * NA_RS + (16 * c + 4 * p4) * 2);
      bf16x8 vf; vf[0] = lo[0]; vf[1] = lo[1]; vf[2] = lo[2]; vf[3] = lo[3]; vf[4] = hi[0]; vf[5] = hi[1]; vf[6] = hi[2]; vf[7] = hi[3];
#pragma unroll
      for (int u = 0; u < NAU; ++u) oacc[u][c] = __builtin_amdgcn_mfma_f32_16x16x32_bf16(vf, pf[u], oacc[u][c], 0, 0, 0);
    }
    asm volatile("s_waitcnt lgkmcnt(0)" ::: "memory");
  }
#pragma unroll
  for (int u = 0; u < NAU; ++u) {
    float ls = lsum[u];
    ls += __shfl_xor(ls, 16, 64); ls += __shfl_xor(ls, 32, 64);
    const float inv = 1.f / ls;
    bf16_t* op = WSP(bf16_t, WS_GM) + (size_t)(qrow[u] + fr) * GSTR + 1024 + h * 64 + 4 * g;
#pragma unroll
    for (int c = 0; c < 4; ++c) {
      u32x2 w; w.x = pk2(oacc[u][c][0] * inv, oacc[u][c][1] * inv); w.y = pk2(oacc[u][c][2] * inv, oacc[u][c][3] * inv);
      *(u32x2*)(op + 16 * c) = w;
    }
  }
}
__device__ void na_phase(const Params& p, int l, LAS unsigned char* lds, int bid, int nb, int mode) {
  WS_LOCAL
  const int tid = otid(), wave = tid >> 6, lane = tid & 63;
  LAS unsigned char* vlb = lds + 4096;
  LAS unsigned char* vl = vlb + wave * 4608;
  constexpr int NLAT = 2 * (128 / NAU) * 4 * 8, NCTX = 2 * (16 / NAU) * 8;
  int t0, t1, ts;
  if (mode == 0) {
    LAS float* rl = (LAS float*)(vlb + 40960);
    const float* rg = KARG(const float, 12) + (size_t)l * 8 * 465;
    for (int k = tid; k < 8 * 465; k += NTHR) rl[k] = rg[k];
    t0 = bid * NWAVES + wave; t1 = NLAT; ts = nb * NWAVES;
  } else {
    const bool on = (l == 0) && (bid >= 32) && (bid < 32 + NCTX / NWAVES);
    t0 = NLAT + (bid - 32) * NWAVES + wave; t1 = on ? NLAT + NCTX : 0; ts = NLAT + NCTX;
  }
  __syncthreads();
  for (int t = t0; t < t1; t += ts) na_wave_task(p, l, vlb, vl, t, lane);
  __syncthreads();
}
#define G_LRS 0
#define G_TOT 8192
#define G_RED 10240
#define G_VT 12288
#define G_KT 46080
#define G_QB 63488
#define G_QE 80896
#define G_ATT 98304
#define G_RK 107520
#define G_RQ (MISC_OFF + 2048)
#define VRS 528
#define KRS 272
#define ARS 144
__device__ __forceinline__ void gla_load_w(const Params& p, int l, int hd, int tid, float (&w)[2][17]) {
  WS_LOCAL
  const int d = tid & 127;
#pragma unroll
  for (int dir = 0; dir < 2; ++dir) {
#pragma unroll
    for (int r = 0; r < 16; ++r) w[dir][r] = KARG(const float, 9)[((size_t)(l * 2 + dir) * 16 + r) * 512 + hd * 128 + d];
    w[dir][16] = KARG(const float, 10)[(l * 2 + dir) * 512 + hd * 128 + d];
  }
}
template <bool FULL>
__device__ __forceinline__ void gla_prep(const Params& p, int l, LAS unsigned char* lds, int hd, int dir, int tid, const float (&w)[17], float* dbout, int kt_off, int tot_off) {
  WS_LOCAL
  const int d = tid & 127, sq = tid >> 7;
  LAS float* lrs = (LAS float*)(lds + G_LRS); LAS float* tot = (LAS float*)(lds + tot_off);
  const float bgk = w[16];
  float pre[16];
#pragma unroll
  for (int i = 0; i < 16; i += 2) {
    const LAS float* lr = lrs + (dir * 16) * 64 + 16 * sq + i;
    f32x2 z = {bgk, bgk};
#pragma unroll
    for (int r = 0; r < 16; ++r) z += *(const LAS f32x2*)(lr + r * 64) * w[r];
    pre[i] = (fminf(z[0], 0.f) - __logf(1.f + __expf(-fabsf(z[0])))) * (1.f / 16.f);
    pre[i + 1] = (fminf(z[1], 0.f) - __logf(1.f + __expf(-fabsf(z[1])))) * (1.f / 16.f);
  }
  if (dir == 0) {
#pragma unroll
    for (int i = 1; i < 16; ++i) pre[i] += pre[i - 1];
  } else {
#pragma unroll
    for (int i = 14; i >= 0; --i) pre[i] += pre[i + 1];
  }
  tot[sq * 128 + d] = (dir == 0) ? pre[15] : pre[0];
  __syncthreads();
  const float t0 = tot[d], t1 = tot[128 + d], t2 = tot[256 + d], t3 = tot[384 + d];
  const float Btot = (t0 + t1) + (t2 + t3);
  float offs;
  if (dir == 0) offs = (sq > 0 ? t0 : 0.f) + (sq > 1 ? t1 : 0.f) + (sq > 2 ? t2 : 0.f);
  else offs = (sq < 3 ? t3 : 0.f) + (sq < 2 ? t2 : 0.f) + (sq < 1 ? t1 : 0.f);
  if (dbout != nullptr && sq == 0) dbout[d] = __expf(Btot);
  LAS unsigned char* kt = lds + kt_off; LAS unsigned char* qb = lds + G_QB; LAS unsigned char* qe = lds + G_QE;
#pragma unroll
  for (int i = 0; i < 16; ++i) {
    const int s = 16 * sq + i;
    const float bs = offs + pre[i];
    *(LAS bf16_t*)(kt + s * KRS + d * 2) = f2bf(bf2f(*(const LAS bf16_t*)(lds + G_RK + (s * 128 + d) * 2)) * __expf(Btot - bs));
    if (FULL) {
      const float qv = bf2f(*(const LAS bf16_t*)(lds + G_RQ + (s * 128 + d) * 2));
      *(LAS bf16_t*)(qb + s * KRS + d * 2) = f2bf(qv * __expf(bs));
      *(LAS bf16_t*)(qe + s * KRS + d * 2) = f2bf(qv * __expf(bs - Btot));
    }
  }
}
__device__ __forceinline__ u32x4 rope8(u32x4 self, u32x4 part, const float* tb, bool lower, float scale) {
  u32x4 o;
#pragma unroll
  for (int q = 0; q < 4; ++q) {
    const f32x4 cssn = *(const f32x4*)(tb + 4 * q);
    const float s0 = bflo(self[q]), s1 = bfhi(self[q]), p0 = bflo(part[q]), p1 = bfhi(part[q]);
    const float r0 = lower ? (s0 * cssn[0] - p0 * cssn[1]) : (p0 * cssn[1] + s0 * cssn[0]);
    const float r1 = lower ? (s1 * cssn[2] - p1 * cssn[3]) : (p1 * cssn[3] + s1 * cssn[2]);
    o[q] = pk2(r0 * scale, r1 * scale);
  }
  return o;
}
struct ChunkRegs { f32x4 lv; u32x4 vv[4], ks[2]; };
template <bool FULL>
__device__ __forceinline__ void gla_issue(const Params& p, int row0, int hd, int c, int tid_, ChunkRegs& R) {
  WS_LOCAL
  int tid = tid_; asm volatile("" : "+v"(tid));
  { const int r = tid >> 3, c4 = (tid & 7) * 4; R.lv = *(const f32x4*)(WSP(float, WS_LR32) + (size_t)(row0 + r) * 32 + c4); }
#pragma unroll
  for (int i = 0; i < 4; ++i) { const int ci = tid + 512 * i, r = ci >> 5, ch = ci & 31; R.vv[i] = *(const u32x4*)(WSP(bf16_t, WS_PROJ) + (size_t)(row0 + r) * PSTR + 1024 + hd * 256 + ch * 8); }
#pragma unroll
  for (int i = 0; i < 2; ++i) {
    const int ci = tid + 512 * i, r = ci >> 4, ch = ci & 15;
    const bf16_t* rowp = WSP(bf16_t, WS_PROJ) + (size_t)(row0 + r) * PSTR + hd * 128;
    if (!FULL) R.ks[i] = *(const u32x4*)(rowp + 512 + ch * 8);
  }
}
template <bool FULL>
__device__ __forceinline__ void gla_commit(const Params& p, LAS unsigned char* lds, int row0, int hd, int c, int tid_, const ChunkRegs& R) {
  WS_LOCAL
  int tid = tid_; asm volatile("" : "+v"(tid));
  { const int r = tid >> 3, c4 = (tid & 7) * 4; LAS float* lt = (LAS float*)(lds + G_LRS) + c4 * 64 + r; lt[0] = R.lv[0]; lt[64] = R.lv[1]; lt[128] = R.lv[2]; lt[192] = R.lv[3]; }
  const bool isctx = c < 4; const int cl = c - 4;
#pragma unroll
  for (int i = 0; i < 2; ++i) {
    const int ci = tid + 512 * i, r = ci >> 4, ch = ci & 15, chp = ch ^ 4;
    const bool lower = (ch & 7) < 4;
    const float* tb = WSP(float, WS_ROPE) + ((size_t)((ch < 8) ? cl : r) * 32 + ((8 * ch) & 31)) * 2;
    const bf16_t* rowp = WSP(bf16_t, WS_PROJ) + (size_t)(row0 + r) * PSTR + hd * 128;
    u32x4 ks = FULL ? *(const u32x4*)(rowp + 512 + ch * 8) : R.ks[i];
    if (!isctx) ks = rope8(ks, *(const u32x4*)(rowp + 512 + chp * 8), tb, lower, 1.f);
    *(LAS u32x4*)(lds + G_RK + ci * 16) = ks;
    if (FULL) {
      u32x4 qs = *(const u32x4*)(rowp + ch * 8);
      if (!isctx) qs = rope8(qs, *(const u32x4*)(rowp + chp * 8), tb, lower, 0.08838834764831845f);
      else {
#pragma unroll
        for (int q = 0; q < 4; ++q) qs[q] = pk2(bflo(qs[q]) * 0.08838834764831845f, bfhi(qs[q]) * 0.08838834764831845f);
      }
      *(LAS u32x4*)(lds + G_RQ + ci * 16) = qs;
    }
  }
#pragma unroll
  for (int i = 0; i < 4; ++i) { const int ci = tid + 512 * i, r = ci >> 5, ch = ci & 31; *(LAS u32x4*)(lds + G_VT + r * VRS + ch * 16) = R.vv[i]; }
}
__device__ __forceinline__ bf16x8 tr8(const LAS unsigned char* base, int rs, int r0, int q4, int cbyte) {
  const s16x4 lo = ds_tr(base + (r0 + q4) * rs + cbyte), hi = ds_tr(base + (r0 + 4 + q4) * rs + cbyte);
  bf16x8 v; v[0] = lo[0]; v[1] = lo[1]; v[2] = lo[2]; v[3] = lo[3]; v[4] = hi[0]; v[5] = hi[1]; v[6] = hi[2]; v[7] = hi[3];
  return v;
}
__device__ void gla_passA(const Params& p, int l, LAS unsigned char* lds, int bid, int nb) {
  WS_LOCAL
  const int tid = otid(), wave = tid >> 6, lane = tid & 63, fr = lane & 15, g = lane >> 4, q4 = fr >> 2, p4 = fr & 3;
  bf16_t* SB = (bf16_t*)WSP(float, WS_RG);
  ChunkRegs R; float wv[2][17];
  if (bid < 1056) {
    const int c = bid % 132, bh = bid / 132, b = bh >> 2, hd = bh & 3;
    gla_issue<false>(p, (c < 4) ? (NL + b * 256 + c * 64) : (b * 8192 + (c - 4) * 64), hd, c, tid, R);
  }
  for (int task = bid; task < 1056; task += nb) {
    const int c = task % 132, bh = task / 132, b = bh >> 2, hd = bh & 3;
    gla_load_w(p, l, hd, tid, wv);
    gla_commit<false>(p, lds, (c < 4) ? (NL + b * 256 + c * 64) : (b * 8192 + (c - 4) * 64), hd, c, tid, R);
    __syncthreads();
#pragma unroll
    for (int dir = 0; dir < 2; ++dir) {
      float wd[17];
#pragma unroll
      for (int r = 0; r < 17; ++r) wd[r] = wv[dir][r];
      gla_prep<false>(p, l, lds, hd, dir, tid, wd, WSP(float, WS_DB) + (size_t)((bh * 2 + dir) * 132 + c) * 128, dir ? G_QB : G_KT, dir ? G_RED : G_TOT);
    }
    __syncthreads();
    if (task + nb < 1056) {
      const int tn = task + nb, cn = tn % 132, bhn = tn / 132, bn = bhn >> 2, hdn = bhn & 3;
      gla_issue<false>(p, (cn < 4) ? (NL + bn * 256 + cn * 64) : (bn * 8192 + (cn - 4) * 64), hdn, cn, tid, R);
    }
    {
      bf16x8 af[2][2];
#pragma unroll
      for (int ks = 0; ks < 2; ++ks) { af[0][ks] = tr8(lds + G_KT, KRS, 32 * ks + 8 * g, q4, (16 * wave + 4 * p4) * 2); af[1][ks] = tr8(lds + G_QB, KRS, 32 * ks + 8 * g, q4, (16 * wave + 4 * p4) * 2); }
      bf16_t* dst0 = SB + ((size_t)((bh * 2) * 132 + c) * 256 + fr) * 128 + 16 * wave + 4 * g;
      bf16_t* dst1 = dst0 + (size_t)132 * 256 * 128;
#pragma unroll 4
      for (int n = 0; n < 16; ++n) {
        f32x4 a0 = {0.f, 0.f, 0.f, 0.f}, a1 = a0;
#pragma unroll
        for (int ks = 0; ks < 2; ++ks) {
          const bf16x8 bfr = tr8(lds + G_VT, VRS, 32 * ks + 8 * g, q4, (16 * n + 4 * p4) * 2);
          a0 = __builtin_amdgcn_mfma_f32_16x16x32_bf16(af[0][ks], bfr, a0, 0, 0, 0);
          a1 = __builtin_amdgcn_mfma_f32_16x16x32_bf16(af[1][ks], bfr, a1, 0, 0, 0);
        }
        u32x2 w0; w0.x = pk2(a0[0], a0[1]); w0.y = pk2(a0[2], a0[3]);
        u32x2 w1; w1.x = pk2(a1[0], a1[1]); w1.y = pk2(a1[2], a1[3]);
        *(u32x2*)(dst0 + (size_t)(16 * n) * 128) = w0;
        *(u32x2*)(dst1 + (size_t)(16 * n) * 128) = w1;
      }
    }
    __syncthreads();
  }
}
__device__ void gla_passB(const Params& p, int bid, int nb) {
  WS_LOCAL
  const int tid = otid();
  bf16_t* SB = (bf16_t*)WSP(float, WS_RG);
  for (int item = bid * NTHR + tid; item < 131072; item += nb * NTHR) {
    const int dq = item & 31, e = (item >> 5) & 255, chain = item >> 13, dir = chain & 1;
    f32x4 S = {0.f, 0.f, 0.f, 0.f};
    bf16_t* base = SB + ((size_t)chain * 132 * 256 + e) * 128 + dq * 4;
    const float* dbase = WSP(float, WS_DB) + (size_t)chain * 132 * 128 + dq * 4;
#pragma unroll 1
    for (int i0 = 0; i0 < 132; i0 += 12) {
      u32x2 u[12]; f32x4 dd[12]; int cc[12];
#pragma unroll
      for (int k = 0; k < 12; ++k) {
        const int i = i0 + k;
        cc[k] = dir ? ((i < 4) ? 3 - i : 135 - i) : i;
        u[k] = __builtin_nontemporal_load((const u32x2*)(base + (size_t)cc[k] * 32768));
        dd[k] = *(const f32x4*)(dbase + cc[k] * 128);
      }
#pragma unroll
      for (int k = 0; k < 12; ++k) {
        u32x2 o; o.x = pk2(S[0], S[1]); o.y = pk2(S[2], S[3]);
        *(u32x2*)(base + (size_t)cc[k] * 32768) = o;
        S[0] = S[0] * dd[k][0] + bflo(u[k].x); S[1] = S[1] * dd[k][1] + bfhi(u[k].x);
        S[2] = S[2] * dd[k][2] + bflo(u[k].y); S[3] = S[3] * dd[k][3] + bfhi(u[k].y);
      }
    }
  }
}
__device__ void gla_passC(const Params& p, int l, LAS unsigned char* lds, int bid, int nb) {
  WS_LOCAL
  const int tid = otid(), wave = tid >> 6, lane = tid & 63, fr = lane & 15, g = lane >> 4, q4 = fr >> 2, p4 = fr & 3;
  const bf16_t* SB = (const bf16_t*)WSP(float, WS_RG);
  const int c_lo = (l == 0) ? 0 : 4, nc = 132 - c_lo, ntask = 8 * nc;
  ChunkRegs R; float wv[2][17];
  if (bid < ntask) {
    const int c = c_lo + bid % nc, bh = bid / nc, b = bh >> 2, hd = bh & 3;
    gla_issue<true>(p, (c < 4) ? (NL + b * 256 + c * 64) : (b * 8192 + (c - 4) * 64), hd, c, tid, R);
  }
  for (int task = bid; task < ntask; task += nb) {
    const int c = c_lo + task % nc, bh = task / nc, b = bh >> 2, hd = bh & 3;
    const int row0 = (c < 4) ? (NL + b * 256 + c * 64) : (b * 8192 + (c - 4) * 64);
    gla_load_w(p, l, hd, tid, wv);
    gla_commit<true>(p, lds, row0, hd, c, tid, R);
    __syncthreads();
    f32x4 acc[2][4];
#pragma unroll
    for (int eb = 0; eb < 2; ++eb)
#pragma unroll
      for (int tb = 0; tb < 4; ++tb) acc[eb][tb] = (f32x4){0.f, 0.f, 0.f, 0.f};
    f32x4 attacc[2];
    attacc[0] = (f32x4){0.f, 0.f, 0.f, 0.f}; attacc[1] = attacc[0];
#pragma unroll 1
    for (int dir = 0; dir < 2; ++dir) {
      const int chain = bh * 2 + dir;
      { float wd[17];
#pragma unroll
        for (int r = 0; r < 17; ++r) wd[r] = dir ? wv[1][r] : wv[0][r];
        gla_prep<true>(p, l, lds, hd, dir, tid, wd, nullptr, G_KT, G_TOT); __syncthreads(); }
      {
        const int sb = wave >> 1;
        bf16x8 ka[4];
#pragma unroll
        for (int ks = 0; ks < 4; ++ks) ka[ks] = *(const LAS bf16x8*)(lds + G_KT + (16 * sb + fr) * KRS + (32 * ks + 8 * g) * 2);
#pragma unroll
        for (int t2 = 0; t2 < 2; ++t2) {
          const int tb = 2 * (wave & 1) + t2;
          f32x4 a = {0.f, 0.f, 0.f, 0.f};
#pragma unroll
          for (int ks = 0; ks < 4; ++ks) {
            const bf16x8 qf = *(const LAS bf16x8*)(lds + G_QE + (16 * tb + fr) * KRS + (32 * ks + 8 * g) * 2);
            a = __builtin_amdgcn_mfma_f32_16x16x32_bf16(ka[ks], qf, a, 0, 0, 0);
          }
          const int t = 16 * tb + fr;
#pragma unroll
          for (int jj = 0; jj < 4; ++jj) { const int s = 16 * sb + 4 * g + jj; const bool keep = dir ? (s >= t) : (s <= t); attacc[t2][jj] += keep ? a[jj] : 0.f; }
          if (dir == 1) {
            u32x2 w2; w2.x = pk2(attacc[t2][0], attacc[t2][1]); w2.y = pk2(attacc[t2][2], attacc[t2][3]);
            *(LAS u32x2*)(lds + G_ATT + t * ARS + (16 * sb + 4 * g) * 2) = w2;
          }
        }
      }
      {
        const bf16_t* sp = SB + ((size_t)(chain * 132 + c) * 256 + 32 * wave + fr) * 128 + 8 * g;
#pragma unroll
        for (int kh = 0; kh < 2; ++kh) {
          bf16x8 sf[2][2];
#pragma unroll
          for (int eb = 0; eb < 2; ++eb)
#pragma unroll
            for (int k2 = 0; k2 < 2; ++k2) sf[eb][k2] = *(const bf16x8*)(sp + (size_t)(16 * eb) * 128 + 32 * (2 * kh + k2));
#pragma unroll
          for (int tb = 0; tb < 4; ++tb)
#pragma unroll
            for (int k2 = 0; k2 < 2; ++k2) {
              const bf16x8 qf = *(const LAS bf16x8*)(lds + G_QB + (16 * tb + fr) * KRS + (32 * (2 * kh + k2) + 8 * g) * 2);
#pragma unroll
              for (int eb = 0; eb < 2; ++eb) acc[eb][tb] = __builtin_amdgcn_mfma_f32_16x16x32_bf16(sf[eb][k2], qf, acc[eb][tb], 0, 0, 0);
            }
          __builtin_amdgcn_sched_barrier(0);
        }
      }
      __syncthreads();
    }
#pragma unroll
    for (int ks = 0; ks < 2; ++ks) {
      bf16x8 vf[2];
#pragma unroll
      for (int eb = 0; eb < 2; ++eb) vf[eb] = tr8(lds + G_VT, VRS, 32 * ks + 8 * g, q4, (16 * (2 * wave + eb) + 4 * p4) * 2);
#pragma unroll
      for (int tb = 0; tb < 4; ++tb) {
        const bf16x8 af = *(const LAS bf16x8*)(lds + G_ATT + (16 * tb + fr) * ARS + (32 * ks + 8 * g) * 2);
#pragma unroll
        for (int eb = 0; eb < 2; ++eb) acc[eb][tb] = __builtin_amdgcn_mfma_f32_16x16x32_bf16(vf[eb], af, acc[eb][tb], 0, 0, 0);
      }
    }
    if (task + nb < ntask) {
      const int tn = task + nb, cn = c_lo + tn % nc, bhn = tn / nc, bn = bhn >> 2, hdn = bhn & 3;
      gla_issue<true>(p, (cn < 4) ? (NL + bn * 256 + cn * 64) : (bn * 8192 + (cn - 4) * 64), hdn, cn, tid, R);
    }
    u32x2 og[2][4]; f32x4 nwv[2];
#pragma unroll
    for (int eb = 0; eb < 2; ++eb) {
      const int e0 = 16 * (2 * wave + eb) + 4 * g;
      nwv[eb] = *(const f32x4*)(KARG(const float, 11) + l * 256 + e0);
#pragma unroll
      for (int tb = 0; tb < 4; ++tb) og[eb][tb] = *(const u32x2*)(WSP(bf16_t, WS_PROJ) + (size_t)(row0 + 16 * tb + fr) * PSTR + 2048 + hd * 256 + e0);
    }
    LAS float* red = (LAS float*)(lds + G_RED);
    float rstd[4];
#pragma unroll
    for (int tb = 0; tb < 4; ++tb) {
      float ss = 0.f;
#pragma unroll
      for (int eb = 0; eb < 2; ++eb)
#pragma unroll
        for (int jj = 0; jj < 4; ++jj) ss += acc[eb][tb][jj] * acc[eb][tb][jj];
      ss += __shfl_xor(ss, 16, 64); ss += __shfl_xor(ss, 32, 64);
      if (g == 0) red[wave * 64 + 16 * tb + fr] = ss;
    }
    __syncthreads();
#pragma unroll
    for (int tb = 0; tb < 4; ++tb) {
      float ss = 0.f;
#pragma unroll
      for (int w8 = 0; w8 < 8; ++w8) ss += red[w8 * 64 + 16 * tb + fr];
      rstd[tb] = rsqrtf(ss * (1.f / 256.f) + 1e-6f);
    }
#pragma unroll
    for (int eb = 0; eb < 2; ++eb) {
      const int e0 = 16 * (2 * wave + eb) + 4 * g;
      const f32x4 nw = nwv[eb];
#pragma unroll
      for (int tb = 0; tb < 4; ++tb) {
        const int row = row0 + 16 * tb + fr;
        const u32x2 ogv = og[eb][tb];
        const float y0 = acc[eb][tb][0] * rstd[tb] * nw[0] * siluf_(bflo(ogv.x)), y1 = acc[eb][tb][1] * rstd[tb] * nw[1] * siluf_(bfhi(ogv.x));
        const float y2 = acc[eb][tb][2] * rstd[tb] * nw[2] * siluf_(bflo(ogv.y)), y3 = acc[eb][tb][3] * rstd[tb] * nw[3] * siluf_(bfhi(ogv.y));
        u32x2 w2; w2.x = pk2(y0, y1); w2.y = pk2(y2, y3);
        *(u32x2*)(WSP(bf16_t, WS_GM) + (size_t)row * GSTR + hd * 256 + e0) = w2;
      }
    }
  }
}
__device__ __forceinline__ void route_top2(float affl, float sell, int& e1, int& e2, float& w1, float& w2) {
  float aff[16], sel[16];
#pragma unroll
  for (int e = 0; e < 16; ++e) { aff[e] = __int_as_float(__builtin_amdgcn_readlane(__float_as_int(affl), 4 * e)); sel[e] = __int_as_float(__builtin_amdgcn_readlane(__float_as_int(sell), 4 * e)); }
  float best = -INFINITY; int gb = 0;
  float bs[4], ba[4];
#pragma unroll
  for (int q = 0; q < 4; ++q) { bs[q] = 0.f; ba[q] = 0.f; }
#pragma unroll
  for (int g = 0; g < 4; ++g) {
    const float s0 = sel[4 * g], s1 = sel[4 * g + 1], s2 = sel[4 * g + 2], s3 = sel[4 * g + 3];
    const float m1 = fmaxf(fmaxf(s0, s1), fmaxf(s2, s3));
    const int f = (s0 == m1) ? 0 : (s1 == m1) ? 1 : (s2 == m1) ? 2 : 3;
    float m2 = -INFINITY;
    if (f != 0) m2 = fmaxf(m2, s0);
    if (f != 1) m2 = fmaxf(m2, s1);
    if (f != 2) m2 = fmaxf(m2, s2);
    if (f != 3) m2 = fmaxf(m2, s3);
    const float gs = m1 + m2;
    if (gs > best) {
      best = gs; gb = g;
      bs[0] = s0; bs[1] = s1; bs[2] = s2; bs[3] = s3;
      ba[0] = aff[4 * g]; ba[1] = aff[4 * g + 1]; ba[2] = aff[4 * g + 2]; ba[3] = aff[4 * g + 3];
    }
  }
  const float m1 = fmaxf(fmaxf(bs[0], bs[1]), fmaxf(bs[2], bs[3]));
  const int i1 = (bs[0] == m1) ? 0 : (bs[1] == m1) ? 1 : (bs[2] == m1) ? 2 : 3;
  float m2 = -INFINITY; int i2 = 0;
#pragma unroll
  for (int q = 3; q >= 0; --q)
    if (q != i1 && bs[q] >= m2) { m2 = bs[q]; i2 = q; }
  const float a1 = (i1 == 0) ? ba[0] : (i1 == 1) ? ba[1] : (i1 == 2) ? ba[2] : ba[3];
  const float a2 = (i2 == 0) ? ba[0] : (i2 == 1) ? ba[1] : (i2 == 2) ? ba[2] : ba[3];
  const float inv = 1.f / (a1 + a2);
  e1 = gb * 4 + i1; e2 = gb * 4 + i2; w1 = a1 * inv; w2 = a2 * inv;
}
__device__ void ph_norm2(const Params& p, int l, LAS unsigned char* lds, int bid, int nb) {
  WS_LOCAL
  const int tid = otid(), wave = tid >> 6, lane = tid & 63, fr = lane & 15, g = lane >> 4;
  const int M = (l == 0) ? NT : NL;
  const int R = (M + nb - 1) / nb, rbeg = bid * R, rend = min(rbeg + R, M);
  LAS int* lcnt = (LAS int*)lds;
  LAS int* lbase = lcnt + 16;
  LAS int* rec = lcnt + 64;
  LAS float* Hs = (LAS float*)(lds + 4096);
  LAS float* part = (LAS float*)(lds + 4096 + 16 * 1028 * 4);
  if (tid < 32) lcnt[tid] = 0;
  for (int k = tid; k < R; k += NTHR) rec[k * 8] = -1;
  float wreg[32];
#pragma unroll
  for (int t = 0; t < 32; ++t) wreg[t] = KARG(const float, 16)[(size_t)(128 * wave + 4 * t + g) * 16 + fr];
  const bf16_t* Yb = WSP(bf16_t, WS_Y);
  const float* nw = KARG(const float, 7) + l * 1024;
  const float brt = KARG(const float, 17)[(lane >> 2) & 15];
  __syncthreads();
  for (int r0 = rbeg; r0 < rend; r0 += 16) {
    int rows[2]; bool val[2];
#pragma unroll
    for (int u = 0; u < 2; ++u) { rows[u] = r0 + 2 * wave + u; val[u] = rows[u] < rend; if (!val[u]) rows[u] = rend - 1; }
    f32x4 v[2][4]; u32x2 yv[2][4];
#pragma unroll
    for (int u = 0; u < 2; ++u) {
      const int row = rows[u];
      const float* src = (l == 0) ? ((row < NL) ? KARG(const float, 0) + (size_t)row * 1024 : KARG(const float, 2) + (size_t)(row - NL) * 1024)
                                  : (const float*)(WSP(float, WS_XBUF) + (size_t)row * 1024);
#pragma unroll
      for (int i = 0; i < 4; ++i) { v[u][i] = *(const f32x4*)(src + i * 256 + lane * 4); yv[u][i] = *(const u32x2*)(Yb + (size_t)row * 1024 + i * 256 + lane * 4); }
    }
#pragma unroll
    for (int u = 0; u < 2; ++u) {
      const int row = rows[u];
      const float* md = WSP(float, WS_MOD) + (l * 3 + ((row < NL) ? (row >> 13) : 2)) * 6144;
      float ss = 0.f;
#pragma unroll
      for (int i = 0; i < 4; ++i) {
        const f32x4 m2 = *(const f32x4*)(md + 2048 + i * 256 + lane * 4);
        v[u][i][0] += m2[0] * bflo(yv[u][i].x); v[u][i][1] += m2[1] * bfhi(yv[u][i].x); v[u][i][2] += m2[2] * bflo(yv[u][i].y); v[u][i][3] += m2[3] * bfhi(yv[u][i].y);
        if (val[u]) *(f32x4*)(WSP(float, WS_XBUF) + (size_t)row * 1024 + i * 256 + lane * 4) = v[u][i];
        ss += v[u][i][0] * v[u][i][0] + v[u][i][1] * v[u][i][1] + v[u][i][2] * v[u][i][2] + v[u][i][3] * v[u][i][3];
      }
      const float rstd = rsqrtf(wave_sum(ss) * (1.f / 1024.f) + 1e-6f);
#pragma unroll
      for (int i = 0; i < 4; ++i) {
        const int j = i * 256 + lane * 4;
        const f32x4 w = *(const f32x4*)(nw + j), m4 = *(const f32x4*)(md + 4096 + j), m3 = *(const f32x4*)(md + 3072 + j);
        f32x4 h;
#pragma unroll
        for (int q = 0; q < 4; ++q) h[q] = v[u][i][q] * rstd * w[q] * (1.f + m4[q]) + m3[q];
        if (val[u]) *(unsigned*)(WSP(unsigned char, WS_H8) + (size_t)row * 1024 + j) = pk4_fp8(h[0], h[1], h[2], h[3]);
        *(LAS f32x4*)(Hs + (2 * wave + u) * 1028 + j) = h;
      }
    }
    __syncthreads();
    {
      f32x4 acc = {0.f, 0.f, 0.f, 0.f};
      const LAS float* hp = Hs + fr * 1028 + 128 * wave + g;
#pragma unroll
      for (int t = 0; t < 32; ++t) acc = __builtin_amdgcn_mfma_f32_16x16x4f32(hp[4 * t], wreg[t], acc, 0, 0, 0);
#pragma unroll
      for (int jj = 0; jj < 4; ++jj) part[(wave * 16 + 4 * g + jj) * 16 + fr] = acc[jj];
    }
    __syncthreads();
#pragma unroll
    for (int u = 0; u < 2; ++u) {
      const int rl = 2 * wave + u, em = (lane >> 2) & 15;
      float lg = 0.f;
#pragma unroll
      for (int w8 = 0; w8 < 8; ++w8) lg += part[(w8 * 16 + rl) * 16 + em];
      const float affl = 1.f / (1.f + expf(-lg)), sell = affl + brt;
      int e1, e2; float w1, w2;
      route_top2(affl, sell, e1, e2, w1, w2);
      if (lane == 0 && val[u]) {
        const int s1 = __hip_atomic_fetch_add(&lcnt[e1], 1, __ATOMIC_RELAXED, __HIP_MEMORY_SCOPE_WORKGROUP);
        const int s2 = __hip_atomic_fetch_add(&lcnt[e2], 1, __ATOMIC_RELAXED, __HIP_MEMORY_SCOPE_WORKGROUP);
        LAS int* rc = rec + (rows[u] - rbeg) * 8;
        rc[0] = rows[u]; rc[1] = e1; rc[2] = s1; rc[3] = e2; rc[4] = s2; rc[5] = __float_as_int(w1); rc[6] = __float_as_int(w2);
      }
    }
  }
  __syncthreads();
  if (tid < 16) { const int n = lcnt[tid]; lbase[tid] = n ? atomicAdd(&WSP(int, WS_CTL + 4096 * 4)[(l * 16 + tid) * 64], n) : 0; }
  __syncthreads();
  for (int k = tid; k < R; k += NTHR) {
    const LAS int* rc = rec + k * 8;
    const int row = rc[0];
    if (row >= 0) {
      const int e1 = rc[1], s1 = lbase[e1] + rc[2], e2 = rc[3], s2 = lbase[e2] + rc[4];
      WSP(int, WS_LIST)[e1 * NT + s1] = row * 2; WSP(float, WS_TOPW)[row * 2] = __int_as_float(rc[5]);
      WSP(int, WS_LIST)[e2 * NT + s2] = row * 2 + 1; WSP(float, WS_TOPW)[row * 2 + 1] = __int_as_float(rc[6]);
    }
  }
}
__device__ __forceinline__ void moe_tables(const Params& p, int l, volatile LAS int* tab, int nN) {
  WS_LOCAL
  if (threadIdx.x == 0) {
    int up = 0, tb = 0;
    for (int e = 0; e < 16; ++e) {
      const int c = __hip_atomic_load(&WSP(int, WS_CTL + 4096 * 4)[(l * 16 + e) * 64], __ATOMIC_RELAXED, __HIP_MEMORY_SCOPE_AGENT), mt = (c + 255) >> 8;
      tab[e] = up; tab[32 + e] = mt > 0 ? mt : 1; tab[64 + e] = tb; tab[96 + e] = c;
      up += mt * nN; tb += mt;
    }
    tab[16] = up;
  }
  __syncthreads();
}
__device__ void ph_proj(const Params& p, int l, LAS unsigned char* lds, int bid, int nb) {
  WS_LOCAL
  pg8::DenseSched S; S.init(NT / 256, PSTR / 256, nb, bid, WSP(unsigned char, WS_HM), WSP(unsigned char, WS_WINT) + (size_t)l * PSTR * 1024, 512);
  EpiProj E{WSP(bf16_t, WS_PROJ), WSP(float, WS_LR32)};
  pg8::gemm_phase<EpiProj, pg8::DenseSched, 0, false, true>(lds, 512, S, E);
}
__device__ void ph_merge(const Params& p, int l, LAS unsigned char* lds, int bid, int nb) {
  WS_LOCAL
  if (l == 0 && bid < 8) {
    const int pm = 64 + (bid >> 2), pn = bid & 3;
    unsigned* ctr = WSP(unsigned, WS_CTL + 6400 * 4) + (bid >> 2) * 64;
    pg8::SingleSched S; S.u0.pm = pm; S.u0.pn = pn; S.u0.e = 0; S.u0.aux = 0;
    S.u0.A = (const char*)WSP(bf16_t, WS_GM) + (size_t)pm * 256 * GSTR * 2; S.u0.B = (const char*)WSP(bf16_t, WS_WMT) + (size_t)pn * 256 * GSTR * 2;
    EpiMerge E{WSP(bf16_t, WS_PROJ), WSP(bf16_t, WS_HM)};
    pg8::gemm_phase<EpiMerge, pg8::SingleSched, 16>(lds, GSTR, S, E);
    asm volatile("s_waitcnt vmcnt(0)" ::: "memory");
    __syncthreads();
    if (threadIdx.x == 0) {
      __builtin_amdgcn_fence(__ATOMIC_RELEASE, "agent");
      asm volatile("s_waitcnt vmcnt(0)" ::: "memory");
      (void)__hip_atomic_fetch_add(ctr, 1u, __ATOMIC_RELAXED, __HIP_MEMORY_SCOPE_AGENT);
    }
  }
  {
    pg8::DenseSched S; S.init(NL / 256, 4, nb, bid, WSP(bf16_t, WS_GM), WSP(bf16_t, WS_WMT) + (size_t)l * 1024 * GSTR, GSTR);
    EpiMerge E{WSP(bf16_t, WS_PROJ), WSP(bf16_t, WS_HM)};
    pg8::gemm_phase<EpiMerge, pg8::DenseSched, 16>(lds, GSTR, S, E);
  }
  if (l == 0 && bid >= 8 && bid < 16) {
    const int j = bid - 8, pm = 64 + (j >> 2), pn = j & 3;
    unsigned* ctr = WSP(unsigned, WS_CTL + 6400 * 4) + (j >> 2) * 64;
    if (threadIdx.x == 0) {
      unsigned sp = 0;
      while (__hip_atomic_load(ctr, __ATOMIC_RELAXED, __HIP_MEMORY_SCOPE_AGENT) < 4u) { __builtin_amdgcn_s_sleep(2); if (++sp > (1u << 24)) break; }
      __builtin_amdgcn_fence(__ATOMIC_ACQUIRE, "agent");
      asm volatile("s_waitcnt vmcnt(0)" ::: "memory");
    }
    __syncthreads();
    pg8::SingleSched S; S.u0.pm = pm; S.u0.pn = pn; S.u0.e = 0; S.u0.aux = 0;
    S.u0.A = (const char*)WSP(bf16_t, WS_HM) + (size_t)pm * 256 * 1024 * 2; S.u0.B = (const char*)WSP(bf16_t, WS_WOT) + (size_t)pn * 256 * 1024 * 2;
    EpiOut E{WSP(bf16_t, WS_Y)};
    pg8::gemm_phase<EpiOut, pg8::SingleSched, 0>(lds, 1024, S, E);
  }
}
__device__ void ph_out(const Params& p, int l, LAS unsigned char* lds, int bid, int nb) {
  WS_LOCAL
  pg8::DenseSched S; S.init(NL / 256, 4, nb, bid, WSP(bf16_t, WS_HM), WSP(bf16_t, WS_WOT) + (size_t)l * 1024 * 1024, 1024);
  EpiOut E{WSP(bf16_t, WS_Y)};
  pg8::gemm_phase<EpiOut, pg8::DenseSched, 0>(lds, 1024, S, E);
}
__device__ void ph_moe1(const Params& p, int l, LAS unsigned char* lds, int bid, int nb) {
  WS_LOCAL
  volatile LAS int* tab = (volatile LAS int*)(lds + MISC_OFF + 256);
  moe_tables(p, l, tab, 8);
  pg8::MoeSched S; S.U = tab[16]; S.nN = 8; S.G = nb; S.c = bid; S.A = (const char*)WSP(unsigned char, WS_H8); S.B = (const char*)WSP(unsigned char, WS_RG);
  S.tstep = (size_t)256 * 1024; S.estep = (size_t)2048 * 1024; S.tab = tab; S.list = WSP(int, WS_LIST); S.gather = true;
  EpiMoe1 E{WSP(unsigned char, WS_PROJ + PROWS * 2048)};
  pg8::gemm_phase<EpiMoe1, pg8::MoeSched, 0, true, true>(lds, 512, S, E);
}
__device__ void ph_moe2(const Params& p, int l, LAS unsigned char* lds, int bid, int nb) {
  WS_LOCAL
  volatile LAS int* tab = (volatile LAS int*)(lds + MISC_OFF + 256);
  __syncthreads();
  moe_tables(p, l, tab, 4);
  pg8::MoeSched S; S.U = tab[16]; S.nN = 4; S.G = nb; S.c = bid; S.A = (const char*)WSP(unsigned char, WS_PROJ + PROWS * 2048); S.B = (const char*)WSP(unsigned char, WS_W2F8);
  S.tstep = (size_t)256 * 1024; S.estep = (size_t)1024 * 1024; S.tab = tab; S.list = WSP(int, WS_LIST); S.gather = false;
  EpiMoe2 E{WSP(bf16_t, WS_PROJ + 2 * PROWS * 2048), WSP(int, WS_LIST), WSP(float, WS_TOPW), tab};
  pg8::gemm_phase<EpiMoe2, pg8::MoeSched, 0, false, true>(lds, 512, S, E);
}
__device__ void ph_final(const Params& p, int bid, int nb) {
  WS_LOCAL
  const int tid = otid(), wave = tid >> 6, lane = tid & 63;
  const int NGW = nb * NWAVES;
  for (int rowa = bid * NWAVES + wave; rowa < NL; rowa += 2 * NGW) {
    int rows[2]; rows[0] = rowa; rows[1] = rowa + NGW;
    const bool has2 = rows[1] < NL;
    if (!has2) rows[1] = rowa;
    f32x4 v[2][4]; float ss[2] = {0.f, 0.f};
#pragma unroll
    for (int u = 0; u < 2; ++u) {
      const int row = rows[u];
      const float* src = WSP(float, WS_XBUF) + (size_t)row * 1024;
      const float* m5 = WSP(float, WS_MOD) + (1 * 3 + (row >> 13)) * 6144 + 5 * 1024;
      const bf16_t* y0 = WSP(bf16_t, WS_PROJ + 2 * PROWS * 2048) + (size_t)(row * 2) * 1024;
#pragma unroll
      for (int i = 0; i < 4; ++i) {
        const int j = i * 256 + lane * 4;
        v[u][i] = __builtin_nontemporal_load((const f32x4*)(src + j));
        const u32x2 ya = __builtin_nontemporal_load((const u32x2*)(y0 + j)), yb = __builtin_nontemporal_load((const u32x2*)(y0 + 1024 + j));
        const f32x4 g = *(const f32x4*)(m5 + j);
        v[u][i][0] += g[0] * (bflo(ya.x) + bflo(yb.x)); v[u][i][1] += g[1] * (bfhi(ya.x) + bfhi(yb.x));
        v[u][i][2] += g[2] * (bflo(ya.y) + bflo(yb.y)); v[u][i][3] += g[3] * (bfhi(ya.y) + bfhi(yb.y));
        ss[u] += v[u][i][0] * v[u][i][0] + v[u][i][1] * v[u][i][1] + v[u][i][2] * v[u][i][2] + v[u][i][3] * v[u][i][3];
      }
    }
#pragma unroll
    for (int u = 0; u < 2; ++u) {
      if (u == 1 && !has2) break;
      const float rstd = rsqrtf(wave_sum(ss[u]) * (1.f / 1024.f) + 1e-6f);
#pragma unroll
      for (int i = 0; i < 4; ++i) {
        const int j = i * 256 + lane * 4;
        const f32x4 w = *(const f32x4*)(KARG(const float, 21) + j);
        __builtin_nontemporal_store(v[u][i] * rstd * w, (f32x4*)(KARG(float, 22) + (size_t)rows[u] * 1024 + j));
      }
    }
  }
}

__global__ void __launch_bounds__(NTHR, 2) k_mega(Params p) {
  extern __shared__ __attribute__((aligned(16))) unsigned char lds_raw[];
  LAS unsigned char* lds0 = (LAS unsigned char*)lds_raw;
  cg::grid_group grid = cg::this_grid();
  const int bid0 = blockIdx.x, nb0 = gridDim.x;
  volatile LAS unsigned* misc = (volatile LAS unsigned*)(lds0 + MISC_OFF);
  if (threadIdx.x < 64) misc[threadIdx.x] = 0u;
  __syncthreads();
  XcdBarrier bar = xcd_barrier_post((unsigned*)(p.ws + WS_CTL), misc);
  if (p.ws == nullptr) grid.sync();
#pragma unroll 1
  for (int step = 0; step < 23; ++step) {
    const int t = step - 2, l = (t >= 0) ? t / 10 : 0, ph = (step == 0) ? -1 : ((step == 1) ? -2 : ((step == 22) ? 11 : t % 10));
    int bid = bid0, nb = nb0; unsigned ldsu = (unsigned)(size_t)lds0;
    asm volatile("" : "+s"(bid), "+s"(nb), "+s"(ldsu));
    LAS unsigned char* lds = (LAS unsigned char*)(size_t)ldsu;
    switch (ph) {
      case -1: ph_init(p, lds, bid, nb); break;
      case -2: ph_ada_reduce(p, bid, nb); break;
      case 0: ph_norm1(p, l, bid, nb); break;
      case 1: ph_proj(p, l, lds, bid, nb); break;
      case 2: case 3: if (ph == 2) gla_passA(p, l, lds, bid, nb); else gla_passB(p, bid, nb);
              na_phase(p, l, lds, bid, nb, ph == 2 ? 1 : 0); break;
      case 4: gla_passC(p, l, lds, bid, nb); break;
      case 5: ph_experts(p, l, lds, bid, nb); __syncthreads(); ph_merge(p, l, lds, bid, nb); break;
      case 6: ph_out(p, l, lds, bid, nb); break;
      case 7: ph_norm2(p, l, lds, bid, nb); break;
      case 8: ph_moe1(p, l, lds, bid, nb); break;
      case 9: ph_moe2(p, l, lds, bid, nb); break;
      default: ph_final(p, bid, nb); break;
    }
    if (step == 22) break;
    xcd_barrier(bar);
  }
}

extern "C" void kernel_launch(void* const* d_in, const int* in_sizes, int n_in, void* d_out, int out_size, void* d_ws,
                              size_t ws_size, hipStream_t stream) {
  Params p{};
  const float** fp = (const float**)&p;
  for (int i = 0; i < 22; ++i) fp[i] = (const float*)d_in[i];
  p.out = (float*)d_out;
  p.ws = (char*)d_ws;
  if (WS_END > ws_size) { fprintf(stderr, "workspace too small: need %zu have %zu\n", (size_t)WS_END, ws_size); return; }

  static int grid_blocks = 0;
  if (!grid_blocks) {
    int dev = 0, cus = 0, per_cu = 0;
    (void)hipGetDevice(&dev);
    (void)hipDeviceGetAttribute(&cus, hipDeviceAttributeMultiprocessorCount, dev);
    (void)hipFuncSetAttribute((const void*)k_mega, hipFuncAttributeMaxDynamicSharedMemorySize, LDS_BYTES);
    (void)hipOccupancyMaxActiveBlocksPerMultiprocessor(&per_cu, k_mega, NTHR, LDS_BYTES);
    if (per_cu < 1) fprintf(stderr, "occupancy query reports %d blocks per CU\n", per_cu);
    grid_blocks = cus > 0 ? cus : 256;
  }
  (void)hipMemsetAsync(p.ws + WS_CTL, 0, 32768, stream);
  void* args[] = {&p};
  hipError_t e = hipLaunchCooperativeKernel((void*)k_mega, dim3(grid_blocks), dim3(NTHR), args, LDS_BYTES, stream);
  if (e != hipSuccess) fprintf(stderr, "cooperative launch failed: %s (grid %d)\n", hipGetErrorString(e), grid_blocks);
}
```
